# Optimizing an MI355X kernel written in HIP

```python
import jax, jax.numpy as jnp
from jax import lax
import numpy as np

D_MODEL = 1024
BATCH = 2
SEQ = 8192
DEPTH = 2
DEC_BATCH = 32
DEC_SEQ = 64
PAST_LEN = 2048

CHUNK = 64
D_PLE = 256
D_FF = 2816
WA = 512
CONV_W = 31
CONV_HIST = CONV_W - 1
WB = 512
SGU_GROUPS = 4
SGU_CHUNK = 128
SGU_GC = WB // SGU_GROUPS
WC = 512
POOL_WINDOWS = (2, 4, 8, 16)
POOL_GROUPS = len(POOL_WINDOWS)
POOL_GC = WC // POOL_GROUPS
POOL_HIST = max(POOL_WINDOWS) - 1
N_BRANCH = 3
D_IN = 2 * WA + 2 * WB + WC + N_BRANCH * D_MODEL
EPS = 1e-6

kernel_name = "gated_hybrid_streaming_encoder_step"


def rmsnorm(x, g):
    x32 = x.astype(jnp.float32)
    y = x32 * lax.rsqrt(jnp.mean(x32 * x32, axis=-1, keepdims=True) + EPS)
    return (y * g.astype(jnp.float32)).astype(x.dtype)


def layernorm(x, g, b):
    x32 = x.astype(jnp.float32)
    mu = jnp.mean(x32, axis=-1, keepdims=True)
    xc = x32 - mu
    y = xc * lax.rsqrt(jnp.mean(xc * xc, axis=-1, keepdims=True) + EPS)
    return (y * g.astype(jnp.float32) + b.astype(jnp.float32)).astype(x.dtype)


def swiglu(x, w_gate, w_up, w_down):
    return (jax.nn.silu(x @ w_gate) * (x @ w_up)) @ w_down


def conv_module(a, b, hist, dw_w, dw_b, ln_g, ln_b, w_out):
    z = a * jax.nn.sigmoid(b)
    full = jnp.concatenate([hist.astype(z.dtype), z], axis=1)
    y = lax.conv_general_dilated(full, dw_w[:, None, :].astype(z.dtype), window_strides=(1,),
                                 padding='VALID', dimension_numbers=('NWC', 'WIO', 'NWC'),
                                 feature_group_count=WA) + dw_b
    y = jax.nn.silu(layernorm(y, ln_g, ln_b))
    return y @ w_out, full[:, -CONV_HIST:]


def spatial_gating(u, vn, w_s, b_s):
    B, S, _ = vn.shape
    n_chunks = -(-S // SGU_CHUNK)
    pad = n_chunks * SGU_CHUNK - S
    vp = jnp.pad(vn, ((0, 0), (0, pad), (0, 0))).reshape(B, n_chunks, SGU_CHUNK, SGU_GROUPS, SGU_GC)
    mask = jnp.tril(jnp.ones((SGU_CHUNK, SGU_CHUNK), dtype=bool))
    ws = jnp.where(mask[None], w_s, jnp.zeros_like(w_s))
    s = jnp.einsum('gij,bnjgc->bnigc', ws, vp) + b_s.T[None, None, :, :, None]
    s = s.reshape(B, n_chunks * SGU_CHUNK, WB)[:, :S]
    return u * s


def pool_mixer(c, hist, start, w_lin, scale, w_out):
    B, S, _ = c.shape
    full = jnp.concatenate([hist.astype(c.dtype), c], axis=1)
    cs = jnp.cumsum(full.astype(jnp.float32), axis=1)
    cs = jnp.concatenate([jnp.zeros((B, 1, WC), jnp.float32), cs], axis=1)
    pos = start + jnp.arange(S)
    means = []
    for g, w in enumerate(POOL_WINDOWS):
        cg = cs[..., g * POOL_GC:(g + 1) * POOL_GC]
        hi = cg[:, POOL_HIST + 1:POOL_HIST + 1 + S]
        lo = cg[:, POOL_HIST + 1 - w:POOL_HIST + 1 - w + S]
        cnt = jnp.minimum(pos + 1, w).astype(jnp.float32)[None, :, None]
        means.append((hi - lo) / cnt)
    mean = jnp.concatenate(means, axis=-1)
    d = (mean - c.astype(jnp.float32)).astype(c.dtype).reshape(B, S, POOL_GROUPS, POOL_GC)
    y = jnp.einsum('bsgc,gcd->bsgd', d, w_lin).reshape(B, S, WC) * scale
    return y @ w_out, full[:, -POOL_HIST:]


def layer(x, p, conv_hist, pool_hist, start, prm):
    h = x + 0.5 * swiglu(rmsnorm(x, prm['ffn1_norm']), prm['ffn1_w_gate'], prm['ffn1_w_up'], prm['ffn1_w_down'])
    n = rmsnorm(h, prm['mix_norm'])
    z = n @ prm['w_in']
    a, b, u, v, c, gl = jnp.split(z, [WA, 2 * WA, 2 * WA + WB, 2 * WA + 2 * WB, 2 * WA + 2 * WB + WC], axis=-1)
    gates = jax.nn.sigmoid(gl + prm['gate_b'])
    g_a, g_b, g_c = jnp.split(gates, N_BRANCH, axis=-1)
    y_a, conv_state = conv_module(a, b, conv_hist, prm['conv_dw_w'], prm['conv_dw_b'],
                                  prm['conv_ln_g'], prm['conv_ln_b'], prm['conv_w_out'])
    vn = layernorm(v, prm['sgu_ln_g'], prm['sgu_ln_b'])
    y_b = spatial_gating(u, vn, prm['sgu_w_s'], prm['sgu_b_s']) @ prm['sgu_w_out']
    y_c, pool_state = pool_mixer(c, pool_hist, start, prm['pool_w'], prm['pool_scale'], prm['pool_w_out'])
    h = h + (g_a * y_a + g_b * y_b + g_c * y_c) @ prm['w_out']
    h = h + 0.5 * swiglu(rmsnorm(h, prm['ffn2_norm']), prm['ffn2_w_gate'], prm['ffn2_w_up'], prm['ffn2_w_down'])
    h = h + jax.nn.sigmoid(rmsnorm(h, prm['pe_norm']) @ prm['pe_w_gate']) * (p @ prm['pe_w_proj'])
    S = x.shape[1]
    cur = ((S - 1) // SGU_CHUNK) * SGU_CHUNK
    return h, conv_state, pool_state, vn[:, cur:]


def setup_inputs(seed: int = 0) -> dict:
    key = jax.random.key(seed)
    ks = iter(jax.random.split(key, 48))
    L = DEPTH

    def nrm(shape, scale):
        return jax.random.normal(next(ks), shape, jnp.float32) * scale

    def gain(shape):
        return 1.0 + nrm(shape, 0.02)

    return {
        "x_prompt": nrm((BATCH, SEQ, D_MODEL), 1.0),
        "x_sample": nrm((DEC_BATCH, DEC_SEQ, D_MODEL), 1.0),
        "p_prompt": nrm((DEPTH, BATCH, SEQ, D_PLE), 1.0),
        "p_sample": nrm((DEPTH, DEC_BATCH, DEC_SEQ, D_PLE), 1.0),
        "cache_conv": nrm((DEPTH, DEC_BATCH, CONV_HIST, WA), 0.5),
        "cache_pool": nrm((DEPTH, DEC_BATCH, POOL_HIST, WC), 1.0),
        "ffn1_norm": gain((L, D_MODEL)),
        "ffn1_w_gate": nrm((L, D_MODEL, D_FF), D_MODEL ** -0.5),
        "ffn1_w_up": nrm((L, D_MODEL, D_FF), D_MODEL ** -0.5),
        "ffn1_w_down": nrm((L, D_FF, D_MODEL), D_FF ** -0.5),
        "mix_norm": gain((L, D_MODEL)),
        "w_in": nrm((L, D_MODEL, D_IN), D_MODEL ** -0.5),
        "gate_b": nrm((L, N_BRANCH * D_MODEL), 0.1),
        "conv_dw_w": nrm((L, CONV_W, WA), CONV_W ** -0.5),
        "conv_dw_b": nrm((L, WA), 0.02),
        "conv_ln_g": gain((L, WA)),
        "conv_ln_b": nrm((L, WA), 0.02),
        "conv_w_out": nrm((L, WA, D_MODEL), WA ** -0.5),
        "sgu_ln_g": gain((L, WB)),
        "sgu_ln_b": nrm((L, WB), 0.02),
        "sgu_w_s": nrm((L, SGU_GROUPS, SGU_CHUNK, SGU_CHUNK), SGU_CHUNK ** -0.5),
        "sgu_b_s": gain((L, SGU_GROUPS, SGU_CHUNK)),
        "sgu_w_out": nrm((L, WB, D_MODEL), WB ** -0.5),
        "pool_w": nrm((L, POOL_GROUPS, POOL_GC, POOL_GC), POOL_GC ** -0.5),
        "pool_scale": gain((L, WC)),
        "pool_w_out": nrm((L, WC, D_MODEL), WC ** -0.5),
        "w_out": nrm((L, D_MODEL, D_MODEL), D_MODEL ** -0.5),
        "ffn2_norm": gain((L, D_MODEL)),
        "ffn2_w_gate": nrm((L, D_MODEL, D_FF), D_MODEL ** -0.5),
        "ffn2_w_up": nrm((L, D_MODEL, D_FF), D_MODEL ** -0.5),
        "ffn2_w_down": nrm((L, D_FF, D_MODEL), D_FF ** -0.5),
        "pe_norm": gain((L, D_MODEL)),
        "pe_w_gate": nrm((L, D_MODEL, D_MODEL), D_MODEL ** -0.5),
        "pe_w_proj": nrm((L, D_PLE, D_MODEL), D_PLE ** -0.5),
        "final_norm": gain((D_MODEL,)),
    }


def reference(x_prompt, x_sample, p_prompt, p_sample, cache_conv, cache_pool,
              ffn1_norm, ffn1_w_gate, ffn1_w_up, ffn1_w_down, mix_norm, w_in, gate_b,
              conv_dw_w, conv_dw_b, conv_ln_g, conv_ln_b, conv_w_out,
              sgu_ln_g, sgu_ln_b, sgu_w_s, sgu_b_s, sgu_w_out,
              pool_w, pool_scale, pool_w_out, w_out,
              ffn2_norm, ffn2_w_gate, ffn2_w_up, ffn2_w_down,
              pe_norm, pe_w_gate, pe_w_proj, final_norm):
    bp = x_prompt.shape[0]
    conv_zero = jnp.zeros((bp, CONV_HIST, WA), x_prompt.dtype)
    pool_zero = jnp.zeros((bp, POOL_HIST, WC), x_prompt.dtype)
    hp, hs = x_prompt, x_sample
    conv_p, conv_s, pool_p, pool_s, v_p, v_s = [], [], [], [], [], []
    for i in range(DEPTH):
        prm = {
            'ffn1_norm': ffn1_norm[i], 'ffn1_w_gate': ffn1_w_gate[i], 'ffn1_w_up': ffn1_w_up[i],
            'ffn1_w_down': ffn1_w_down[i], 'mix_norm': mix_norm[i], 'w_in': w_in[i], 'gate_b': gate_b[i],
            'conv_dw_w': conv_dw_w[i], 'conv_dw_b': conv_dw_b[i], 'conv_ln_g': conv_ln_g[i],
            'conv_ln_b': conv_ln_b[i], 'conv_w_out': conv_w_out[i],
            'sgu_ln_g': sgu_ln_g[i], 'sgu_ln_b': sgu_ln_b[i], 'sgu_w_s': sgu_w_s[i], 'sgu_b_s': sgu_b_s[i],
            'sgu_w_out': sgu_w_out[i], 'pool_w': pool_w[i], 'pool_scale': pool_scale[i],
            'pool_w_out': pool_w_out[i], 'w_out': w_out[i],
            'ffn2_norm': ffn2_norm[i], 'ffn2_w_gate': ffn2_w_gate[i], 'ffn2_w_up': ffn2_w_up[i],
            'ffn2_w_down': ffn2_w_down[i], 'pe_norm': pe_norm[i], 'pe_w_gate': pe_w_gate[i],
            'pe_w_proj': pe_w_proj[i],
        }
        hp, cp, pp, vp = layer(hp, p_prompt[i], conv_zero, pool_zero, 0, prm)
        hs, cs, ps, vs = layer(hs, p_sample[i], cache_conv[i], cache_pool[i], PAST_LEN, prm)
        conv_p.append(cp); conv_s.append(cs); pool_p.append(pp); pool_s.append(ps)
        v_p.append(vp); v_s.append(vs)
    y_prompt = rmsnorm(hp, final_norm)
    y_sample = rmsnorm(hs, final_norm)
    return (y_prompt, y_sample, jnp.stack(conv_p), jnp.stack(conv_s), jnp.stack(pool_p),
            jnp.stack(pool_s), jnp.stack(v_p), jnp.stack(v_s))
```

```cpp
#include <hip/hip_runtime.h>
#include <hip/hip_cooperative_groups.h>
#include <cstdio>
#include <cstdint>
namespace cg = cooperative_groups;

#ifndef MK_N_LAUNCHES
#define MK_N_LAUNCHES 1
#endif
#ifndef G_SP2
#define G_SP2 true
#endif
#ifndef G_ALIGN
#define G_ALIGN true
#endif

#define LAS __attribute__((address_space(3)))
typedef unsigned short bf16_t;
typedef short bf16x8 __attribute__((ext_vector_type(8)));
typedef float f32x4 __attribute__((ext_vector_type(4)));
typedef unsigned u32x4 __attribute__((ext_vector_type(4)));
typedef unsigned u32x2 __attribute__((ext_vector_type(2)));

constexpr int D = 1024, FF = 2816, MP = 16384, MS = 2048, M = MP + MS, SEQ = 8192, DSEQ = 64, DPLE = 256;
constexpr int NLAYER = 2;
constexpr float EPS = 1e-6f;
constexpr int ZMW = 2048, ZGW = 3072, XW = 512;
constexpr size_t O_Y = 0, O_CONVP = (size_t)M * D, O_CONVS = O_CONVP + 2 * 2 * 30 * 512, O_POOLP = O_CONVS + 2 * 32 * 30 * 512,
                 O_POOLS = O_POOLP + 2 * 2 * 15 * 512, O_VP = O_POOLS + 2 * 32 * 15 * 512, O_VS = O_VP + 2 * 2 * 128 * 512, O_END = O_VS + 2 * 32 * 64 * 512;
constexpr size_t MiB = 1u << 20;
constexpr size_t WS_W = 1 * MiB, WS_PB = 54 * MiB, WS_NB = 63 * MiB, WS_BIG = 99 * MiB, WS_X = 207 * MiB, WS_END = 279 * MiB;
constexpr size_t W_GU1 = 0, W_D1 = W_GU1 + (size_t)5632 * 1024, W_IM = W_D1 + (size_t)1024 * 2816, W_IG = W_IM + (size_t)2560 * 1024,
                 W_CA = W_IG + (size_t)3072 * 1024, W_SB = W_CA + 524288, W_PC = W_SB + 524288, W_PBD = W_PC + 524288, W_O = W_PBD + 262144,
                 W_GU2 = W_O + 1048576, W_D2 = W_GU2 + (size_t)5632 * 1024, W_PG = W_D2 + (size_t)1024 * 2816, W_PE = W_PG + 1048576,
                 W_WS = W_PE + 262144, W_TOTAL = W_WS + 65536;
static_assert(W_TOTAL * 2 <= 53 * MiB, "weight region");
constexpr int LDS_BYTES = 147456;

typedef __bf16 bf16x2_t __attribute__((ext_vector_type(2)));
__device__ __forceinline__ unsigned cvt_pk_bf16(float lo, float hi) { bf16x2_t v; v[0] = (__bf16)lo; v[1] = (__bf16)hi; return __builtin_bit_cast(unsigned, v); }
__device__ __forceinline__ bf16_t f2bf(float f) { return (bf16_t)(cvt_pk_bf16(f, 0.f) & 0xffffu); }
__device__ __forceinline__ float bf2f(bf16_t b) { return __uint_as_float(((unsigned)b) << 16); }
__device__ __forceinline__ float bflo(unsigned w) { return __uint_as_float(w << 16); }
__device__ __forceinline__ float bfhi(unsigned w) { return __uint_as_float(w & 0xffff0000u); }
__device__ __forceinline__ float sigmoidf_(float x) { return __builtin_amdgcn_rcpf(1.0f + __builtin_amdgcn_exp2f(-1.4426950408889634f * x)); }
__device__ __forceinline__ float wave_sum(float v) {
#pragma unroll
    for (int o = 32; o > 0; o >>= 1) v += __shfl_xor(v, o);
    return v;
}
__device__ __forceinline__ void unpack8(const u32x4 w, float (&x)[8]) {
    x[0] = bflo(w.x); x[1] = bfhi(w.x); x[2] = bflo(w.y); x[3] = bfhi(w.y); x[4] = bflo(w.z); x[5] = bfhi(w.z); x[6] = bflo(w.w); x[7] = bfhi(w.w);
}
__device__ __forceinline__ u32x4 pack8(const float (&x)[8]) {
    u32x4 w; w.x = cvt_pk_bf16(x[0], x[1]); w.y = cvt_pk_bf16(x[2], x[3]); w.z = cvt_pk_bf16(x[4], x[5]); w.w = cvt_pk_bf16(x[6], x[7]); return w;
}

namespace pg8 {
constexpr int BM = 256, BK = 64, HALF = 128, HTB = HALF * BK * 2, STAGE_BYTES = 8 * HTB, NXCD = 8, WGM = 8;
__device__ __forceinline__ int lds_byte(int r, int c) { const int st = (r >> 4) * 2 + (c >> 5), rr = r & 15, cc = c & 31, ob = rr * 64 + cc * 2; return st * 1024 + (ob ^ (((ob >> 9) & 1) << 5)); }
__device__ __forceinline__ void stage_rc(int b, int& R, int& C) { const int st = b / 1024, sb = b % 1024, swz = sb ^ (((sb >> 9) & 1) << 5); R = (st >> 1) * 16 + swz / 64; C = (st & 1) * 32 + (swz % 64) / 2; }
__device__ __forceinline__ int perm32(int rho) { const int n = rho >> 4, i = rho & 15; return 8 * (i >> 2) + 4 * n + (i & 3); }

struct Unit { int pm, pn, pass; };
struct Gemm { const bf16_t* A0; const bf16_t* A1; const bf16_t* A2; const bf16_t* B0; const bf16_t* B1; const bf16_t* B2; int K; };
struct Sched {
    int nM, nN, nwg, G, c, npass;
    __device__ void init(int M_, int N_, int G_, int c_, int npass_) { nM = M_ / BM; nN = N_ / BM; nwg = nM * nN; G = G_; c = c_; npass = npass_; }
    __device__ bool next(int i, Unit& u) const {
        const int ti = i / npass; u.pass = i - ti * npass;
        const long L = (long)ti * G + c; if (L >= nwg) return false;
        int wgid = (int)L; { const int q = nwg / NXCD, r = nwg % NXCD, xcd = wgid % NXCD, off = wgid / NXCD; wgid = (xcd < r ? xcd * (q + 1) : r * (q + 1) + (xcd - r) * q) + off; }
        const int nig = WGM * nN, gid = wgid / nig, fm = gid * WGM, gsz = (nM - fm) < WGM ? (nM - fm) : WGM;
        u.pm = fm + ((wgid % nig) % gsz); u.pn = (wgid % nig) / gsz; return true;
    }
};
template <class Epi, bool ALIGN_EPI, bool SP2>
__device__ __forceinline__ void gemm_phase(LAS unsigned char* lds, int tid_in, const Gemm g, const Sched& S, const Epi& E) {
    int tid_ = tid_in; asm volatile("" : "+v"(tid_));
    const int tid = tid_, wid = __builtin_amdgcn_readfirstlane(tid >> 6), lane = tid & 63, wr = wid >> 2, wc = wid & 3, fr = lane & 15, fq = lane >> 4;
    const int K = g.K, nt = K / BK;
    unsigned voffA[2], voffB[2];
#pragma unroll
    for (int i = 0; i < 2; ++i) { int R, C; stage_rc(tid * 16 + i * 8192, R, C); const int Rb = (R & ~31) + perm32(R & 31);
        voffA[i] = (unsigned)(R * K + C) * 2u; voffB[i] = (unsigned)(Rb * K + C) * 2u; }
    const size_t kstep = (size_t)(BK * 2);
    const size_t hstep = (size_t)HALF * K * 2;
    const size_t tstep = 2 * hstep;
    const unsigned ldsw = (unsigned)wid * 1024u;
    const int aoff = lds_byte(wr * 64 + fr, fq * 8), boff = lds_byte(wc * 32 + fr, fq * 8);
#define PG8_SA(b, h) (((b) * 2 + (h)) * HTB)
#define PG8_SB(b, h) ((4 + (b) * 2 + (h)) * HTB)
#define PG8_STAGE(bufoff, gbase, voff) do { _Pragma("unroll") for (int _i = 0; _i < 2; ++_i) \
        __builtin_amdgcn_global_load_lds((const unsigned*)((const char*)(gbase) + (voff)[_i]), (LAS unsigned*)(lds + (bufoff) + ldsw + _i * 8192), 16, 0, 0); } while (0)
#define PG8_LDA(dst, b, h) do { _Pragma("unroll") for (int m = 0; m < 4; ++m) _Pragma("unroll") for (int k = 0; k < 2; ++k) dst[m][k] = *(const LAS bf16x8*)(lds + PG8_SA(b, h) + aoff + m * 2048 + k * 1024); } while (0)
#define PG8_LDB(dst, b, h) do { _Pragma("unroll") for (int n = 0; n < 2; ++n) _Pragma("unroll") for (int k = 0; k < 2; ++k) dst[n][k] = *(const LAS bf16x8*)(lds + PG8_SB(b, h) + boff + n * 2048 + k * 1024); } while (0)
#define PG8_MMA(ai, bj, At, Bt) do { __builtin_amdgcn_s_setprio(1); _Pragma("unroll") for (int m = 0; m < 4; ++m) _Pragma("unroll") for (int n = 0; n < 2; ++n) _Pragma("unroll") for (int k = 0; k < 2; ++k) \
        acc[ai][bj][m][n] = __builtin_amdgcn_mfma_f32_16x16x32_bf16(Bt[n][k], At[m][k], acc[ai][bj][m][n], 0, 0, 0); __builtin_amdgcn_s_setprio(0); } while (0)
#define PG8_WAIT_V(n) asm volatile("s_waitcnt vmcnt(" #n ")" ::: "memory")
#define PG8_WAIT_L(n) asm volatile("s_waitcnt lgkmcnt(" #n ")" ::: "memory")
#define PG8_BAR __builtin_amdgcn_s_barrier()
#define PG8_SCHED __builtin_amdgcn_sched_barrier(0)
#define PG8_ABASE(u) ((const char*)((u).pass == 0 ? g.A0 : ((u).pass == 1 ? g.A1 : g.A2)))
#define PG8_BBASE(u) ((const char*)((u).pass == 0 ? g.B0 : ((u).pass == 1 ? g.B1 : g.B2)))
    Unit cur, nxt; int ui = 0;
    if (!S.next(0, cur)) return;
    f32x4 acc[2][2][4][2];
#pragma unroll
    for (int a = 0; a < 2; ++a)
#pragma unroll
        for (int b = 0; b < 2; ++b)
#pragma unroll
            for (int m = 0; m < 4; ++m)
#pragma unroll
                for (int n = 0; n < 2; ++n) acc[a][b][m][n] = (f32x4){0.f, 0.f, 0.f, 0.f};
    bf16x8 At[4][2], B0[2][2], B1[2][2];
    const char* cA = PG8_ABASE(cur) + (size_t)cur.pm * tstep; const char* cB = PG8_BBASE(cur) + (size_t)cur.pn * tstep;
    if constexpr (SP2) {
        PG8_STAGE(PG8_SB(0, 0), cB, voffB); PG8_STAGE(PG8_SB(0, 1), cB + hstep, voffB); PG8_STAGE(PG8_SA(0, 0), cA, voffA); PG8_STAGE(PG8_SA(0, 1), cA + hstep, voffA);
        if (wr == 1) PG8_BAR;
        PG8_WAIT_V(2); PG8_BAR;
        PG8_STAGE(PG8_SB(1, 0), cB + kstep, voffB); PG8_STAGE(PG8_SA(1, 0), cA + kstep, voffA); PG8_STAGE(PG8_SB(1, 1), cB + hstep + kstep, voffB);
        PG8_WAIT_V(6); PG8_BAR;
    } else {
        PG8_STAGE(PG8_SB(0, 0), cB, voffB); PG8_STAGE(PG8_SA(0, 0), cA, voffA); PG8_STAGE(PG8_SB(0, 1), cB + hstep, voffB); PG8_STAGE(PG8_SA(0, 1), cA + hstep, voffA);
        if (wr == 1) PG8_BAR;
        PG8_WAIT_V(4); PG8_BAR;
        PG8_STAGE(PG8_SB(1, 0), cB + kstep, voffB); PG8_STAGE(PG8_SA(1, 0), cA + kstep, voffA); PG8_STAGE(PG8_SB(1, 1), cB + hstep + kstep, voffB);
        PG8_WAIT_V(6); PG8_BAR;
    }
    for (;;) {
        const bool has_next = S.next(ui + 1, nxt);
        const char* nA = has_next ? PG8_ABASE(nxt) + (size_t)nxt.pm * tstep : cA; const char* nB = has_next ? PG8_BBASE(nxt) + (size_t)nxt.pn * tstep : cB;
        for (int t = 0; t < nt; t += 2) {
            const bool last = (t == nt - 2);
            const char* a1 = cA + (size_t)(t + 1) * kstep;
            const char* a2 = last ? nA : cA + (size_t)(t + 2) * kstep; const char* b2 = last ? nB : cB + (size_t)(t + 2) * kstep;
            const char* a3 = a2 + kstep; const char* b3 = b2 + kstep;
            if constexpr (SP2) {
            PG8_LDB(B0, 0, 0); PG8_LDB(B1, 0, 1); PG8_SCHED; PG8_LDA(At, 0, 0); PG8_STAGE(PG8_SA(1, 1), a1 + hstep, voffA);
            PG8_WAIT_V(8); PG8_WAIT_L(0); PG8_BAR; PG8_MMA(0, 0, At, B0); PG8_MMA(0, 1, At, B1); PG8_BAR; PG8_SCHED;
            PG8_LDA(At, 0, 1); PG8_STAGE(PG8_SB(0, 0), b2, voffB); PG8_STAGE(PG8_SB(0, 1), b2 + hstep, voffB); PG8_STAGE(PG8_SA(0, 0), a2, voffA);
            PG8_WAIT_V(8); PG8_WAIT_L(0); PG8_BAR; PG8_MMA(1, 0, At, B0); PG8_MMA(1, 1, At, B1); PG8_BAR; PG8_SCHED;
            PG8_LDB(B0, 1, 0); PG8_LDB(B1, 1, 1); PG8_SCHED; PG8_LDA(At, 1, 0); PG8_STAGE(PG8_SA(0, 1), a2 + hstep, voffA);
            PG8_WAIT_V(8); PG8_WAIT_L(0); PG8_BAR; PG8_MMA(0, 0, At, B0); PG8_MMA(0, 1, At, B1); PG8_BAR; PG8_SCHED;
            PG8_LDA(At, 1, 1); PG8_STAGE(PG8_SB(1, 0), b3, voffB); PG8_STAGE(PG8_SB(1, 1), b3 + hstep, voffB); PG8_STAGE(PG8_SA(1, 0), a3, voffA);
            PG8_WAIT_V(8); PG8_WAIT_L(0); PG8_BAR; PG8_MMA(1, 0, At, B0); PG8_MMA(1, 1, At, B1); PG8_BAR; PG8_SCHED;
            } else {
            PG8_LDB(B0, 0, 0); PG8_SCHED; PG8_LDA(At, 0, 0); PG8_STAGE(PG8_SA(1, 1), a1 + hstep, voffA);
            PG8_WAIT_L(8); PG8_BAR; PG8_WAIT_L(0); PG8_MMA(0, 0, At, B0); PG8_BAR; PG8_SCHED;
            PG8_LDB(B1, 0, 1); PG8_STAGE(PG8_SB(0, 0), b2, voffB);
            PG8_BAR; PG8_WAIT_L(0); PG8_MMA(0, 1, At, B1); PG8_BAR;
            PG8_LDA(At, 0, 1); PG8_STAGE(PG8_SA(0, 0), a2, voffA);
            PG8_BAR; PG8_WAIT_L(0); PG8_MMA(1, 0, At, B0); PG8_BAR; PG8_SCHED;
            PG8_STAGE(PG8_SB(0, 1), b2 + hstep, voffB);
            PG8_WAIT_V(6); PG8_BAR; PG8_MMA(1, 1, At, B1); PG8_BAR;
            PG8_LDB(B0, 1, 0); PG8_SCHED; PG8_LDA(At, 1, 0); PG8_STAGE(PG8_SA(0, 1), a2 + hstep, voffA);
            PG8_WAIT_L(8); PG8_BAR; PG8_WAIT_L(0); PG8_MMA(0, 0, At, B0); PG8_BAR; PG8_SCHED;
            PG8_LDB(B1, 1, 1); PG8_STAGE(PG8_SB(1, 0), b3, voffB);
            PG8_BAR; PG8_WAIT_L(0); PG8_MMA(0, 1, At, B1); PG8_BAR;
            PG8_LDA(At, 1, 1); PG8_STAGE(PG8_SA(1, 0), a3, voffA);
            PG8_BAR; PG8_WAIT_L(0); PG8_MMA(1, 0, At, B0); PG8_BAR; PG8_SCHED;
            PG8_STAGE(PG8_SB(1, 1), b3 + hstep, voffB);
            PG8_WAIT_V(6); PG8_BAR; PG8_MMA(1, 1, At, B1); PG8_BAR;
            }
        }
        if constexpr (ALIGN_EPI) { if (wr == 0) PG8_BAR; }
        E(acc, cur, wr, wc, fr, fq);
        if (!has_next) break;
        if (nxt.pass == 0) {
#pragma unroll
        for (int a = 0; a < 2; ++a)
#pragma unroll
            for (int b = 0; b < 2; ++b)
#pragma unroll
                for (int m = 0; m < 4; ++m)
#pragma unroll
                    for (int n = 0; n < 2; ++n) acc[a][b][m][n] = (f32x4){0.f, 0.f, 0.f, 0.f};
        }
        cur = nxt; cA = nA; cB = nB; ++ui;
        if constexpr (ALIGN_EPI) { if (wr == 1) PG8_BAR; }
    }
    PG8_WAIT_V(0);
    if constexpr (!ALIGN_EPI) { if (wr == 0) PG8_BAR; }
    PG8_BAR;
#undef PG8_SA
#undef PG8_SB
#undef PG8_STAGE
#undef PG8_LDA
#undef PG8_LDB
#undef PG8_MMA
#undef PG8_WAIT_V
#undef PG8_WAIT_L
#undef PG8_BAR
#undef PG8_SCHED
#undef PG8_ABASE
#undef PG8_BBASE
}

typedef f32x4 (&AccRef)[2][2][4][2];
#define EPI_ROW(u, ai, m) ((u).pm * BM + (ai) * HALF + wr * 64 + (m) * 16 + fr)
#define EPI_COLW (wc * 32 + fq * 8)

struct EpiGU {
    bf16_t* O; int ldo;
    __device__ __forceinline__ void operator()(AccRef acc, const Unit& u, int wr, int wc, int fr, int fq) const {
#pragma unroll
        for (int ai = 0; ai < 2; ++ai)
#pragma unroll
            for (int m = 0; m < 4; ++m) {
                bf16_t* p = O + (size_t)EPI_ROW(u, ai, m) * ldo + u.pn * 128 + EPI_COLW;
                float h[8];
#pragma unroll
                for (int n = 0; n < 2; ++n)
#pragma unroll
                    for (int j = 0; j < 4; ++j) { const float gt = acc[ai][0][m][n][j], up = acc[ai][1][m][n][j]; h[n * 4 + j] = gt * sigmoidf_(gt) * up; }
                *(u32x4*)p = pack8(h);
            }
    }
};
struct EpiWinMix {
    bf16_t* Z;
    __device__ __forceinline__ void operator()(AccRef acc, const Unit& u, int wr, int wc, int fr, int fq) const {
        if (u.pn < 4) {
#pragma unroll
            for (int ai = 0; ai < 2; ++ai)
#pragma unroll
                for (int m = 0; m < 4; ++m) {
                    bf16_t* p = Z + (size_t)EPI_ROW(u, ai, m) * ZMW + u.pn * 128 + EPI_COLW;
                    float h[8];
#pragma unroll
                    for (int n = 0; n < 2; ++n)
#pragma unroll
                        for (int j = 0; j < 4; ++j) h[n * 4 + j] = acc[ai][0][m][n][j] * sigmoidf_(acc[ai][1][m][n][j]);
                    *(u32x4*)p = pack8(h);
                }
        } else {
#pragma unroll
            for (int ai = 0; ai < 2; ++ai)
#pragma unroll
                for (int m = 0; m < 4; ++m) {
                    bf16_t* p = Z + (size_t)EPI_ROW(u, ai, m) * ZMW + 512 + (u.pn - 4) * 256 + EPI_COLW;
#pragma unroll
                    for (int bj = 0; bj < 2; ++bj) {
                        float h[8];
#pragma unroll
                        for (int n = 0; n < 2; ++n)
#pragma unroll
                            for (int j = 0; j < 4; ++j) h[n * 4 + j] = acc[ai][bj][m][n][j];
                        *(u32x4*)(p + bj * HALF) = pack8(h);
                    }
                }
        }
    }
};
struct EpiGates {
    bf16_t* Z; const float* bias;
    __device__ __forceinline__ void operator()(AccRef acc, const Unit& u, int wr, int wc, int fr, int fq) const {
        const int col0 = u.pn * 256 + EPI_COLW;
        f32x4 bv[2][2];
#pragma unroll
        for (int bj = 0; bj < 2; ++bj)
#pragma unroll
            for (int n = 0; n < 2; ++n) bv[bj][n] = *(const f32x4*)(bias + col0 + bj * HALF + n * 4);
#pragma unroll
        for (int ai = 0; ai < 2; ++ai)
#pragma unroll
            for (int m = 0; m < 4; ++m) {
                bf16_t* p = Z + (size_t)EPI_ROW(u, ai, m) * ZGW + col0;
#pragma unroll
                for (int bj = 0; bj < 2; ++bj) {
                    float h[8];
#pragma unroll
                    for (int n = 0; n < 2; ++n)
#pragma unroll
                        for (int j = 0; j < 4; ++j) h[n * 4 + j] = sigmoidf_(acc[ai][bj][m][n][j] + bv[bj][n][j]);
                    *(u32x4*)(p + bj * HALF) = pack8(h);
                }
            }
    }
};
struct EpiScale {
    bf16_t* O; int ldo; const float* scale;
    __device__ __forceinline__ void operator()(AccRef acc, const Unit& u, int wr, int wc, int fr, int fq) const {
        const int col0 = u.pn * 256 + EPI_COLW;
        f32x4 bv[2][2];
#pragma unroll
        for (int bj = 0; bj < 2; ++bj)
#pragma unroll
            for (int n = 0; n < 2; ++n) bv[bj][n] = *(const f32x4*)(scale + col0 + bj * HALF + n * 4);
#pragma unroll
        for (int ai = 0; ai < 2; ++ai)
#pragma unroll
            for (int m = 0; m < 4; ++m) {
                bf16_t* p = O + (size_t)EPI_ROW(u, ai, m) * ldo + col0;
#pragma unroll
                for (int bj = 0; bj < 2; ++bj) {
                    float h[8];
#pragma unroll
                    for (int n = 0; n < 2; ++n)
#pragma unroll
                        for (int j = 0; j < 4; ++j) h[n * 4 + j] = acc[ai][bj][m][n][j] * bv[bj][n][j];
                    *(u32x4*)(p + bj * HALF) = pack8(h);
                }
            }
    }
};
struct EpiRes {
    float* H; float s;
    __device__ __forceinline__ void operator()(AccRef acc, const Unit& u, int wr, int wc, int fr, int fq) const {
        const int col0 = u.pn * 256 + EPI_COLW;
#pragma unroll
        for (int ai = 0; ai < 2; ++ai)
#pragma unroll
            for (int m = 0; m < 4; ++m) {
                float* p = H + (size_t)EPI_ROW(u, ai, m) * D + col0;
#pragma unroll
                for (int bj = 0; bj < 2; ++bj)
#pragma unroll
                    for (int n = 0; n < 2; ++n) { f32x4* q = (f32x4*)(p + bj * HALF + n * 4); f32x4 v = *q; v += acc[ai][bj][m][n] * s; *q = v; }
            }
    }
};
struct EpiT {
    float* T;
    __device__ __forceinline__ void operator()(AccRef acc, const Unit& u, int wr, int wc, int fr, int fq) const {
        const int col0 = u.pn * 256 + EPI_COLW;
#pragma unroll
        for (int ai = 0; ai < 2; ++ai)
#pragma unroll
            for (int m = 0; m < 4; ++m) {
                float* p = T + (size_t)EPI_ROW(u, ai, m) * D + col0;
#pragma unroll
                for (int bj = 0; bj < 2; ++bj)
#pragma unroll
                    for (int n = 0; n < 2; ++n) *(f32x4*)(p + bj * HALF + n * 4) = acc[ai][bj][m][n];
            }
    }
};
struct EpiPE {
    float* H; const float* T;
    __device__ __forceinline__ void operator()(AccRef acc, const Unit& u, int wr, int wc, int fr, int fq) const {
        const int col0 = u.pn * 256 + EPI_COLW;
#pragma unroll
        for (int ai = 0; ai < 2; ++ai)
#pragma unroll
            for (int m = 0; m < 4; ++m) {
                const size_t off = (size_t)EPI_ROW(u, ai, m) * D + col0;
#pragma unroll
                for (int bj = 0; bj < 2; ++bj)
#pragma unroll
                    for (int n = 0; n < 2; ++n) {
                        f32x4* q = (f32x4*)(H + off + bj * HALF + n * 4); const f32x4 t = *(const f32x4*)(T + off + bj * HALF + n * 4); f32x4 v = *q;
#pragma unroll
                        for (int j = 0; j < 4; ++j) v[j] += sigmoidf_(acc[ai][bj][m][n][j]) * t[j];
                        *q = v;
                    }
            }
    }
};
struct EpiMerge {
    const bf16_t* ZG; bf16_t* O;
    __device__ __forceinline__ void operator()(AccRef acc, const Unit& u, int wr, int wc, int fr, int fq) const {
        const int col0 = u.pn * 256 + EPI_COLW;
#pragma unroll
        for (int ai = 0; ai < 2; ++ai)
#pragma unroll
            for (int m = 0; m < 4; ++m) {
                const size_t row = (size_t)EPI_ROW(u, ai, m);
                const bf16_t* gp = ZG + row * ZGW + u.pass * 1024 + col0;
#pragma unroll
                for (int bj = 0; bj < 2; ++bj) {
                    float g0[8], f[8];
                    unpack8(*(const u32x4*)(gp + bj * HALF), g0);
                    if (u.pass < 2) {
                        float g1[8]; unpack8(*(const u32x4*)(gp + 1024 + bj * HALF), g1);
#pragma unroll
                        for (int e = 0; e < 8; ++e) f[e] = fmaxf(g0[e], 1e-30f) * __builtin_amdgcn_rcpf(fmaxf(g1[e], 1e-30f));
                    } else {
#pragma unroll
                        for (int e = 0; e < 8; ++e) f[e] = fmaxf(g0[e], 1e-30f);
                    }
#pragma unroll
                    for (int n = 0; n < 2; ++n)
#pragma unroll
                        for (int j = 0; j < 4; ++j) acc[ai][bj][m][n][j] *= f[n * 4 + j];
                    if (u.pass == 2) {
                        float h[8];
#pragma unroll
                        for (int n = 0; n < 2; ++n)
#pragma unroll
                            for (int j = 0; j < 4; ++j) h[n * 4 + j] = acc[ai][bj][m][n][j];
                        *(u32x4*)(O + row * D + col0 + bj * HALF) = pack8(h);
                    }
                }
            }
    }
};
}

struct Args { const float* in[35]; float* out; unsigned char* ws; int ph_lo, ph_hi; };
static_assert(sizeof(Args) == 35 * 8 + 8 + 8 + 8, "Args has no padding");

typedef const Args __attribute__((address_space(4)))* ArgsP;
__device__ __forceinline__ ArgsP get_args() { ArgsP p = (ArgsP)__builtin_amdgcn_kernarg_segment_ptr(); asm volatile("" : "+s"(p)); return p; }
struct Ctx {
    LAS unsigned char* lds;
    int tid, lane, wave, gw, nW;
    float* H; bf16_t* W; bf16_t* PB; bf16_t* NB; unsigned char* BIG; bf16_t* XA; bf16_t* XB; bf16_t* XD; bf16_t* XC;
};

__device__ __forceinline__ const float* x_row(ArgsP a, int r) { return r < MP ? a->in[0] + (size_t)r * D : a->in[1] + (size_t)(r - MP) * D; }
__device__ __forceinline__ const float* p_row(const float* pp, const float* ps, int L, int r) { return r < MP ? pp + ((size_t)L * MP + r) * DPLE : ps + ((size_t)L * MS + (r - MP)) * DPLE; }

template <int MODE>
__device__ __forceinline__ void norm_phase(const Ctx& c, const float* gain) {
    const int lane = c.lane;
    ArgsP ap = get_args();
    f32x4 gv[4];
#pragma unroll
    for (int i = 0; i < 4; ++i) gv[i] = *(const f32x4*)(gain + i * 256 + lane * 4);
    for (int r = c.gw; r < M; r += c.nW) {
        const float* src = (MODE == 0) ? x_row(ap, r) : c.H + (size_t)r * D;
        f32x4 v[4]; float ss = 0.f;
#pragma unroll
        for (int i = 0; i < 4; ++i) { v[i] = *(const f32x4*)(src + i * 256 + lane * 4); ss += v[i][0] * v[i][0] + v[i][1] * v[i][1] + v[i][2] * v[i][2] + v[i][3] * v[i][3]; }
        ss = wave_sum(ss);
        const float rs = __builtin_amdgcn_rsqf(ss * (1.0f / D) + EPS);
#pragma unroll
        for (int i = 0; i < 4; ++i) {
            if (MODE == 0) *(f32x4*)(c.H + (size_t)r * D + i * 256 + lane * 4) = v[i];
            const f32x4 y = v[i] * rs * gv[i];
            if (MODE == 2) *(f32x4*)(c.H + (size_t)r * D + i * 256 + lane * 4) = y;
            else { u32x2 w; w.x = cvt_pk_bf16(y[0], y[1]); w.y = cvt_pk_bf16(y[2], y[3]); *(u32x2*)(c.NB + (size_t)r * D + i * 256 + lane * 4) = w; }
        }
    }
}

__device__ __forceinline__ void prep_phase(const Ctx& c, int L) {
    ArgsP a = get_args();
    LAS unsigned* Tw = (LAS unsigned*)c.lds;
    const int tid = c.tid, lane = c.lane, wave = c.wave;
    constexpr int NITEMS = 1648;
    for (int it = blockIdx.x; it < NITEMS; it += gridDim.x) {
        int r = it; const float* src; int ld, K, col0, d0, kc; size_t dsto;
        if (r < 352) { const int s = r >> 2; kc = r & 3; d0 = s * 64; const int tile = d0 >> 8, w = d0 & 255, half = w >> 7, off = w & 127;
            src = (half ? a->in[8] : a->in[7]) + (size_t)L * D * FF; ld = FF; K = D; col0 = tile * 128 + off; dsto = W_GU1; }
        else if ((r -= 352) < 176) { const int s = r / 11; kc = r - s * 11; d0 = s * 64; src = a->in[9] + (size_t)L * FF * D; ld = D; K = FF; col0 = d0; dsto = W_D1; }
        else if ((r -= 176) < 160) { const int s = r >> 2; kc = r & 3; d0 = s * 64;
            if (d0 < 1024) { const int tile = d0 >> 8, w = d0 & 255, half = w >> 7, off = w & 127; col0 = half * 512 + tile * 128 + off; } else col0 = d0;
            src = a->in[11] + (size_t)L * D * 5632; ld = 5632; K = D; dsto = W_IM; }
        else if ((r -= 160) < 192) { const int s = r >> 2; kc = r & 3; d0 = s * 64; src = a->in[11] + (size_t)L * D * 5632; ld = 5632; K = D; col0 = 2560 + d0; dsto = W_IG; }
        else if ((r -= 192) < 32) { const int s = r >> 1; kc = r & 1; d0 = s * 64; src = a->in[17] + (size_t)L * 512 * D; ld = D; K = 512; col0 = d0; dsto = W_CA; }
        else if ((r -= 32) < 32) { const int s = r >> 1; kc = r & 1; d0 = s * 64; src = a->in[22] + (size_t)L * 512 * D; ld = D; K = 512; col0 = d0; dsto = W_SB; }
        else if ((r -= 32) < 32) { const int s = r >> 1; kc = r & 1; d0 = s * 64; src = a->in[25] + (size_t)L * 512 * D; ld = D; K = 512; col0 = d0; dsto = W_PC; }
        else if ((r -= 32) < 64) { const int s = r >> 2; kc = r & 3; d0 = s * 64; src = a->in[26] + (size_t)L * D * D; ld = D; K = D; col0 = d0; dsto = W_O; }
        else if ((r -= 64) < 352) { const int s = r >> 2; kc = r & 3; d0 = s * 64; const int tile = d0 >> 8, w = d0 & 255, half = w >> 7, off = w & 127;
            src = (half ? a->in[29] : a->in[28]) + (size_t)L * D * FF; ld = FF; K = D; col0 = tile * 128 + off; dsto = W_GU2; }
        else if ((r -= 352) < 176) { const int s = r / 11; kc = r - s * 11; d0 = s * 64; src = a->in[30] + (size_t)L * FF * D; ld = D; K = FF; col0 = d0; dsto = W_D2; }
        else if ((r -= 176) < 64) { const int s = r >> 2; kc = r & 3; d0 = s * 64; src = a->in[32] + (size_t)L * D * D; ld = D; K = D; col0 = d0; dsto = W_PG; }
        else { r -= 64; const int s = r; kc = 0; d0 = s * 64; src = a->in[33] + (size_t)L * DPLE * D; ld = D; K = DPLE; col0 = d0; dsto = W_PE; }
        const int k0 = kc * 256;
#pragma unroll 4
        for (int i2 = 0; i2 < 16; ++i2) {
            const int kp = wave * 16 + i2;
            const float* sp = src + (size_t)(k0 + 2 * kp) * ld + col0 + lane;
            const float v0 = sp[0], v1 = sp[ld];
            Tw[lane * 129 + kp] = cvt_pk_bf16(v0, v1);
        }
        __syncthreads();
        bf16_t* dst = c.W + dsto;
#pragma unroll
        for (int i = 0; i < 4; ++i) {
            const int uu = tid + 512 * i, n = uu >> 5, q = uu & 31;
            u32x4 w; w.x = Tw[n * 129 + 4 * q]; w.y = Tw[n * 129 + 4 * q + 1]; w.z = Tw[n * 129 + 4 * q + 2]; w.w = Tw[n * 129 + 4 * q + 3];
            *(u32x4*)(dst + (size_t)(d0 + n) * K + k0 + 8 * q) = w;
        }
        __syncthreads();
    }
    const size_t gtid = (size_t)blockIdx.x * 512 + tid, gstride = (size_t)gridDim.x * 512;
    const float* pw = a->in[23] + (size_t)L * 4 * 128 * 128;
    for (size_t i = gtid; i < 512 * 512; i += gstride) { const int n = (int)(i >> 9), k = (int)(i & 511);
        c.W[W_PBD + i] = ((n >> 7) == (k >> 7)) ? f2bf(pw[((size_t)(n >> 7) * 128 + (k & 127)) * 128 + (n & 127)]) : (bf16_t)0; }
    const float* wsrc = a->in[20] + (size_t)L * 4 * 128 * 128;
    for (size_t i = gtid; i < 65536; i += gstride) { const int ii = (int)((i >> 7) & 127), jj = (int)(i & 127); c.W[W_WS + i] = (jj <= ii) ? f2bf(wsrc[i]) : (bf16_t)0; }
    const float* pp = a->in[2]; const float* ps = a->in[3];
    for (size_t i = gtid; i < (size_t)M * 64; i += gstride) { const int r = (int)(i >> 6), c4 = (int)(i & 63);
        const f32x4 v = *(const f32x4*)(p_row(pp, ps, L, r) + c4 * 4); u32x2 w; w.x = cvt_pk_bf16(v[0], v[1]); w.y = cvt_pk_bf16(v[2], v[3]); *(u32x2*)(c.PB + (size_t)r * DPLE + c4 * 4) = w; }
}

__device__ __forceinline__ void load_bf8(const bf16_t* p, float (&x)[8]) { unpack8(*(const u32x4*)p, x); }

__device__ __forceinline__ void mix_phase(const Ctx& c, int L) {
    ArgsP a = get_args();
    const bf16_t* ZM = (const bf16_t*)c.BIG;
    const int tid = c.tid, lane = c.lane, wave = c.wave, fr = lane & 15, fq = lane >> 4;
    float* out = a->out;
    for (int b = blockIdx.x; b < 160; b += gridDim.x) {
        const int row0 = b < 128 ? b * 128 : MP + (b - 128) * 64, R = b < 128 ? 128 : 64;
        LAS unsigned char* vnT = c.lds;
        const float* lg = a->in[18] + L * 512; const float* lb = a->in[19] + L * 512;
        float gch[8], bch[8];
#pragma unroll
        for (int e = 0; e < 8; ++e) { gch[e] = lg[lane + 64 * e]; bch[e] = lb[lane + 64 * e]; }
        float* vout = nullptr;
        if (b < 128) { if ((b & 63) == 63) vout = out + O_VP + ((size_t)(L * 2 + (b >> 6)) * 128) * 512; }
        else vout = out + O_VS + ((size_t)(L * 32 + (b - 128)) * 64) * 512;
        for (int grp = wave; grp < 16; grp += 8) {
            const int j0 = grp * 8;
            if (j0 >= R) {
#pragma unroll
                for (int e = 0; e < 8; ++e) *(LAS u32x4*)(vnT + (lane + 64 * e) * 272 + j0 * 2) = (u32x4){0u, 0u, 0u, 0u};
                continue;
            }
            float y[8][8];
#pragma unroll
            for (int rr = 0; rr < 8; ++rr) {
                const bf16_t* vp = ZM + (size_t)(row0 + j0 + rr) * ZMW + 1024 + lane;
                float s = 0.f;
#pragma unroll
                for (int e = 0; e < 8; ++e) { y[rr][e] = bf2f(vp[64 * e]); s += y[rr][e]; }
                const float mu = wave_sum(s) * (1.0f / 512);
                float q = 0.f;
#pragma unroll
                for (int e = 0; e < 8; ++e) { y[rr][e] -= mu; q += y[rr][e] * y[rr][e]; }
                const float rstd = __builtin_amdgcn_rsqf(wave_sum(q) * (1.0f / 512) + EPS);
#pragma unroll
                for (int e = 0; e < 8; ++e) y[rr][e] = y[rr][e] * rstd * gch[e] + bch[e];
                if (vout) {
#pragma unroll
                    for (int e = 0; e < 8; ++e) vout[(size_t)(j0 + rr) * 512 + lane + 64 * e] = y[rr][e];
                }
            }
#pragma unroll
            for (int e = 0; e < 8; ++e) {
                u32x4 w; w.x = cvt_pk_bf16(y[0][e], y[1][e]); w.y = cvt_pk_bf16(y[2][e], y[3][e]); w.z = cvt_pk_bf16(y[4][e], y[5][e]); w.w = cvt_pk_bf16(y[6][e], y[7][e]);
                *(LAS u32x4*)(vnT + (lane + 64 * e) * 272 + j0 * 2) = w;
            }
        }
        __syncthreads();
        const int ib = wave * 16, nkb = (ib + 15) / 32 + 1;
        const bf16_t* WsB = c.W + W_WS;
        const float* bs = a->in[21] + L * 512;
        for (int g = 0; g < 4; ++g) {
            bf16x8 af[4];
#pragma unroll
            for (int kb = 0; kb < 4; ++kb) af[kb] = *(const bf16x8*)(WsB + ((size_t)g * 128 + ib + fr) * 128 + kb * 32 + fq * 8);
            for (int ni = 0; ni < 8; ++ni) {
                const int col = g * 128 + ni * 16 + fr;
                f32x4 acc = (f32x4){0.f, 0.f, 0.f, 0.f};
#pragma unroll
                for (int kb = 0; kb < 4; ++kb) if (kb < nkb) {
                    const bf16x8 bfr = *(const LAS bf16x8*)(vnT + col * 272 + (kb * 32 + fq * 8) * 2);
                    acc = __builtin_amdgcn_mfma_f32_16x16x32_bf16(af[kb], bfr, acc, 0, 0, 0);
                }
#pragma unroll
                for (int jj = 0; jj < 4; ++jj) {
                    const int i = ib + fq * 4 + jj;
                    if (i < R) { const size_t r = (size_t)(row0 + i);
                        const float uv = bf2f(ZM[r * ZMW + 512 + col]);
                        c.XB[r * XW + col] = f2bf(uv * (acc[jj] + bs[g * 128 + i])); }
                }
            }
        }
        __syncthreads();
    }
    __syncthreads();
    {
        LAS float* wl = (LAS float*)c.lds; const float* wg = a->in[13] + (size_t)L * 31 * 512;
        for (int i = tid; i < 31 * 512 / 4; i += 512) *(LAS f32x4*)(wl + i * 4) = *(const f32x4*)(wg + i * 4);
    }
    __syncthreads();
    {
        const LAS float* wl = (const LAS float*)c.lds;
        float dwb[8], lng[8], lnb[8];
#pragma unroll
        for (int e = 0; e < 8; ++e) { dwb[e] = a->in[14][L * 512 + lane * 8 + e]; lng[e] = a->in[15][L * 512 + lane * 8 + e]; lnb[e] = a->in[16][L * 512 + lane * 8 + e]; }
        for (int itm = c.gw; itm < M / 4; itm += c.nW) {
            const int r0 = itm * 4;
            int seq0, trel; const float* hist = nullptr;
            if (r0 < MP) { seq0 = (r0 / SEQ) * SEQ; trel = r0 - seq0; }
            else { const int s = (r0 - MP) / DSEQ; seq0 = MP + s * DSEQ; trel = r0 - seq0; hist = a->in[4] + ((size_t)(L * 32 + s) * 30) * 512; }
            float acc[4][8];
#pragma unroll
            for (int o = 0; o < 4; ++o)
#pragma unroll
                for (int e = 0; e < 8; ++e) acc[o][e] = dwb[e];
            float xw[4][8];
            auto ldrow = [&](int ri, float (&x)[8]) {
                const int t = trel - 30 + ri;
                if (t >= 0) load_bf8(ZM + (size_t)(seq0 + t) * ZMW + lane * 8, x);
                else if (hist) { const f32x4 h0 = *(const f32x4*)(hist + (size_t)(30 + t) * 512 + lane * 8), h1 = *(const f32x4*)(hist + (size_t)(30 + t) * 512 + lane * 8 + 4);
                    x[0] = h0[0]; x[1] = h0[1]; x[2] = h0[2]; x[3] = h0[3]; x[4] = h1[0]; x[5] = h1[1]; x[6] = h1[2]; x[7] = h1[3]; }
                else {
#pragma unroll
                    for (int e = 0; e < 8; ++e) x[e] = 0.f; }
            };
            ldrow(0, xw[0]); ldrow(1, xw[1]); ldrow(2, xw[2]);
#pragma unroll 1
            for (int kk = 0; kk < 32; kk += 4) {
#pragma unroll
                for (int k4 = 0; k4 < 4; ++k4) {
                    const int k = kk + k4;
                    if (k < 31) {
                        ldrow(k + 3, xw[(k4 + 3) & 3]);
                        const f32x4 w0 = *(const LAS f32x4*)(wl + k * 512 + lane * 8), w1 = *(const LAS f32x4*)(wl + k * 512 + lane * 8 + 4);
#pragma unroll
                        for (int o = 0; o < 4; ++o) {
#pragma unroll
                            for (int e = 0; e < 4; ++e) { acc[o][e] += xw[(k4 + o) & 3][e] * w0[e]; acc[o][e + 4] += xw[(k4 + o) & 3][e + 4] * w1[e]; }
                        }
                    }
                }
            }
#pragma unroll
            for (int o = 0; o < 4; ++o) {
                float s = 0.f;
#pragma unroll
                for (int e = 0; e < 8; ++e) s += acc[o][e];
                const float mu = wave_sum(s) * (1.0f / 512);
                float q = 0.f;
#pragma unroll
                for (int e = 0; e < 8; ++e) { acc[o][e] -= mu; q += acc[o][e] * acc[o][e]; }
                const float rstd = __builtin_amdgcn_rsqf(wave_sum(q) * (1.0f / 512) + EPS);
                float h[8];
#pragma unroll
                for (int e = 0; e < 8; ++e) { const float yv = acc[o][e] * rstd * lng[e] + lnb[e]; h[e] = yv * sigmoidf_(yv); }
                *(u32x4*)(c.XA + (size_t)(r0 + o) * XW + lane * 8) = pack8(h);
            }
        }
    }
    {
        const int win = 2 << (lane >> 4);
        for (int itm = c.gw; itm < M / 4; itm += c.nW) {
            const int r0 = itm * 4;
            int seq0, trel; const float* hist = nullptr;
            if (r0 < MP) { seq0 = (r0 / SEQ) * SEQ; trel = r0 - seq0; }
            else { const int s = (r0 - MP) / DSEQ; seq0 = MP + s * DSEQ; trel = r0 - seq0; hist = a->in[5] + ((size_t)(L * 32 + s) * 15) * 512; }
            float acc[4][8], cur[4][8];
#pragma unroll
            for (int o = 0; o < 4; ++o)
#pragma unroll
                for (int e = 0; e < 8; ++e) { acc[o][e] = 0.f; cur[o][e] = 0.f; }
#pragma unroll
            for (int ri = 0; ri < 19; ++ri) {
                const int t = trel - 15 + ri;
                float x[8];
                if (t >= 0) load_bf8(ZM + (size_t)(seq0 + t) * ZMW + 1536 + lane * 8, x);
                else if (hist) { const f32x4 h0 = *(const f32x4*)(hist + (size_t)(15 + t) * 512 + lane * 8), h1 = *(const f32x4*)(hist + (size_t)(15 + t) * 512 + lane * 8 + 4);
                    x[0] = h0[0]; x[1] = h0[1]; x[2] = h0[2]; x[3] = h0[3]; x[4] = h1[0]; x[5] = h1[1]; x[6] = h1[2]; x[7] = h1[3]; }
                else {
#pragma unroll
                    for (int e = 0; e < 8; ++e) x[e] = 0.f; }
#pragma unroll
                for (int o = 0; o < 4; ++o) {
                    const int dd = 15 + o - ri;
                    if (dd >= 0 && dd < 16) {
                        const bool inw = dd < win;
#pragma unroll
                        for (int e = 0; e < 8; ++e) acc[o][e] += inw ? x[e] : 0.f;
                        if (dd == 0) {
#pragma unroll
                            for (int e = 0; e < 8; ++e) cur[o][e] = x[e];
                        }
                    }
                }
            }
#pragma unroll
            for (int o = 0; o < 4; ++o) {
                const int cnt = hist ? win : min(trel + o + 1, win);
                const float inv = 1.0f / (float)cnt;
                float h[8];
#pragma unroll
                for (int e = 0; e < 8; ++e) h[e] = acc[o][e] * inv - cur[o][e];
                *(u32x4*)(c.XD + (size_t)(r0 + o) * XW + lane * 8) = pack8(h);
            }
        }
    }
    for (int idx = c.gw; idx < 34 * 45; idx += c.nW) {
        const int seq = idx / 45, k = idx - seq * 45;
        size_t srow; float* dst; int coff;
        if (k < 30) { coff = 0;
            if (seq < 2) { srow = (size_t)seq * SEQ + (SEQ - 30) + k; dst = out + O_CONVP + ((size_t)(L * 2 + seq) * 30 + k) * 512; }
            else { srow = (size_t)MP + (seq - 2) * DSEQ + (DSEQ - 30) + k; dst = out + O_CONVS + ((size_t)(L * 32 + seq - 2) * 30 + k) * 512; }
        } else { const int kk = k - 30; coff = 1536;
            if (seq < 2) { srow = (size_t)seq * SEQ + (SEQ - 15) + kk; dst = out + O_POOLP + ((size_t)(L * 2 + seq) * 15 + kk) * 512; }
            else { srow = (size_t)MP + (seq - 2) * DSEQ + (DSEQ - 15) + kk; dst = out + O_POOLS + ((size_t)(L * 32 + seq - 2) * 15 + kk) * 512; }
        }
        float x[8]; load_bf8(ZM + srow * ZMW + coff + lane * 8, x);
        *(f32x4*)(dst + lane * 8) = (f32x4){x[0], x[1], x[2], x[3]}; *(f32x4*)(dst + lane * 8 + 4) = (f32x4){x[4], x[5], x[6], x[7]};
    }
    __syncthreads();
}

constexpr int NPHASE = 1 + 14 * NLAYER;

__global__ void __launch_bounds__(512, 2) fwd_kernel(Args args) {
    extern __shared__ __attribute__((aligned(16))) unsigned char lds_raw[];
    (void)args;
    LAS unsigned char* lds = (LAS unsigned char*)lds_raw;
    const int wave0 = __builtin_amdgcn_readfirstlane((int)threadIdx.x >> 6);
    const int hi = get_args()->ph_hi;
#define MKCTX() Ctx c; { ArgsP ka = get_args(); int t_; asm volatile("v_mbcnt_lo_u32_b32 %0, -1, 0\n\tv_mbcnt_hi_u32_b32 %0, -1, %0" : "=v"(t_)); t_ += wave0 * 64; unsigned char* ws = ka->ws; \
        c.lds = lds; c.tid = t_; c.lane = t_ & 63; c.wave = wave0; c.gw = blockIdx.x * 8 + c.wave; c.nW = gridDim.x * 8; \
        c.H = ka->out; c.W = (bf16_t*)(ws + WS_W); c.PB = (bf16_t*)(ws + WS_PB); c.NB = (bf16_t*)(ws + WS_NB); c.BIG = ws + WS_BIG; \
        c.XA = (bf16_t*)(ws + WS_X); c.XB = c.XA + (size_t)M * XW; c.XD = c.XB + (size_t)M * XW; c.XC = c.XD + (size_t)M * XW; } \
        bf16_t* HID = (bf16_t*)c.BIG; bf16_t* ZM = (bf16_t*)c.BIG; bf16_t* ZG = (bf16_t*)c.BIG; float* T = (float*)c.BIG; (void)HID; (void)ZM; (void)ZG; (void)T; \
        const int G = gridDim.x, cb = blockIdx.x; (void)G; (void)cb;
#define GEMM1(EPI, Aptr, Bptr, Nn, Kk, ...) do { pg8::Gemm g{(Aptr), (Aptr), (Aptr), (Bptr), (Bptr), (Bptr), (Kk)}; pg8::Sched S; S.init(M, (Nn), G, cb, 1); \
        pg8::EPI E{__VA_ARGS__}; pg8::gemm_phase<pg8::EPI, G_ALIGN, G_SP2>(lds, c.tid, g, S, E); } while (0)

#pragma unroll 1
    for (int ph = get_args()->ph_lo; ph < hi; ++ph) {
        const int L = ph == 0 ? 0 : (ph - 1) / 14, j = ph == 0 ? -1 : (ph - 1) - 14 * L;
        switch (j) {
        case -1: { MKCTX(); prep_phase(c, 0); norm_phase<0>(c, get_args()->in[6]); } break;
        case 0: { MKCTX(); GEMM1(EpiGU, c.NB, c.W + W_GU1, 2 * FF, D, HID, FF); } break;
        case 1: { MKCTX(); GEMM1(EpiRes, HID, c.W + W_D1, D, FF, c.H, 0.5f); } break;
        case 2: { MKCTX(); norm_phase<1>(c, get_args()->in[10] + L * D); } break;
        case 3: { MKCTX(); GEMM1(EpiWinMix, c.NB, c.W + W_IM, 2560, D, ZM); } break;
        case 4: { MKCTX(); mix_phase(c, L); } break;
        case 5: {
            { MKCTX(); GEMM1(EpiGates, c.NB, c.W + W_IG, 3072, D, ZG, get_args()->in[12] + L * 3072); }
            { MKCTX(); GEMM1(EpiScale, c.XD, c.W + W_PBD, 512, 512, c.XC, XW, get_args()->in[24] + L * 512); }
        } break;
        case 6: { MKCTX();
            pg8::Gemm g{c.XA, c.XB, c.XC, c.W + W_CA, c.W + W_SB, c.W + W_PC, 512}; pg8::Sched S; S.init(M, D, G, cb, 3);
            pg8::EpiMerge E{ZG, c.NB}; pg8::gemm_phase<pg8::EpiMerge, G_ALIGN, G_SP2>(lds, c.tid, g, S, E);
        } break;
        case 7: { MKCTX(); GEMM1(EpiRes, c.NB, c.W + W_O, D, D, c.H, 1.0f); } break;
        case 8: { MKCTX(); norm_phase<1>(c, get_args()->in[27] + L * D); } break;
        case 9: { MKCTX(); GEMM1(EpiGU, c.NB, c.W + W_GU2, 2 * FF, D, HID, FF); } break;
        case 10: { MKCTX(); GEMM1(EpiRes, HID, c.W + W_D2, D, FF, c.H, 0.5f); } break;
        case 11: { { MKCTX(); norm_phase<1>(c, get_args()->in[31] + L * D); } { MKCTX(); GEMM1(EpiT, c.PB, c.W + W_PE, D, DPLE, T); } } break;
        case 12: { MKCTX(); GEMM1(EpiPE, c.NB, c.W + W_PG, D, D, c.H, T); } break;
        default: { MKCTX();
            if (L + 1 < NLAYER) { prep_phase(c, L + 1); norm_phase<1>(c, get_args()->in[6] + (L + 1) * D); }
            else norm_phase<2>(c, get_args()->in[34]);
        } break;
        }
        if (ph + 1 < hi) cg::this_grid().sync();
    }
#undef GEMM1
#undef MKCTX
}

extern "C" void kernel_launch(void* const* d_in, const int* in_sizes, int n_in, void* d_out, int out_size, void* d_ws, size_t ws_size, hipStream_t stream) {
    static int grid = 0;
    if (grid == 0) {
        if (n_in != 35 || (size_t)out_size != O_END || ws_size < WS_END) { fprintf(stderr, "kernel_launch: unexpected shapes (n_in %d, out %d, ws %zu)\n", n_in, out_size, ws_size); grid = -1; return; }
        int dev = 0, cus = 0, per_cu = 0;
        if (hipGetDevice(&dev) != hipSuccess || hipDeviceGetAttribute(&cus, hipDeviceAttributeMultiprocessorCount, dev) != hipSuccess) { grid = -1; return; }
        if (hipFuncSetAttribute((const void*)fwd_kernel, hipFuncAttributeMaxDynamicSharedMemorySize, LDS_BYTES) != hipSuccess) { fprintf(stderr, "kernel_launch: hipFuncSetAttribute failed\n"); grid = -1; return; }
        if (hipOccupancyMaxActiveBlocksPerMultiprocessor(&per_cu, (const void*)fwd_kernel, 512, LDS_BYTES) != hipSuccess || per_cu < 1) { fprintf(stderr, "kernel_launch: occupancy query says %d\n", per_cu); per_cu = 1; }
        (void)hipGetLastError();
        grid = cus * 1;
    }
    if (grid < 0) return;
    Args a{};
    for (int i = 0; i < 35; ++i) a.in[i] = (const float*)d_in[i];
    a.out = (float*)d_out; a.ws = (unsigned char*)d_ws;
#if MK_N_LAUNCHES == 1
    a.ph_lo = 0; a.ph_hi = NPHASE;
    void* kargs[] = {&a};
    hipError_t e = hipLaunchCooperativeKernel((const void*)fwd_kernel, dim3(grid), dim3(512), kargs, LDS_BYTES, stream);
    if (e != hipSuccess) fprintf(stderr, "kernel_launch: cooperative launch failed: %s (grid %d)\n", hipGetErrorString(e), grid);
#else
    for (int ph = 0; ph < NPHASE; ++ph) {
        a.ph_lo = ph; a.ph_hi = ph + 1;
        hipLaunchKernelGGL(fwd_kernel, dim3(grid), dim3(512), LDS_BYTES, stream, a);
    }
#endif
}
```

```cpp
#include <hip/hip_runtime.h>
#include <hip/hip_cooperative_groups.h>
#include <cstdio>
#include <cstdint>
namespace cg = cooperative_groups;

#ifndef MK_N_LAUNCHES
#define MK_N_LAUNCHES 1
#endif
#ifndef REP_MASK
#define REP_MASK 0u
#endif
#ifndef G_SP2
#define G_SP2 true
#endif
#ifndef G_ALIGN
#define G_ALIGN true
#endif

#define LAS __attribute__((address_space(3)))
typedef unsigned short bf16_t;
typedef short bf16x8 __attribute__((ext_vector_type(8)));
typedef float f32x4 __attribute__((ext_vector_type(4)));
typedef unsigned u32x4 __attribute__((ext_vector_type(4)));
typedef unsigned u32x2 __attribute__((ext_vector_type(2)));

constexpr int D = 1024, FF = 2816, MP = 16384, MS = 2048, M = MP + MS, SEQ = 8192, DSEQ = 64, DPLE = 256;
constexpr int NLAYER = 2;
constexpr float EPS = 1e-6f;
constexpr int ZMW = 2048, ZGW = 3072, XW = 512;
constexpr size_t O_Y = 0, O_CONVP = (size_t)M * D, O_CONVS = O_CONVP + 2 * 2 * 30 * 512, O_POOLP = O_CONVS + 2 * 32 * 30 * 512,
                 O_POOLS = O_POOLP + 2 * 2 * 15 * 512, O_VP = O_POOLS + 2 * 32 * 15 * 512, O_VS = O_VP + 2 * 2 * 128 * 512, O_END = O_VS + 2 * 32 * 64 * 512;
constexpr size_t MiB = 1u << 20;
constexpr size_t WS_BAR = 768 * 1024, WS_W = 1 * MiB, WS_PB = 54 * MiB, WS_NB = 63 * MiB, WS_BIG = 99 * MiB, WS_X = 207 * MiB, WS_NB2 = 279 * MiB, WS_END = 315 * MiB;
constexpr size_t W_GU1 = 0, W_D1 = W_GU1 + (size_t)5632 * 1024, W_IM = W_D1 + (size_t)1024 * 2816, W_IG = W_IM + (size_t)2560 * 1024,
                 W_CA = W_IG + (size_t)3072 * 1024, W_SB = W_CA + 524288, W_PC = W_SB + 524288, W_PBD = W_PC + 524288, W_O = W_PBD + 262144,
                 W_GU2 = W_O + 1048576, W_D2 = W_GU2 + (size_t)5632 * 1024, W_PG = W_D2 + (size_t)1024 * 2816, W_PE = W_PG + 1048576,
                 W_WS = W_PE + 262144, W_TOTAL = W_WS + 65536;
static_assert(W_TOTAL * 2 <= 53 * MiB, "weight region");
constexpr int LDS_BYTES = 147456;

typedef __bf16 bf16x2_t __attribute__((ext_vector_type(2)));
__device__ __forceinline__ unsigned cvt_pk_bf16(float lo, float hi) { bf16x2_t v; v[0] = (__bf16)lo; v[1] = (__bf16)hi; return __builtin_bit_cast(unsigned, v); }
__device__ __forceinline__ bf16_t f2bf(float f) { return (bf16_t)(cvt_pk_bf16(f, 0.f) & 0xffffu); }
__device__ __forceinline__ float bf2f(bf16_t b) { return __uint_as_float(((unsigned)b) << 16); }
__device__ __forceinline__ float bflo(unsigned w) { return __uint_as_float(w << 16); }
__device__ __forceinline__ float bfhi(unsigned w) { return __uint_as_float(w & 0xffff0000u); }
__device__ __forceinline__ float sigmoidf_(float x) { return __builtin_amdgcn_rcpf(1.0f + __builtin_amdgcn_exp2f(-1.4426950408889634f * x)); }
__device__ __forceinline__ float wave_sum(float v) {
#pragma unroll
    for (int o = 32; o > 0; o >>= 1) v += __shfl_xor(v, o);
    return v;
}
__device__ __forceinline__ void unpack8(const u32x4 w, float (&x)[8]) {
    x[0] = bflo(w.x); x[1] = bfhi(w.x); x[2] = bflo(w.y); x[3] = bfhi(w.y); x[4] = bflo(w.z); x[5] = bfhi(w.z); x[6] = bflo(w.w); x[7] = bfhi(w.w);
}
__device__ __forceinline__ u32x4 pack8(const float (&x)[8]) {
    u32x4 w; w.x = cvt_pk_bf16(x[0], x[1]); w.y = cvt_pk_bf16(x[2], x[3]); w.z = cvt_pk_bf16(x[4], x[5]); w.w = cvt_pk_bf16(x[6], x[7]); return w;
}

namespace pg8 {
constexpr int BM = 256, BK = 64, HALF = 128, HTB = HALF * BK * 2, STAGE_BYTES = 8 * HTB, NXCD = 8, WGM = 8;
__device__ __forceinline__ int lds_byte(int r, int c) { const int st = (r >> 4) * 2 + (c >> 5), rr = r & 15, cc = c & 31, ob = rr * 64 + cc * 2; return st * 1024 + (ob ^ (((ob >> 9) & 1) << 5)); }
__device__ __forceinline__ void stage_rc(int b, int& R, int& C) { const int st = b / 1024, sb = b % 1024, swz = sb ^ (((sb >> 9) & 1) << 5); R = (st >> 1) * 16 + swz / 64; C = (st & 1) * 32 + (swz % 64) / 2; }
__device__ __forceinline__ int perm32(int rho) { const int n = rho >> 4, i = rho & 15; return 8 * (i >> 2) + 4 * n + (i & 3); }

struct Unit { int pm, pn, pass; };
struct Gemm { const bf16_t* A0; const bf16_t* A1; const bf16_t* A2; const bf16_t* B0; const bf16_t* B1; const bf16_t* B2; };
template <int N_, int NPASS>
struct Sched {
    static constexpr int nM = 18432 / BM, nN = N_ / BM, nwg = nM * nN;
    __device__ __forceinline__ static bool next(int i, int G, int c, Unit& u) {
        const int ti = i / NPASS; u.pass = i - ti * NPASS;
        const int L = ti * G + c; if (L >= nwg) return false;
        int wgid = L; { constexpr int q = nwg / NXCD, r = nwg % NXCD; const int xcd = wgid % NXCD, off = wgid / NXCD; wgid = (xcd < r ? xcd * (q + 1) : r * (q + 1) + (xcd - r) * q) + off; }
        constexpr int nig = WGM * nN; const int gid = wgid / nig, fm = gid * WGM, gsz = (nM - fm) < WGM ? (nM - fm) : WGM;
        u.pm = fm + ((wgid % nig) % gsz); u.pn = (wgid % nig) / gsz; return true;
    }
};
template <class Epi, int N_, int K, int NPASS, bool ALIGN_EPI, bool SP2>
__device__ __forceinline__ void gemm_phase(LAS unsigned char* lds, int tid_in, const Gemm g, const Epi& E) {
    typedef Sched<N_, NPASS> S;
    int tid_ = tid_in; asm volatile("" : "+v"(tid_));
    const int tid = tid_, wid = __builtin_amdgcn_readfirstlane(tid >> 6), lane = tid & 63, wr = wid >> 2, wc = wid & 3, fr = lane & 15, fq = lane >> 4;
    constexpr int nt = K / BK;
    unsigned voffA[2], voffB[2];
#pragma unroll
    for (int i = 0; i < 2; ++i) { int R, C; stage_rc(tid * 16 + i * 8192, R, C); const int Rb = (R & ~31) + perm32(R & 31);
        voffA[i] = (unsigned)(R * K + C) * 2u; voffB[i] = (unsigned)(Rb * K + C) * 2u; }
    constexpr size_t kstep = (size_t)(BK * 2);
    constexpr size_t hstep = (size_t)HALF * K * 2;
    constexpr size_t tstep = 2 * hstep;
    const unsigned ldsw = (unsigned)wid * 1024u;
    const int aoff = lds_byte(wr * 64 + fr, fq * 8), boff = lds_byte(wc * 32 + fr, fq * 8);
#define PG8_SA(b, h) (((b) * 2 + (h)) * HTB)
#define PG8_SB(b, h) ((4 + (b) * 2 + (h)) * HTB)
#define PG8_STAGE(bufoff, gbase, voff) do { _Pragma("unroll") for (int _i = 0; _i < 2; ++_i) \
        __builtin_amdgcn_global_load_lds((const unsigned*)((const char*)(gbase) + (voff)[_i]), (LAS unsigned*)(lds + (bufoff) + ldsw + _i * 8192), 16, 0, 0); } while (0)
#define PG8_LDA(dst, b, h) do { _Pragma("unroll") for (int m = 0; m < 4; ++m) _Pragma("unroll") for (int k = 0; k < 2; ++k) dst[m][k] = *(const LAS bf16x8*)(lds + PG8_SA(b, h) + aoff + m * 2048 + k * 1024); } while (0)
#define PG8_LDB(dst, b, h) do { _Pragma("unroll") for (int n = 0; n < 2; ++n) _Pragma("unroll") for (int k = 0; k < 2; ++k) dst[n][k] = *(const LAS bf16x8*)(lds + PG8_SB(b, h) + boff + n * 2048 + k * 1024); } while (0)
#define PG8_MMA(ai, bj, At, Bt) do { __builtin_amdgcn_s_setprio(1); _Pragma("unroll") for (int m = 0; m < 4; ++m) _Pragma("unroll") for (int n = 0; n < 2; ++n) _Pragma("unroll") for (int k = 0; k < 2; ++k) \
        acc[ai][bj][m][n] = __builtin_amdgcn_mfma_f32_16x16x32_bf16(Bt[n][k], At[m][k], acc[ai][bj][m][n], 0, 0, 0); __builtin_amdgcn_s_setprio(0); } while (0)
#define PG8_WAIT_V(n) asm volatile("s_waitcnt vmcnt(" #n ")" ::: "memory")
#define PG8_WAIT_L(n) asm volatile("s_waitcnt lgkmcnt(" #n ")" ::: "memory")
#define PG8_BAR __builtin_amdgcn_s_barrier()
#define PG8_SCHED __builtin_amdgcn_sched_barrier(0)
#define PG8_ABASE(u) ((const char*)((u).pass == 0 ? g.A0 : ((u).pass == 1 ? g.A1 : g.A2)))
#define PG8_BBASE(u) ((const char*)((u).pass == 0 ? g.B0 : ((u).pass == 1 ? g.B1 : g.B2)))
    Unit cur, nxt; int ui = 0;
    int sG = (int)gridDim.x, sC = (int)blockIdx.x; asm volatile("" : "+s"(sG), "+s"(sC));
    if (!S::next(0, sG, sC, cur)) return;
    f32x4 acc[2][2][4][2];
#pragma unroll
    for (int a = 0; a < 2; ++a)
#pragma unroll
        for (int b = 0; b < 2; ++b)
#pragma unroll
            for (int m = 0; m < 4; ++m)
#pragma unroll
                for (int n = 0; n < 2; ++n) acc[a][b][m][n] = (f32x4){0.f, 0.f, 0.f, 0.f};
    bf16x8 At[4][2], B0[2][2], B1[2][2];
    const char* cA = PG8_ABASE(cur) + (size_t)cur.pm * tstep; const char* cB = PG8_BBASE(cur) + (size_t)cur.pn * tstep;
    if constexpr (SP2) {
        PG8_STAGE(PG8_SB(0, 0), cB, voffB); PG8_STAGE(PG8_SB(0, 1), cB + hstep, voffB); PG8_STAGE(PG8_SA(0, 0), cA, voffA); PG8_STAGE(PG8_SA(0, 1), cA + hstep, voffA);
        if (wr == 1) PG8_BAR;
        PG8_WAIT_V(2); PG8_BAR;
        PG8_STAGE(PG8_SB(1, 0), cB + kstep, voffB); PG8_STAGE(PG8_SA(1, 0), cA + kstep, voffA); PG8_STAGE(PG8_SB(1, 1), cB + hstep + kstep, voffB);
        PG8_WAIT_V(6); PG8_BAR;
    } else {
        PG8_STAGE(PG8_SB(0, 0), cB, voffB); PG8_STAGE(PG8_SA(0, 0), cA, voffA); PG8_STAGE(PG8_SB(0, 1), cB + hstep, voffB); PG8_STAGE(PG8_SA(0, 1), cA + hstep, voffA);
        if (wr == 1) PG8_BAR;
        PG8_WAIT_V(4); PG8_BAR;
        PG8_STAGE(PG8_SB(1, 0), cB + kstep, voffB); PG8_STAGE(PG8_SA(1, 0), cA + kstep, voffA); PG8_STAGE(PG8_SB(1, 1), cB + hstep + kstep, voffB);
        PG8_WAIT_V(6); PG8_BAR;
    }
    for (;;) {
        const bool has_next = S::next(ui + 1, sG, sC, nxt);
        const char* nA = has_next ? PG8_ABASE(nxt) + (size_t)nxt.pm * tstep : cA; const char* nB = has_next ? PG8_BBASE(nxt) + (size_t)nxt.pn * tstep : cB;
#pragma unroll 1
        for (int t = 0; t < nt; t += 2) {
            const bool last = (t == nt - 2);
            const char* a1 = cA + (size_t)(t + 1) * kstep;
            const char* a2 = last ? nA : cA + (size_t)(t + 2) * kstep; const char* b2 = last ? nB : cB + (size_t)(t + 2) * kstep;
            const char* a3 = a2 + kstep; const char* b3 = b2 + kstep;
            if constexpr (SP2) {
            PG8_LDB(B0, 0, 0); PG8_LDB(B1, 0, 1); PG8_SCHED; PG8_LDA(At, 0, 0); PG8_STAGE(PG8_SA(1, 1), a1 + hstep, voffA);
            PG8_WAIT_V(8); PG8_WAIT_L(0); PG8_BAR; PG8_MMA(0, 0, At, B0); PG8_MMA(0, 1, At, B1); PG8_BAR; PG8_SCHED;
            PG8_LDA(At, 0, 1); PG8_STAGE(PG8_SB(0, 0), b2, voffB); PG8_STAGE(PG8_SB(0, 1), b2 + hstep, voffB); PG8_STAGE(PG8_SA(0, 0), a2, voffA);
            PG8_WAIT_V(8); PG8_WAIT_L(0); PG8_BAR; PG8_MMA(1, 0, At, B0); PG8_MMA(1, 1, At, B1); PG8_BAR; PG8_SCHED;
            PG8_LDB(B0, 1, 0); PG8_LDB(B1, 1, 1); PG8_SCHED; PG8_LDA(At, 1, 0); PG8_STAGE(PG8_SA(0, 1), a2 + hstep, voffA);
            PG8_WAIT_V(8); PG8_WAIT_L(0); PG8_BAR; PG8_MMA(0, 0, At, B0); PG8_MMA(0, 1, At, B1); PG8_BAR; PG8_SCHED;
            PG8_LDA(At, 1, 1); PG8_STAGE(PG8_SB(1, 0), b3, voffB); PG8_STAGE(PG8_SB(1, 1), b3 + hstep, voffB); PG8_STAGE(PG8_SA(1, 0), a3, voffA);
            PG8_WAIT_V(8); PG8_WAIT_L(0); PG8_BAR; PG8_MMA(1, 0, At, B0); PG8_MMA(1, 1, At, B1); PG8_BAR; PG8_SCHED;
            } else {
            PG8_LDB(B0, 0, 0); PG8_SCHED; PG8_LDA(At, 0, 0); PG8_STAGE(PG8_SA(1, 1), a1 + hstep, voffA);
            PG8_WAIT_L(8); PG8_BAR; PG8_WAIT_L(0); PG8_MMA(0, 0, At, B0); PG8_BAR; PG8_SCHED;
            PG8_LDB(B1, 0, 1); PG8_STAGE(PG8_SB(0, 0), b2, voffB);
            PG8_BAR; PG8_WAIT_L(0); PG8_MMA(0, 1, At, B1); PG8_BAR;
            PG8_LDA(At, 0, 1); PG8_STAGE(PG8_SA(0, 0), a2, voffA);
            PG8_BAR; PG8_WAIT_L(0); PG8_MMA(1, 0, At, B0); PG8_BAR; PG8_SCHED;
            PG8_STAGE(PG8_SB(0, 1), b2 + hstep, voffB);
            PG8_WAIT_V(6); PG8_BAR; PG8_MMA(1, 1, At, B1); PG8_BAR;
            PG8_LDB(B0, 1, 0); PG8_SCHED; PG8_LDA(At, 1, 0); PG8_STAGE(PG8_SA(0, 1), a2 + hstep, voffA);
            PG8_WAIT_L(8); PG8_BAR; PG8_WAIT_L(0); PG8_MMA(0, 0, At, B0); PG8_BAR; PG8_SCHED;
            PG8_LDB(B1, 1, 1); PG8_STAGE(PG8_SB(1, 0), b3, voffB);
            PG8_BAR; PG8_WAIT_L(0); PG8_MMA(0, 1, At, B1); PG8_BAR;
            PG8_LDA(At, 1, 1); PG8_STAGE(PG8_SA(1, 0), a3, voffA);
            PG8_BAR; PG8_WAIT_L(0); PG8_MMA(1, 0, At, B0); PG8_BAR; PG8_SCHED;
            PG8_STAGE(PG8_SB(1, 1), b3 + hstep, voffB);
            PG8_WAIT_V(6); PG8_BAR; PG8_MMA(1, 1, At, B1); PG8_BAR;
            }
        }
        if constexpr (ALIGN_EPI) { if (wr == 0) PG8_BAR; }
        E(acc, cur, wr, wc, fr, fq);
        if (!has_next) break;
        if (nxt.pass == 0) {
#pragma unroll
        for (int a = 0; a < 2; ++a)
#pragma unroll
            for (int b = 0; b < 2; ++b)
#pragma unroll
                for (int m = 0; m < 4; ++m)
#pragma unroll
                    for (int n = 0; n < 2; ++n) acc[a][b][m][n] = (f32x4){0.f, 0.f, 0.f, 0.f};
        }
        cur = nxt; cA = nA; cB = nB; ++ui;
        if constexpr (ALIGN_EPI) { if (wr == 1) PG8_BAR; }
    }
    PG8_WAIT_V(0);
    if constexpr (!ALIGN_EPI) { if (wr == 0) PG8_BAR; }
    PG8_BAR;
#undef PG8_SA
#undef PG8_SB
#undef PG8_STAGE
#undef PG8_LDA
#undef PG8_LDB
#undef PG8_MMA
#undef PG8_WAIT_V
#undef PG8_WAIT_L
#undef PG8_BAR
#undef PG8_SCHED
#undef PG8_ABASE
#undef PG8_BBASE
}

typedef f32x4 (&AccRef)[2][2][4][2];
#define EPI_ROW(u, ai, m) ((u).pm * BM + (ai) * HALF + wr * 64 + (m) * 16 + fr)
#define EPI_COLW (wc * 32 + fq * 8)

#define EPI_RS(ss, row) __builtin_amdgcn_rsqf((ss)[row] * (1.0f / 1024.0f) + 1e-6f)
struct EpiGU {
    bf16_t* O; int ldo; const float* ss;
    __device__ __forceinline__ void operator()(AccRef acc, const Unit& u, int wr, int wc, int fr, int fq) const {
#pragma unroll
        for (int ai = 0; ai < 2; ++ai)
#pragma unroll
            for (int m = 0; m < 4; ++m) {
                const int row = EPI_ROW(u, ai, m); const float rs = EPI_RS(ss, row);
                bf16_t* p = O + (size_t)row * ldo + u.pn * 128 + EPI_COLW;
                float h[8];
#pragma unroll
                for (int n = 0; n < 2; ++n)
#pragma unroll
                    for (int j = 0; j < 4; ++j) { const float gt = rs * acc[ai][0][m][n][j], up = rs * acc[ai][1][m][n][j]; h[n * 4 + j] = gt * sigmoidf_(gt) * up; }
                *(u32x4*)p = pack8(h);
            }
    }
};
struct EpiWinMix {
    bf16_t* Z; const float* ss;
    __device__ __forceinline__ void operator()(AccRef acc, const Unit& u, int wr, int wc, int fr, int fq) const {
        if (u.pn < 4) {
#pragma unroll
            for (int ai = 0; ai < 2; ++ai)
#pragma unroll
                for (int m = 0; m < 4; ++m) {
                    const int row = EPI_ROW(u, ai, m); const float rs = EPI_RS(ss, row);
                    bf16_t* p = Z + (size_t)row * ZMW + u.pn * 128 + EPI_COLW;
                    float h[8];
#pragma unroll
                    for (int n = 0; n < 2; ++n)
#pragma unroll
                        for (int j = 0; j < 4; ++j) h[n * 4 + j] = rs * acc[ai][0][m][n][j] * sigmoidf_(rs * acc[ai][1][m][n][j]);
                    *(u32x4*)p = pack8(h);
                }
        } else {
#pragma unroll
            for (int ai = 0; ai < 2; ++ai)
#pragma unroll
                for (int m = 0; m < 4; ++m) {
                    const int row = EPI_ROW(u, ai, m); const float rs = EPI_RS(ss, row);
                    bf16_t* p = Z + (size_t)row * ZMW + 512 + (u.pn - 4) * 256 + EPI_COLW;
#pragma unroll
                    for (int bj = 0; bj < 2; ++bj) {
                        float h[8];
#pragma unroll
                        for (int n = 0; n < 2; ++n)
#pragma unroll
                            for (int j = 0; j < 4; ++j) h[n * 4 + j] = rs * acc[ai][bj][m][n][j];
                        *(u32x4*)(p + bj * HALF) = pack8(h);
                    }
                }
        }
    }
};
struct EpiGates {
    bf16_t* Z; const float* bias; const float* ss;
    __device__ __forceinline__ void operator()(AccRef acc, const Unit& u, int wr, int wc, int fr, int fq) const {
        const int col0 = u.pn * 256 + EPI_COLW;
        f32x4 bv[2][2];
#pragma unroll
        for (int bj = 0; bj < 2; ++bj)
#pragma unroll
            for (int n = 0; n < 2; ++n) bv[bj][n] = *(const f32x4*)(bias + col0 + bj * HALF + n * 4);
#pragma unroll
        for (int ai = 0; ai < 2; ++ai)
#pragma unroll
            for (int m = 0; m < 4; ++m) {
                const int row = EPI_ROW(u, ai, m); const float rs = EPI_RS(ss, row);
                bf16_t* p = Z + (size_t)row * ZGW + col0;
#pragma unroll
                for (int bj = 0; bj < 2; ++bj) {
                    float h[8];
#pragma unroll
                    for (int n = 0; n < 2; ++n)
#pragma unroll
                        for (int j = 0; j < 4; ++j) h[n * 4 + j] = sigmoidf_(rs * acc[ai][bj][m][n][j] + bv[bj][n][j]);
                    *(u32x4*)(p + bj * HALF) = pack8(h);
                }
            }
    }
};
struct EpiScale {
    bf16_t* O; int ldo; const float* scale;
    __device__ __forceinline__ void operator()(AccRef acc, const Unit& u, int wr, int wc, int fr, int fq) const {
        const int col0 = u.pn * 256 + EPI_COLW;
        f32x4 bv[2][2];
#pragma unroll
        for (int bj = 0; bj < 2; ++bj)
#pragma unroll
            for (int n = 0; n < 2; ++n) bv[bj][n] = *(const f32x4*)(scale + col0 + bj * HALF + n * 4);
#pragma unroll
        for (int ai = 0; ai < 2; ++ai)
#pragma unroll
            for (int m = 0; m < 4; ++m) {
                bf16_t* p = O + (size_t)EPI_ROW(u, ai, m) * ldo + col0;
#pragma unroll
                for (int bj = 0; bj < 2; ++bj) {
                    float h[8];
#pragma unroll
                    for (int n = 0; n < 2; ++n)
#pragma unroll
                        for (int j = 0; j < 4; ++j) h[n * 4 + j] = acc[ai][bj][m][n][j] * bv[bj][n][j];
                    *(u32x4*)(p + bj * HALF) = pack8(h);
                }
            }
    }
};
struct EpiRes {
    float* H; bf16_t* NBo; float* sso; float s, sw;
    __device__ __forceinline__ void operator()(AccRef acc, const Unit& u, int wr, int wc, int fr, int fq) const {
        const int col0 = u.pn * 256 + EPI_COLW;
#pragma unroll
        for (int ai = 0; ai < 2; ++ai)
#pragma unroll
            for (int m = 0; m < 4; ++m) {
                const int row = EPI_ROW(u, ai, m);
                float* p = H + (size_t)row * D + col0;
                float q = 0.f;
#pragma unroll
                for (int bj = 0; bj < 2; ++bj) {
                    float h[8];
#pragma unroll
                    for (int n = 0; n < 2; ++n) { f32x4* qp = (f32x4*)(p + bj * HALF + n * 4); f32x4 v = *qp; v += acc[ai][bj][m][n] * s; *qp = v;
#pragma unroll
                        for (int j = 0; j < 4; ++j) { h[n * 4 + j] = v[j]; q += v[j] * v[j]; } }
                    *(u32x4*)(NBo + (size_t)row * D + col0 + bj * HALF) = pack8(h);
                }
                q += __shfl_xor(q, 16); q += __shfl_xor(q, 32);
                if (fq == 0) atomicAdd(sso + row, q * sw);
            }
    }
};
struct EpiT {
    float* T;
    __device__ __forceinline__ void operator()(AccRef acc, const Unit& u, int wr, int wc, int fr, int fq) const {
        const int col0 = u.pn * 256 + EPI_COLW;
#pragma unroll
        for (int ai = 0; ai < 2; ++ai)
#pragma unroll
            for (int m = 0; m < 4; ++m) {
                float* p = T + (size_t)EPI_ROW(u, ai, m) * D + col0;
#pragma unroll
                for (int bj = 0; bj < 2; ++bj)
#pragma unroll
                    for (int n = 0; n < 2; ++n) *(f32x4*)(p + bj * HALF + n * 4) = acc[ai][bj][m][n];
            }
    }
};
struct EpiPE {
    float* H; const float* T; float s; const float* ss; bf16_t* NBo; float* sso;
    __device__ __forceinline__ void operator()(AccRef acc, const Unit& u, int wr, int wc, int fr, int fq) const {
        const int col0 = u.pn * 256 + EPI_COLW;
#pragma unroll
        for (int ai = 0; ai < 2; ++ai)
#pragma unroll
            for (int m = 0; m < 4; ++m) {
                const int row = EPI_ROW(u, ai, m); const float rs = EPI_RS(ss, row);
                const size_t off = (size_t)row * D + col0;
                float q = 0.f;
#pragma unroll
                for (int bj = 0; bj < 2; ++bj) {
                    float h[8];
#pragma unroll
                    for (int n = 0; n < 2; ++n) {
                        f32x4* qp = (f32x4*)(H + off + bj * HALF + n * 4); const f32x4 t = *(const f32x4*)(T + off + bj * HALF + n * 4); f32x4 v = *qp;
#pragma unroll
                        for (int j = 0; j < 4; ++j) { v[j] += s * sigmoidf_(rs * acc[ai][bj][m][n][j]) * t[j]; h[n * 4 + j] = v[j]; q += v[j] * v[j]; }
                        *qp = v;
                    }
                    *(u32x4*)(NBo + off + bj * HALF) = pack8(h);
                }
                q += __shfl_xor(q, 16); q += __shfl_xor(q, 32);
                if (fq == 0) atomicAdd(sso + row, q * s);
            }
    }
};
struct EpiMerge {
    const bf16_t* ZG; bf16_t* O;
    __device__ __forceinline__ void operator()(AccRef acc, const Unit& u, int wr, int wc, int fr, int fq) const {
        const int col0 = u.pn * 256 + EPI_COLW;
#pragma unroll
        for (int ai = 0; ai < 2; ++ai)
#pragma unroll
            for (int m = 0; m < 4; ++m) {
                const size_t row = (size_t)EPI_ROW(u, ai, m);
                const bf16_t* gp = ZG + row * ZGW + u.pass * 1024 + col0;
#pragma unroll
                for (int bj = 0; bj < 2; ++bj) {
                    float g0[8], f[8];
                    unpack8(*(const u32x4*)(gp + bj * HALF), g0);
                    if (u.pass < 2) {
                        float g1[8]; unpack8(*(const u32x4*)(gp + 1024 + bj * HALF), g1);
#pragma unroll
                        for (int e = 0; e < 8; ++e) f[e] = fmaxf(g0[e], 1e-30f) * __builtin_amdgcn_rcpf(fmaxf(g1[e], 1e-30f));
                    } else {
#pragma unroll
                        for (int e = 0; e < 8; ++e) f[e] = fmaxf(g0[e], 1e-30f);
                    }
#pragma unroll
                    for (int n = 0; n < 2; ++n)
#pragma unroll
                        for (int j = 0; j < 4; ++j) acc[ai][bj][m][n][j] *= f[n * 4 + j];
                    if (u.pass == 2) {
                        float h[8];
#pragma unroll
                        for (int n = 0; n < 2; ++n)
#pragma unroll
                            for (int j = 0; j < 4; ++j) h[n * 4 + j] = acc[ai][bj][m][n][j];
                        *(u32x4*)(O + row * D + col0 + bj * HALF) = pack8(h);
                    }
                }
            }
    }
};
}

struct Args { const float* in[35]; float* out; unsigned char* ws; int ph_lo, ph_hi; };
static_assert(sizeof(Args) == 35 * 8 + 8 + 8 + 8, "Args has no padding");

typedef const Args __attribute__((address_space(4)))* ArgsP;
__device__ __forceinline__ ArgsP get_args() { ArgsP p = (ArgsP)__builtin_amdgcn_kernarg_segment_ptr(); asm volatile("" : "+s"(p)); return p; }
struct Ctx {
    LAS unsigned char* lds;
    int tid, lane, wave, gw, nW, bx, gx;
    float* H; float* SS; bf16_t* W; bf16_t* PB; bf16_t* NB; bf16_t* NB2; unsigned char* BIG; bf16_t* XA; bf16_t* XB; bf16_t* XD; bf16_t* XC;
};

__device__ __forceinline__ const float* x_row(ArgsP a, int r) { return r < MP ? a->in[0] + (size_t)r * D : a->in[1] + (size_t)(r - MP) * D; }
__device__ __forceinline__ const float* p_row(const float* pp, const float* ps, int L, int r) { return r < MP ? pp + ((size_t)L * MP + r) * DPLE : ps + ((size_t)L * MS + (r - MP)) * DPLE; }

template <int MODE>
__device__ __forceinline__ void norm_phase(const Ctx& c, const float* gain) {
    const int lane = c.lane;
    ArgsP ap = get_args();
    if (MODE == 0) { for (size_t i = (size_t)c.bx * 512 + c.tid; i < (size_t)8 * M; i += (size_t)c.gx * 512) c.SS[M + i] = 0.f; }
    f32x4 gv[4];
#pragma unroll
    for (int i = 0; i < 4; ++i) gv[i] = (MODE == 2) ? *(const f32x4*)(gain + i * 256 + lane * 4) : (f32x4){1.f, 1.f, 1.f, 1.f};
    for (int r = c.gw; r < M; r += c.nW) {
        const float* src = (MODE == 0) ? x_row(ap, r) : c.H + (size_t)r * D;
        f32x4 v[4]; float ss = 0.f;
#pragma unroll
        for (int i = 0; i < 4; ++i) { v[i] = *(const f32x4*)(src + i * 256 + lane * 4); ss += v[i][0] * v[i][0] + v[i][1] * v[i][1] + v[i][2] * v[i][2] + v[i][3] * v[i][3]; }
        if (MODE == 0) {
            ss = wave_sum(ss);
            if (lane == 0) c.SS[r] = ss;
#pragma unroll
            for (int i = 0; i < 4; ++i) {
                *(f32x4*)(c.H + (size_t)r * D + i * 256 + lane * 4) = v[i];
                u32x2 w; w.x = cvt_pk_bf16(v[i][0], v[i][1]); w.y = cvt_pk_bf16(v[i][2], v[i][3]); *(u32x2*)(c.NB2 + (size_t)r * D + i * 256 + lane * 4) = w;
            }
        } else {
            const float rs = __builtin_amdgcn_rsqf(c.SS[(size_t)8 * M + r] * (1.0f / D) + EPS);
#pragma unroll
            for (int i = 0; i < 4; ++i) *(f32x4*)(c.H + (size_t)r * D + i * 256 + lane * 4) = v[i] * rs * gv[i];
        }
    }
}

__device__ __forceinline__ void prep_phase(const Ctx& c, int L) {
    ArgsP a = get_args();
    LAS unsigned* Tw = (LAS unsigned*)c.lds;
    const int tid = c.tid, lane = c.lane, wave = c.wave;
    constexpr int NITEMS = 1648;
    for (int it = c.bx; it < NITEMS; it += c.gx) {
        int r = it; const float* src; const float* gain = nullptr; int ld, K, col0, d0, kc; size_t dsto;
        if (r < 352) { const int s = r >> 2; kc = r & 3; d0 = s * 64; const int tile = d0 >> 8, w = d0 & 255, half = w >> 7, off = w & 127;
            src = (half ? a->in[8] : a->in[7]) + (size_t)L * D * FF; gain = a->in[6] + L * D; ld = FF; K = D; col0 = tile * 128 + off; dsto = W_GU1; }
        else if ((r -= 352) < 176) { const int s = r / 11; kc = r - s * 11; d0 = s * 64; src = a->in[9] + (size_t)L * FF * D; ld = D; K = FF; col0 = d0; dsto = W_D1; }
        else if ((r -= 176) < 160) { const int s = r >> 2; kc = r & 3; d0 = s * 64;
            if (d0 < 1024) { const int tile = d0 >> 8, w = d0 & 255, half = w >> 7, off = w & 127; col0 = half * 512 + tile * 128 + off; } else col0 = d0;
            src = a->in[11] + (size_t)L * D * 5632; gain = a->in[10] + L * D; ld = 5632; K = D; dsto = W_IM; }
        else if ((r -= 160) < 192) { const int s = r >> 2; kc = r & 3; d0 = s * 64; src = a->in[11] + (size_t)L * D * 5632; gain = a->in[10] + L * D; ld = 5632; K = D; col0 = 2560 + d0; dsto = W_IG; }
        else if ((r -= 192) < 32) { const int s = r >> 1; kc = r & 1; d0 = s * 64; src = a->in[17] + (size_t)L * 512 * D; ld = D; K = 512; col0 = d0; dsto = W_CA; }
        else if ((r -= 32) < 32) { const int s = r >> 1; kc = r & 1; d0 = s * 64; src = a->in[22] + (size_t)L * 512 * D; ld = D; K = 512; col0 = d0; dsto = W_SB; }
        else if ((r -= 32) < 32) { const int s = r >> 1; kc = r & 1; d0 = s * 64; src = a->in[25] + (size_t)L * 512 * D; ld = D; K = 512; col0 = d0; dsto = W_PC; }
        else if ((r -= 32) < 64) { const int s = r >> 2; kc = r & 3; d0 = s * 64; src = a->in[26] + (size_t)L * D * D; ld = D; K = D; col0 = d0; dsto = W_O; }
        else if ((r -= 64) < 352) { const int s = r >> 2; kc = r & 3; d0 = s * 64; const int tile = d0 >> 8, w = d0 & 255, half = w >> 7, off = w & 127;
            src = (half ? a->in[29] : a->in[28]) + (size_t)L * D * FF; gain = a->in[27] + L * D; ld = FF; K = D; col0 = tile * 128 + off; dsto = W_GU2; }
        else if ((r -= 352) < 176) { const int s = r / 11; kc = r - s * 11; d0 = s * 64; src = a->in[30] + (size_t)L * FF * D; ld = D; K = FF; col0 = d0; dsto = W_D2; }
        else if ((r -= 176) < 64) { const int s = r >> 2; kc = r & 3; d0 = s * 64; src = a->in[32] + (size_t)L * D * D; gain = a->in[31] + L * D; ld = D; K = D; col0 = d0; dsto = W_PG; }
        else { r -= 64; const int s = r; kc = 0; d0 = s * 64; src = a->in[33] + (size_t)L * DPLE * D; ld = D; K = DPLE; col0 = d0; dsto = W_PE; }
        const int k0 = kc * 256;
#pragma unroll 4
        for (int i2 = 0; i2 < 16; ++i2) {
            const int kp = wave * 16 + i2;
            const float* sp = src + (size_t)(k0 + 2 * kp) * ld + col0 + lane;
            float v0 = sp[0], v1 = sp[ld];
            if (gain) { v0 *= gain[k0 + 2 * kp]; v1 *= gain[k0 + 2 * kp + 1]; }
            Tw[lane * 129 + kp] = cvt_pk_bf16(v0, v1);
        }
        __syncthreads();
        bf16_t* dst = c.W + dsto;
#pragma unroll
        for (int i = 0; i < 4; ++i) {
            const int uu = tid + 512 * i, n = uu >> 5, q = uu & 31;
            u32x4 w; w.x = Tw[n * 129 + 4 * q]; w.y = Tw[n * 129 + 4 * q + 1]; w.z = Tw[n * 129 + 4 * q + 2]; w.w = Tw[n * 129 + 4 * q + 3];
            *(u32x4*)(dst + (size_t)(d0 + n) * K + k0 + 8 * q) = w;
        }
        __syncthreads();
    }
    const size_t gtid = (size_t)c.bx * 512 + tid, gstride = (size_t)c.gx * 512;
    const float* pw = a->in[23] + (size_t)L * 4 * 128 * 128;
    for (size_t i = gtid; i < 512 * 512; i += gstride) { const int n = (int)(i >> 9), k = (int)(i & 511);
        c.W[W_PBD + i] = ((n >> 7) == (k >> 7)) ? f2bf(pw[((size_t)(n >> 7) * 128 + (k & 127)) * 128 + (n & 127)]) : (bf16_t)0; }
    const float* wsrc = a->in[20] + (size_t)L * 4 * 128 * 128;
    for (size_t i = gtid; i < 65536; i += gstride) { const int ii = (int)((i >> 7) & 127), jj = (int)(i & 127); c.W[W_WS + i] = (jj <= ii) ? f2bf(wsrc[i]) : (bf16_t)0; }
    const float* pp = a->in[2]; const float* ps = a->in[3];
    for (size_t i = gtid; i < (size_t)M * 64; i += gstride) { const int r = (int)(i >> 6), c4 = (int)(i & 63);
        const f32x4 v = *(const f32x4*)(p_row(pp, ps, L, r) + c4 * 4); u32x2 w; w.x = cvt_pk_bf16(v[0], v[1]); w.y = cvt_pk_bf16(v[2], v[3]); *(u32x2*)(c.PB + (size_t)r * DPLE + c4 * 4) = w; }
}

__device__ __forceinline__ void load_bf8(const bf16_t* p, float (&x)[8]) { unpack8(*(const u32x4*)p, x); }

__device__ __forceinline__ void mix_phase(const Ctx& c, int L) {
    ArgsP a = get_args();
    const bf16_t* ZM = (const bf16_t*)c.BIG;
    const int tid = c.tid, lane = c.lane, wave = c.wave, fr = lane & 15, fq = lane >> 4;
    float* out = a->out;
    for (int b = c.bx; b < 160; b += c.gx) {
        const int row0 = b < 128 ? b * 128 : MP + (b - 128) * 64, R = b < 128 ? 128 : 64;
        LAS unsigned char* vnT = c.lds;
        const float* lg = a->in[18] + L * 512; const float* lb = a->in[19] + L * 512;
        float gch[8], bch[8];
#pragma unroll
        for (int e = 0; e < 8; ++e) { gch[e] = lg[lane + 64 * e]; bch[e] = lb[lane + 64 * e]; }
        float* vout = nullptr;
        if (b < 128) { if ((b & 63) == 63) vout = out + O_VP + ((size_t)(L * 2 + (b >> 6)) * 128) * 512; }
        else vout = out + O_VS + ((size_t)(L * 32 + (b - 128)) * 64) * 512;
        for (int grp = wave; grp < 16; grp += 8) {
            const int j0 = grp * 8;
            if (j0 >= R) {
#pragma unroll
                for (int e = 0; e < 8; ++e) *(LAS u32x4*)(vnT + (lane + 64 * e) * 272 + j0 * 2) = (u32x4){0u, 0u, 0u, 0u};
                continue;
            }
            float y[8][8];
#pragma unroll
            for (int rr = 0; rr < 8; ++rr) {
                const bf16_t* vp = ZM + (size_t)(row0 + j0 + rr) * ZMW + 1024 + lane;
                float s = 0.f;
#pragma unroll
                for (int e = 0; e < 8; ++e) { y[rr][e] = bf2f(vp[64 * e]); s += y[rr][e]; }
                const float mu = wave_sum(s) * (1.0f / 512);
                float q = 0.f;
#pragma unroll
                for (int e = 0; e < 8; ++e) { y[rr][e] -= mu; q += y[rr][e] * y[rr][e]; }
                const float rstd = __builtin_amdgcn_rsqf(wave_sum(q) * (1.0f / 512) + EPS);
#pragma unroll
                for (int e = 0; e < 8; ++e) y[rr][e] = y[rr][e] * rstd * gch[e] + bch[e];
                if (vout) {
#pragma unroll
                    for (int e = 0; e < 8; ++e) vout[(size_t)(j0 + rr) * 512 + lane + 64 * e] = y[rr][e];
                }
            }
#pragma unroll
            for (int e = 0; e < 8; ++e) {
                u32x4 w; w.x = cvt_pk_bf16(y[0][e], y[1][e]); w.y = cvt_pk_bf16(y[2][e], y[3][e]); w.z = cvt_pk_bf16(y[4][e], y[5][e]); w.w = cvt_pk_bf16(y[6][e], y[7][e]);
                *(LAS u32x4*)(vnT + (lane + 64 * e) * 272 + j0 * 2) = w;
            }
        }
        __syncthreads();
        const int ib = wave * 16, nkb = (ib + 15) / 32 + 1;
        const bf16_t* WsB = c.W + W_WS;
        const float* bs = a->in[21] + L * 512;
        for (int g = 0; g < 4; ++g) {
            bf16x8 af[4];
#pragma unroll
            for (int kb = 0; kb < 4; ++kb) af[kb] = *(const bf16x8*)(WsB + ((size_t)g * 128 + ib + fr) * 128 + kb * 32 + fq * 8);
            for (int ni = 0; ni < 8; ++ni) {
                const int col = g * 128 + ni * 16 + fr;
                f32x4 acc = (f32x4){0.f, 0.f, 0.f, 0.f};
#pragma unroll
                for (int kb = 0; kb < 4; ++kb) if (kb < nkb) {
                    const bf16x8 bfr = *(const LAS bf16x8*)(vnT + col * 272 + (kb * 32 + fq * 8) * 2);
                    acc = __builtin_amdgcn_mfma_f32_16x16x32_bf16(af[kb], bfr, acc, 0, 0, 0);
                }
#pragma unroll
                for (int jj = 0; jj < 4; ++jj) {
                    const int i = ib + fq * 4 + jj;
                    if (i < R) { const size_t r = (size_t)(row0 + i);
                        const float uv = bf2f(ZM[r * ZMW + 512 + col]);
                        c.XB[r * XW + col] = f2bf(uv * (acc[jj] + bs[g * 128 + i])); }
                }
            }
        }
        __syncthreads();
    }
    __syncthreads();
    {
        LAS float* wl = (LAS float*)c.lds; const float* wg = a->in[13] + (size_t)L * 31 * 512;
        for (int i = tid; i < 31 * 512 / 4; i += 512) *(LAS f32x4*)(wl + i * 4) = *(const f32x4*)(wg + i * 4);
    }
    __syncthreads();
    {
        const LAS float* wl = (const LAS float*)c.lds;
        float dwb[8], lng[8], lnb[8];
#pragma unroll
        for (int e = 0; e < 8; ++e) { dwb[e] = a->in[14][L * 512 + lane * 8 + e]; lng[e] = a->in[15][L * 512 + lane * 8 + e]; lnb[e] = a->in[16][L * 512 + lane * 8 + e]; }
        for (int itm = c.gw; itm < M / 4; itm += c.nW) {
            const int r0 = itm * 4;
            int seq0, trel; const float* hist = nullptr;
            if (r0 < MP) { seq0 = (r0 / SEQ) * SEQ; trel = r0 - seq0; }
            else { const int s = (r0 - MP) / DSEQ; seq0 = MP + s * DSEQ; trel = r0 - seq0; hist = a->in[4] + ((size_t)(L * 32 + s) * 30) * 512; }
            float acc[4][8];
#pragma unroll
            for (int o = 0; o < 4; ++o)
#pragma unroll
                for (int e = 0; e < 8; ++e) acc[o][e] = dwb[e];
            float xw[4][8];
            auto ldrow = [&](int ri, float (&x)[8]) {
                const int t = trel - 30 + ri;
                if (t >= 0) load_bf8(ZM + (size_t)(seq0 + t) * ZMW + lane * 8, x);
                else if (hist) { const f32x4 h0 = *(const f32x4*)(hist + (size_t)(30 + t) * 512 + lane * 8), h1 = *(const f32x4*)(hist + (size_t)(30 + t) * 512 + lane * 8 + 4);
                    x[0] = h0[0]; x[1] = h0[1]; x[2] = h0[2]; x[3] = h0[3]; x[4] = h1[0]; x[5] = h1[1]; x[6] = h1[2]; x[7] = h1[3]; }
                else {
#pragma unroll
                    for (int e = 0; e < 8; ++e) x[e] = 0.f; }
            };
            ldrow(0, xw[0]); ldrow(1, xw[1]); ldrow(2, xw[2]);
#pragma unroll 1
            for (int kk = 0; kk < 32; kk += 4) {
#pragma unroll
                for (int k4 = 0; k4 < 4; ++k4) {
                    const int k = kk + k4;
                    if (k < 31) {
                        ldrow(k + 3, xw[(k4 + 3) & 3]);
                        const f32x4 w0 = *(const LAS f32x4*)(wl + k * 512 + lane * 8), w1 = *(const LAS f32x4*)(wl + k * 512 + lane * 8 + 4);
#pragma unroll
                        for (int o = 0; o < 4; ++o) {
#pragma unroll
                            for (int e = 0; e < 4; ++e) { acc[o][e] += xw[(k4 + o) & 3][e] * w0[e]; acc[o][e + 4] += xw[(k4 + o) & 3][e + 4] * w1[e]; }
                        }
                    }
                }
            }
#pragma unroll
            for (int o = 0; o < 4; ++o) {
                float s = 0.f;
#pragma unroll
                for (int e = 0; e < 8; ++e) s += acc[o][e];
                const float mu = wave_sum(s) * (1.0f / 512);
                float q = 0.f;
#pragma unroll
                for (int e = 0; e < 8; ++e) { acc[o][e] -= mu; q += acc[o][e] * acc[o][e]; }
                const float rstd = __builtin_amdgcn_rsqf(wave_sum(q) * (1.0f / 512) + EPS);
                float h[8];
#pragma unroll
                for (int e = 0; e < 8; ++e) { const float yv = acc[o][e] * rstd * lng[e] + lnb[e]; h[e] = yv * sigmoidf_(yv); }
                *(u32x4*)(c.XA + (size_t)(r0 + o) * XW + lane * 8) = pack8(h);
            }
        }
    }
    {
        const int win = 2 << (lane >> 4);
        for (int itm = c.gw; itm < M / 4; itm += c.nW) {
            const int r0 = itm * 4;
            int seq0, trel; const float* hist = nullptr;
            if (r0 < MP) { seq0 = (r0 / SEQ) * SEQ; trel = r0 - seq0; }
            else { const int s = (r0 - MP) / DSEQ; seq0 = MP + s * DSEQ; trel = r0 - seq0; hist = a->in[5] + ((size_t)(L * 32 + s) * 15) * 512; }
            float acc[4][8], cur[4][8];
#pragma unroll
            for (int o = 0; o < 4; ++o)
#pragma unroll
                for (int e = 0; e < 8; ++e) { acc[o][e] = 0.f; cur[o][e] = 0.f; }
#pragma unroll
            for (int ri = 0; ri < 19; ++ri) {
                const int t = trel - 15 + ri;
                float x[8];
                if (t >= 0) load_bf8(ZM + (size_t)(seq0 + t) * ZMW + 1536 + lane * 8, x);
                else if (hist) { const f32x4 h0 = *(const f32x4*)(hist + (size_t)(15 + t) * 512 + lane * 8), h1 = *(const f32x4*)(hist + (size_t)(15 + t) * 512 + lane * 8 + 4);
                    x[0] = h0[0]; x[1] = h0[1]; x[2] = h0[2]; x[3] = h0[3]; x[4] = h1[0]; x[5] = h1[1]; x[6] = h1[2]; x[7] = h1[3]; }
                else {
#pragma unroll
                    for (int e = 0; e < 8; ++e) x[e] = 0.f; }
#pragma unroll
                for (int o = 0; o < 4; ++o) {
                    const int dd = 15 + o - ri;
                    if (dd >= 0 && dd < 16) {
                        const bool inw = dd < win;
#pragma unroll
                        for (int e = 0; e < 8; ++e) acc[o][e] += inw ? x[e] : 0.f;
                        if (dd == 0) {
#pragma unroll
                            for (int e = 0; e < 8; ++e) cur[o][e] = x[e];
                        }
                    }
                }
            }
#pragma unroll
            for (int o = 0; o < 4; ++o) {
                const int cnt = hist ? win : min(trel + o + 1, win);
                const float inv = 1.0f / (float)cnt;
                float h[8];
#pragma unroll
                for (int e = 0; e < 8; ++e) h[e] = acc[o][e] * inv - cur[o][e];
                *(u32x4*)(c.XD + (size_t)(r0 + o) * XW + lane * 8) = pack8(h);
            }
        }
    }
    for (int idx = c.gw; idx < 34 * 45; idx += c.nW) {
        const int seq = idx / 45, k = idx - seq * 45;
        size_t srow; float* dst; int coff;
        if (k < 30) { coff = 0;
            if (seq < 2) { srow = (size_t)seq * SEQ + (SEQ - 30) + k; dst = out + O_CONVP + ((size_t)(L * 2 + seq) * 30 + k) * 512; }
            else { srow = (size_t)MP + (seq - 2) * DSEQ + (DSEQ - 30) + k; dst = out + O_CONVS + ((size_t)(L * 32 + seq - 2) * 30 + k) * 512; }
        } else { const int kk = k - 30; coff = 1536;
            if (seq < 2) { srow = (size_t)seq * SEQ + (SEQ - 15) + kk; dst = out + O_POOLP + ((size_t)(L * 2 + seq) * 15 + kk) * 512; }
            else { srow = (size_t)MP + (seq - 2) * DSEQ + (DSEQ - 15) + kk; dst = out + O_POOLS + ((size_t)(L * 32 + seq - 2) * 15 + kk) * 512; }
        }
        float x[8]; load_bf8(ZM + srow * ZMW + coff + lane * 8, x);
        *(f32x4*)(dst + lane * 8) = (f32x4){x[0], x[1], x[2], x[3]}; *(f32x4*)(dst + lane * 8 + 4) = (f32x4){x[4], x[5], x[6], x[7]};
    }
    __syncthreads();
}


#define XB_TMO      128
#define XB_XCNT(j)  (256  + 64 * (j))
#define XB_XSUB(j)  (1280 + 64 * (j))
#define XB_XGEN(j)  (2304 + 64 * (j))
#define XB_TOP      3328
#define XB_TOPGEN   3392
#define XCD_BAR_WORDS 3456
#define XB_SPIN_CAP (1u << 22)
__device__ __forceinline__ unsigned xb_ld(unsigned* p)              { return __hip_atomic_load(p, __ATOMIC_RELAXED, __HIP_MEMORY_SCOPE_AGENT); }
__device__ __forceinline__ unsigned xb_add(unsigned* p, unsigned v) { return __hip_atomic_fetch_add(p, v, __ATOMIC_RELAXED, __HIP_MEMORY_SCOPE_AGENT); }
__device__ __forceinline__ unsigned xb_xcc_id() { return (unsigned)__builtin_amdgcn_s_getreg((3 << 11) | 20) & 0xFu; }
#define XB_SPIN(cond, bar) do { unsigned _sp = 0; while (cond) { __builtin_amdgcn_s_sleep(1); \
    if ((++_sp & 255u) == 0u) { if (xb_ld(&(bar)[XB_TMO])) break; if (_sp > XB_SPIN_CAP) { atomicAdd(&(bar)[XB_TMO], 1u); break; } } } } while (0)
__device__ __forceinline__ void xcd_barrier_complete(unsigned* bar, unsigned x, unsigned& nloc, unsigned& nx) {
    const unsigned G = gridDim.x * gridDim.y * gridDim.z;
    unsigned sum, cnt, mine, sp = 0u;
    for (;;) {
        sum = 0u; cnt = 0u; mine = 0u;
#pragma unroll
        for (unsigned j = 0; j < 16; ++j) { const unsigned c = xb_ld(&bar[XB_XCNT(j)]); sum += c; cnt += (c > 0u) ? 1u : 0u; mine = (j == x) ? c : mine; }
        if (sum == G) break;
        __builtin_amdgcn_s_sleep(1);
        if ((++sp & 255u) == 0u) { if (xb_ld(&bar[XB_TMO])) break; if (sp > XB_SPIN_CAP) { atomicAdd(&bar[XB_TMO], 1u); break; } }
    }
    nloc = mine > 0u ? mine : 1u; nx = cnt > 0u ? cnt : 1u;
}
__device__ __forceinline__ void xcd_barrier(unsigned* bar, volatile LAS unsigned* st, int tid) {
    asm volatile("s_waitcnt vmcnt(0)" ::: "memory");
    __syncthreads();
    if (tid == 0) {
        __builtin_amdgcn_s_waitcnt(0);
        const unsigned x = xb_xcc_id();
        unsigned nloc = st[0], nx = st[1];
        if (nloc == 0u) { xcd_barrier_complete(bar, x, nloc, nx); st[0] = nloc; st[1] = nx; }
        const unsigned old = xb_add(&bar[XB_XSUB(x)], 1u);
        const unsigned gen = old / nloc;
        if (old + 1u == (gen + 1u) * nloc) {
            __builtin_amdgcn_fence(__ATOMIC_RELEASE, "agent");
            asm volatile("s_waitcnt vmcnt(0)" ::: "memory");
            const unsigned og = xb_add(&bar[XB_TOP], 1u);
            const unsigned tg = og / nx;
            if (og + 1u == (tg + 1u) * nx) xb_add(&bar[XB_TOPGEN], 1u);
            else XB_SPIN(xb_ld(&bar[XB_TOPGEN]) == tg, bar);
            __builtin_amdgcn_fence(__ATOMIC_ACQUIRE, "agent");
            xb_add(&bar[XB_XGEN(x)], 1u);
            asm volatile("s_waitcnt vmcnt(0)" ::: "memory");
        } else {
            XB_SPIN(xb_ld(&bar[XB_XGEN(x)]) == gen, bar);
            __builtin_amdgcn_fence(__ATOMIC_ACQUIRE, "agent");
            asm volatile("s_waitcnt vmcnt(0)" ::: "memory");
        }
    }
    __syncthreads();
}

constexpr int NPT = 11;
constexpr int P0N = 1 + (int)(REP_MASK & 1u), PPL = NPT + __builtin_popcount((REP_MASK >> 1) & ((1u << NPT) - 1u)), NPHASE = P0N + PPL * NLAYER;

__global__ void __launch_bounds__(512, 2) fwd_kernel(Args args) {
    extern __shared__ __attribute__((aligned(16))) unsigned char lds_raw[];
    (void)args;
    LAS unsigned char* lds = (LAS unsigned char*)lds_raw;
    const int wave0 = __builtin_amdgcn_readfirstlane((int)threadIdx.x >> 6);
    const int hi = get_args()->ph_hi;
    volatile LAS unsigned* bst = (volatile LAS unsigned*)(lds + LDS_BYTES - 16);
    unsigned* bar = (unsigned*)(get_args()->ws + WS_BAR);
    if (threadIdx.x == 0) { bst[0] = 0u; bst[1] = 0u; (void)xb_add(&bar[XB_XCNT(xb_xcc_id())], 1u); }
    __syncthreads();
#define MKCTX() Ctx c; { ArgsP ka = get_args(); int t_; asm volatile("v_mbcnt_lo_u32_b32 %0, -1, 0\n\tv_mbcnt_hi_u32_b32 %0, -1, %0" : "=v"(t_)); int wv_ = wave0, bx_ = (int)blockIdx.x, gx_ = (int)gridDim.x; asm volatile("" : "+s"(wv_), "+s"(bx_), "+s"(gx_)); t_ += wv_ * 64; unsigned char* ws = ka->ws; \
        c.lds = lds; c.tid = t_; c.lane = t_ & 63; c.wave = wv_; c.bx = bx_; c.gx = gx_; c.gw = bx_ * 8 + wv_; c.nW = gx_ * 8; \
        c.H = ka->out; c.SS = (float*)ws; c.NB2 = (bf16_t*)(ws + WS_NB2); c.W = (bf16_t*)(ws + WS_W); c.PB = (bf16_t*)(ws + WS_PB); c.NB = (bf16_t*)(ws + WS_NB); c.BIG = ws + WS_BIG; \
        c.XA = (bf16_t*)(ws + WS_X); c.XB = c.XA + (size_t)M * XW; c.XD = c.XB + (size_t)M * XW; c.XC = c.XD + (size_t)M * XW; } \
        bf16_t* HID = (bf16_t*)c.BIG; bf16_t* ZM = (bf16_t*)c.BIG; bf16_t* ZG = (bf16_t*)c.BIG; float* T = (float*)c.BIG; (void)HID; (void)ZM; (void)ZG; (void)T; \

#define GEMM1(EPI, Aptr, Bptr, Nn, Kk, ...) do { pg8::Gemm g{(Aptr), (Aptr), (Aptr), (Bptr), (Bptr), (Bptr)}; \
        pg8::EPI E{__VA_ARGS__}; pg8::gemm_phase<pg8::EPI, (Nn), (Kk), 1, G_ALIGN, G_SP2>(lds, c.tid, g, E); } while (0)

#pragma unroll 1
    for (int ph = get_args()->ph_lo; ph < hi; ++ph) {
        int L = 0, j = -1, rep = 0;
        if (ph < P0N) rep = ph;
        else { int q = ph - P0N; L = q / PPL; q -= L * PPL;
            for (int jj = 0; jj < NPT; ++jj) { const int cnt = 1 + (int)((REP_MASK >> (jj + 1)) & 1u); if (q < cnt) { j = jj; rep = q; break; } q -= cnt; } }
        const float rsc = rep ? 0.f : 1.f, rsh = rep ? 0.f : 0.5f;
        {
        switch (j) {
        case -1: { MKCTX(); prep_phase(c, 0); norm_phase<0>(c, nullptr); } break;
        case 0: case 7: { MKCTX(); const bool f1 = (j == 0);
            GEMM1(EpiGU, f1 ? c.NB2 : c.NB, c.W + (f1 ? W_GU1 : W_GU2), 2 * FF, D, HID, FF, c.SS + (size_t)(4 * L + (f1 ? 0 : 2)) * M); } break;
        case 1: case 8: { MKCTX(); const bool f1 = (j == 1);
            GEMM1(EpiRes, HID, c.W + (f1 ? W_D1 : W_D2), D, FF, c.H, c.NB, c.SS + (size_t)(4 * L + (f1 ? 1 : 3)) * M, rsh, rsc); } break;
        case 2: { MKCTX(); GEMM1(EpiWinMix, c.NB, c.W + W_IM, 2560, D, ZM, c.SS + (size_t)(4 * L + 1) * M); } break;
        case 3: { MKCTX(); mix_phase(c, L); } break;
        case 4: {
            { MKCTX(); GEMM1(EpiGates, c.NB, c.W + W_IG, 3072, D, ZG, get_args()->in[12] + L * 3072, c.SS + (size_t)(4 * L + 1) * M); }
            { MKCTX(); GEMM1(EpiScale, c.XD, c.W + W_PBD, 512, 512, c.XC, XW, get_args()->in[24] + L * 512); }
        } break;
        case 5: { MKCTX();
            pg8::Gemm g{c.XA, c.XB, c.XC, c.W + W_CA, c.W + W_SB, c.W + W_PC};
            pg8::EpiMerge E{ZG, c.NB2}; pg8::gemm_phase<pg8::EpiMerge, D, 512, 3, G_ALIGN, G_SP2>(lds, c.tid, g, E);
        } break;
        case 6: {
            { MKCTX(); GEMM1(EpiRes, c.NB2, c.W + W_O, D, D, c.H, c.NB, c.SS + (size_t)(4 * L + 2) * M, rsc, rsc); }
            { MKCTX(); GEMM1(EpiT, c.PB, c.W + W_PE, D, DPLE, (float*)c.XA); }
        } break;
        case 9: { MKCTX(); GEMM1(EpiPE, c.NB, c.W + W_PG, D, D, c.H, (const float*)c.XA, rsc, c.SS + (size_t)(4 * L + 3) * M, c.NB2, c.SS + (size_t)(4 * L + 4) * M); } break;
        default: { MKCTX();
            if (L + 1 < NLAYER) prep_phase(c, L + 1);
            else if (!rep) norm_phase<2>(c, get_args()->in[34]);
        } break;
        }
        }
        if (ph + 1 < hi) {
            if (ph == 0) cg::this_grid().sync();
            else { int t_; asm volatile("v_mbcnt_lo_u32_b32 %0, -1, 0\n\tv_mbcnt_hi_u32_b32 %0, -1, %0" : "=v"(t_)); xcd_barrier(bar, bst, t_ + wave0 * 64); }
        }
    }
#undef GEMM1
#undef MKCTX
}

extern "C" void kernel_launch(void* const* d_in, const int* in_sizes, int n_in, void* d_out, int out_size, void* d_ws, size_t ws_size, hipStream_t stream) {
    static int grid = 0;
    if (grid == 0) {
        if (n_in != 35 || (size_t)out_size != O_END || ws_size < WS_END) { fprintf(stderr, "kernel_launch: unexpected shapes (n_in %d, out %d, ws %zu)\n", n_in, out_size, ws_size); grid = -1; return; }
        int dev = 0, cus = 0, per_cu = 0;
        if (hipGetDevice(&dev) != hipSuccess || hipDeviceGetAttribute(&cus, hipDeviceAttributeMultiprocessorCount, dev) != hipSuccess) { grid = -1; return; }
        if (hipFuncSetAttribute((const void*)fwd_kernel, hipFuncAttributeMaxDynamicSharedMemorySize, LDS_BYTES) != hipSuccess) { fprintf(stderr, "kernel_launch: hipFuncSetAttribute failed\n"); grid = -1; return; }
        if (hipOccupancyMaxActiveBlocksPerMultiprocessor(&per_cu, (const void*)fwd_kernel, 512, LDS_BYTES) != hipSuccess || per_cu < 1) { fprintf(stderr, "kernel_launch: occupancy query says %d\n", per_cu); per_cu = 1; }
        (void)hipGetLastError();
        grid = cus * 1;
    }
    if (grid < 0) return;
    Args a{};
    for (int i = 0; i < 35; ++i) a.in[i] = (const float*)d_in[i];
    a.out = (float*)d_out; a.ws = (unsigned char*)d_ws;
#if MK_N_LAUNCHES == 1
    (void)hipMemsetAsync((char*)d_ws + WS_BAR, 0, 16384, stream);
    a.ph_lo = 0; a.ph_hi = NPHASE;
    void* kargs[] = {&a};
    hipError_t e = hipLaunchCooperativeKernel((const void*)fwd_kernel, dim3(grid), dim3(512), kargs, LDS_BYTES, stream);
    if (e != hipSuccess) fprintf(stderr, "kernel_launch: cooperative launch failed: %s (grid %d)\n", hipGetErrorString(e), grid);
#else
    for (int ph = 0; ph < NPHASE; ++ph) {
        a.ph_lo = ph; a.ph_hi = ph + 1;
        hipLaunchKernelGGL(fwd_kernel, dim3(grid), dim3(512), LDS_BYTES, stream, a);
    }
#endif
}
```

```cpp
#include <hip/hip_runtime.h>
#include <hip/hip_cooperative_groups.h>
#include <cstdio>
#include <cstdint>
namespace cg = cooperative_groups;

#ifndef MK_N_LAUNCHES
#define MK_N_LAUNCHES 1
#endif
#ifndef REP_MASK
#define REP_MASK 0u
#endif
#ifndef G_SP2
#define G_SP2 true
#endif
#ifndef G_ALIGN
#define G_ALIGN true
#endif

#define LAS __attribute__((address_space(3)))
typedef unsigned short bf16_t;
typedef short bf16x8 __attribute__((ext_vector_type(8)));
typedef float f32x4 __attribute__((ext_vector_type(4)));
typedef unsigned u32x4 __attribute__((ext_vector_type(4)));
typedef unsigned u32x2 __attribute__((ext_vector_type(2)));

constexpr int D = 1024, FF = 2816, MP = 16384, MS = 2048, M = MP + MS, SEQ = 8192, DSEQ = 64, DPLE = 256;
constexpr int NLAYER = 2;
constexpr float EPS = 1e-6f;
constexpr int ZMW = 2048, ZGW = 3072, XW = 512;
constexpr size_t O_Y = 0, O_CONVP = (size_t)M * D, O_CONVS = O_CONVP + 2 * 2 * 30 * 512, O_POOLP = O_CONVS + 2 * 32 * 30 * 512,
                 O_POOLS = O_POOLP + 2 * 2 * 15 * 512, O_VP = O_POOLS + 2 * 32 * 15 * 512, O_VS = O_VP + 2 * 2 * 128 * 512, O_END = O_VS + 2 * 32 * 64 * 512;
constexpr size_t MiB = 1u << 20;
constexpr size_t WS_BAR = 768 * 1024, WS_W = 1 * MiB, WS_PB = 54 * MiB, WS_NB = 63 * MiB, WS_BIG = 99 * MiB, WS_X = 207 * MiB, WS_NB2 = 279 * MiB, WS_END = 315 * MiB;
constexpr size_t W_GU1 = 0, W_D1 = W_GU1 + (size_t)5632 * 1024, W_IM = W_D1 + (size_t)1024 * 2816, W_IG = W_IM + (size_t)2560 * 1024,
                 W_CA = W_IG + (size_t)3072 * 1024, W_SB = W_CA + 524288, W_PC = W_SB + 524288, W_PBD = W_PC + 524288, W_O = W_PBD + 262144,
                 W_GU2 = W_O + 1048576, W_D2 = W_GU2 + (size_t)5632 * 1024, W_PG = W_D2 + (size_t)1024 * 2816, W_PE = W_PG + 1048576,
                 W_WS = W_PE + 262144, W_TOTAL = W_WS + 65536;
static_assert(W_TOTAL * 2 <= 53 * MiB, "weight region");
constexpr int LDS_BYTES = 147456;

typedef __bf16 bf16x2_t __attribute__((ext_vector_type(2)));
__device__ __forceinline__ unsigned cvt_pk_bf16(float lo, float hi) { bf16x2_t v; v[0] = (__bf16)lo; v[1] = (__bf16)hi; return __builtin_bit_cast(unsigned, v); }
__device__ __forceinline__ bf16_t f2bf(float f) { return (bf16_t)(cvt_pk_bf16(f, 0.f) & 0xffffu); }
__device__ __forceinline__ float bf2f(bf16_t b) { return __uint_as_float(((unsigned)b) << 16); }
__device__ __forceinline__ float bflo(unsigned w) { return __uint_as_float(w << 16); }
__device__ __forceinline__ float bfhi(unsigned w) { return __uint_as_float(w & 0xffff0000u); }
__device__ __forceinline__ float sigmoidf_(float x) { return __builtin_amdgcn_rcpf(1.0f + __builtin_amdgcn_exp2f(-1.4426950408889634f * x)); }
__device__ __forceinline__ float wave_sum(float v) {
#pragma unroll
    for (int o = 32; o > 0; o >>= 1) v += __shfl_xor(v, o);
    return v;
}
__device__ __forceinline__ void unpack8(const u32x4 w, float (&x)[8]) {
    x[0] = bflo(w.x); x[1] = bfhi(w.x); x[2] = bflo(w.y); x[3] = bfhi(w.y); x[4] = bflo(w.z); x[5] = bfhi(w.z); x[6] = bflo(w.w); x[7] = bfhi(w.w);
}
__device__ __forceinline__ u32x4 pack8(const float (&x)[8]) {
    u32x4 w; w.x = cvt_pk_bf16(x[0], x[1]); w.y = cvt_pk_bf16(x[2], x[3]); w.z = cvt_pk_bf16(x[4], x[5]); w.w = cvt_pk_bf16(x[6], x[7]); return w;
}

#define HANDOFF_STORE(v, rsrc, off, samel2) do { if (samel2) __builtin_amdgcn_raw_buffer_store_b128((v), (rsrc), (off), 0, 0); else __builtin_amdgcn_raw_buffer_store_b128((v), (rsrc), (off), 0, 16); } while (0)
#define SAME_L2(ldsbase) (__builtin_amdgcn_readfirstlane((int)*(volatile LAS unsigned*)((ldsbase) + LDS_BYTES - 4)) != 0)

namespace pg8 {
constexpr int BM = 256, BK = 64, HALF = 128, HTB = HALF * BK * 2, STAGE_BYTES = 8 * HTB, NXCD = 8, WGM = 8;
__device__ __forceinline__ int lds_byte(int r, int c) { const int st = (r >> 4) * 2 + (c >> 5), rr = r & 15, cc = c & 31, ob = rr * 64 + cc * 2; return st * 1024 + (ob ^ (((ob >> 9) & 1) << 5)); }
__device__ __forceinline__ void stage_rc(int b, int& R, int& C) { const int st = b / 1024, sb = b % 1024, swz = sb ^ (((sb >> 9) & 1) << 5); R = (st >> 1) * 16 + swz / 64; C = (st & 1) * 32 + (swz % 64) / 2; }
__device__ __forceinline__ int perm32(int rho) { const int n = rho >> 4, i = rho & 15; return 8 * (i >> 2) + 4 * n + (i & 3); }

struct Unit { int pm, pn, pass; };
struct Gemm { const bf16_t* A0; const bf16_t* A1; const bf16_t* A2; const bf16_t* B0; const bf16_t* B1; const bf16_t* B2; };
template <int N_, int NPASS>
struct Sched {
    static constexpr int nM = 18432 / BM, nN = N_ / BM, nwg = nM * nN;
    __device__ __forceinline__ static bool next(int i, int G, int c, Unit& u) {
        const int ti = i / NPASS; u.pass = i - ti * NPASS;
        const int L = ti * G + c; if (L >= nwg) return false;
        int wgid = L; { constexpr int q = nwg / NXCD, r = nwg % NXCD; const int xcd = wgid % NXCD, off = wgid / NXCD; wgid = (xcd < r ? xcd * (q + 1) : r * (q + 1) + (xcd - r) * q) + off; }
        constexpr int nig = WGM * nN; const int gid = wgid / nig, fm = gid * WGM, gsz = (nM - fm) < WGM ? (nM - fm) : WGM;
        u.pm = fm + ((wgid % nig) % gsz); u.pn = (wgid % nig) / gsz; return true;
    }
};
template <class Epi, int N_, int K, int NPASS, bool ALIGN_EPI, bool SP2, bool ONE = false>
__device__ __forceinline__ void gemm_phase(LAS unsigned char* lds, int tid_in, const Gemm g, const Epi& E, int one_pm = 0, int one_pn = 0) {
    typedef Sched<N_, NPASS> S;
#define PG8_NEXT(i, u) (ONE ? ((i) < NPASS ? ((u).pm = one_pm, (u).pn = one_pn, (u).pass = (i), true) : false) : S::next((i), sG, sC, (u)))
    int tid_ = tid_in; asm volatile("" : "+v"(tid_));
    const int tid = tid_, wid = __builtin_amdgcn_readfirstlane(tid >> 6), lane = tid & 63, wr = wid >> 2, wc = wid & 3, fr = lane & 15, fq = lane >> 4;
    constexpr int nt = K / BK;
    unsigned voffA[2], voffB[2];
#pragma unroll
    for (int i = 0; i < 2; ++i) { int R, C; stage_rc(tid * 16 + i * 8192, R, C); const int Rb = (R & ~31) + perm32(R & 31);
        voffA[i] = (unsigned)(R * K + C) * 2u; voffB[i] = (unsigned)(Rb * K + C) * 2u; }
    constexpr size_t kstep = (size_t)(BK * 2);
    constexpr size_t hstep = (size_t)HALF * K * 2;
    constexpr size_t tstep = 2 * hstep;
    const unsigned ldsw = (unsigned)wid * 1024u;
    const int aoff = lds_byte(wr * 64 + fr, fq * 8), boff = lds_byte(wc * 32 + fr, fq * 8);
#define PG8_SA(b, h) (((b) * 2 + (h)) * HTB)
#define PG8_SB(b, h) ((4 + (b) * 2 + (h)) * HTB)
#define PG8_STAGE(bufoff, gbase, voff) do { _Pragma("unroll") for (int _i = 0; _i < 2; ++_i) \
        __builtin_amdgcn_global_load_lds((const unsigned*)((const char*)(gbase) + (voff)[_i]), (LAS unsigned*)(lds + (bufoff) + ldsw + _i * 8192), 16, 0, 0); } while (0)
#define PG8_LDA(dst, b, h) do { _Pragma("unroll") for (int m = 0; m < 4; ++m) _Pragma("unroll") for (int k = 0; k < 2; ++k) dst[m][k] = *(const LAS bf16x8*)(lds + PG8_SA(b, h) + aoff + m * 2048 + k * 1024); } while (0)
#define PG8_LDB(dst, b, h) do { _Pragma("unroll") for (int n = 0; n < 2; ++n) _Pragma("unroll") for (int k = 0; k < 2; ++k) dst[n][k] = *(const LAS bf16x8*)(lds + PG8_SB(b, h) + boff + n * 2048 + k * 1024); } while (0)
#define PG8_MMA(ai, bj, At, Bt) do { __builtin_amdgcn_s_setprio(1); _Pragma("unroll") for (int m = 0; m < 4; ++m) _Pragma("unroll") for (int n = 0; n < 2; ++n) _Pragma("unroll") for (int k = 0; k < 2; ++k) \
        acc[ai][bj][m][n] = __builtin_amdgcn_mfma_f32_16x16x32_bf16(Bt[n][k], At[m][k], acc[ai][bj][m][n], 0, 0, 0); __builtin_amdgcn_s_setprio(0); } while (0)
#define PG8_WAIT_V(n) asm volatile("s_waitcnt vmcnt(" #n ")" ::: "memory")
#define PG8_WAIT_L(n) asm volatile("s_waitcnt lgkmcnt(" #n ")" ::: "memory")
#define PG8_BAR __builtin_amdgcn_s_barrier()
#define PG8_SCHED __builtin_amdgcn_sched_barrier(0)
#define PG8_ABASE(u) ((const char*)((u).pass == 0 ? g.A0 : ((u).pass == 1 ? g.A1 : g.A2)))
#define PG8_BBASE(u) ((const char*)((u).pass == 0 ? g.B0 : ((u).pass == 1 ? g.B1 : g.B2)))
    Unit cur, nxt; int ui = 0;
    int sG = (int)gridDim.x, sC = (int)__builtin_amdgcn_readfirstlane((int)*(volatile LAS unsigned*)(lds + LDS_BYTES - 8)); asm volatile("" : "+s"(sG), "+s"(sC));
    if (!PG8_NEXT(0, cur)) return;
    f32x4 acc[2][2][4][2];
#pragma unroll
    for (int a = 0; a < 2; ++a)
#pragma unroll
        for (int b = 0; b < 2; ++b)
#pragma unroll
            for (int m = 0; m < 4; ++m)
#pragma unroll
                for (int n = 0; n < 2; ++n) acc[a][b][m][n] = (f32x4){0.f, 0.f, 0.f, 0.f};
    bf16x8 At[4][2], B0[2][2], B1[2][2];
    const char* cA = PG8_ABASE(cur) + (size_t)cur.pm * tstep; const char* cB = PG8_BBASE(cur) + (size_t)cur.pn * tstep;
    if constexpr (SP2) {
        PG8_STAGE(PG8_SB(0, 0), cB, voffB); PG8_STAGE(PG8_SB(0, 1), cB + hstep, voffB); PG8_STAGE(PG8_SA(0, 0), cA, voffA); PG8_STAGE(PG8_SA(0, 1), cA + hstep, voffA);
        if (wr == 1) PG8_BAR;
        PG8_WAIT_V(2); PG8_BAR;
        PG8_STAGE(PG8_SB(1, 0), cB + kstep, voffB); PG8_STAGE(PG8_SA(1, 0), cA + kstep, voffA); PG8_STAGE(PG8_SB(1, 1), cB + hstep + kstep, voffB);
        PG8_WAIT_V(6); PG8_BAR;
    } else {
        PG8_STAGE(PG8_SB(0, 0), cB, voffB); PG8_STAGE(PG8_SA(0, 0), cA, voffA); PG8_STAGE(PG8_SB(0, 1), cB + hstep, voffB); PG8_STAGE(PG8_SA(0, 1), cA + hstep, voffA);
        if (wr == 1) PG8_BAR;
        PG8_WAIT_V(4); PG8_BAR;
        PG8_STAGE(PG8_SB(1, 0), cB + kstep, voffB); PG8_STAGE(PG8_SA(1, 0), cA + kstep, voffA); PG8_STAGE(PG8_SB(1, 1), cB + hstep + kstep, voffB);
        PG8_WAIT_V(6); PG8_BAR;
    }
    for (;;) {
        const bool has_next = PG8_NEXT(ui + 1, nxt);
        const char* nA = has_next ? PG8_ABASE(nxt) + (size_t)nxt.pm * tstep : cA; const char* nB = has_next ? PG8_BBASE(nxt) + (size_t)nxt.pn * tstep : cB;
#pragma unroll 1
        for (int t = 0; t < nt; t += 2) {
            const bool last = (t == nt - 2);
            const char* a1 = cA + (size_t)(t + 1) * kstep;
            const char* a2 = last ? nA : cA + (size_t)(t + 2) * kstep; const char* b2 = last ? nB : cB + (size_t)(t + 2) * kstep;
            const char* a3 = a2 + kstep; const char* b3 = b2 + kstep;
            if constexpr (SP2) {
            PG8_LDB(B0, 0, 0); PG8_LDB(B1, 0, 1); PG8_SCHED; PG8_LDA(At, 0, 0); PG8_STAGE(PG8_SA(1, 1), a1 + hstep, voffA);
            PG8_WAIT_V(8); PG8_WAIT_L(0); PG8_BAR; PG8_MMA(0, 0, At, B0); PG8_MMA(0, 1, At, B1); PG8_BAR; PG8_SCHED;
            PG8_LDA(At, 0, 1); PG8_STAGE(PG8_SB(0, 0), b2, voffB); PG8_STAGE(PG8_SB(0, 1), b2 + hstep, voffB); PG8_STAGE(PG8_SA(0, 0), a2, voffA);
            PG8_WAIT_V(8); PG8_WAIT_L(0); PG8_BAR; PG8_MMA(1, 0, At, B0); PG8_MMA(1, 1, At, B1); PG8_BAR; PG8_SCHED;
            PG8_LDB(B0, 1, 0); PG8_LDB(B1, 1, 1); PG8_SCHED; PG8_LDA(At, 1, 0); PG8_STAGE(PG8_SA(0, 1), a2 + hstep, voffA);
            PG8_WAIT_V(8); PG8_WAIT_L(0); PG8_BAR; PG8_MMA(0, 0, At, B0); PG8_MMA(0, 1, At, B1); PG8_BAR; PG8_SCHED;
            PG8_LDA(At, 1, 1); PG8_STAGE(PG8_SB(1, 0), b3, voffB); PG8_STAGE(PG8_SB(1, 1), b3 + hstep, voffB); PG8_STAGE(PG8_SA(1, 0), a3, voffA);
            PG8_WAIT_V(8); PG8_WAIT_L(0); PG8_BAR; PG8_MMA(1, 0, At, B0); PG8_MMA(1, 1, At, B1); PG8_BAR; PG8_SCHED;
            } else {
            PG8_LDB(B0, 0, 0); PG8_SCHED; PG8_LDA(At, 0, 0); PG8_STAGE(PG8_SA(1, 1), a1 + hstep, voffA);
            PG8_WAIT_L(8); PG8_BAR; PG8_WAIT_L(0); PG8_MMA(0, 0, At, B0); PG8_BAR; PG8_SCHED;
            PG8_LDB(B1, 0, 1); PG8_STAGE(PG8_SB(0, 0), b2, voffB);
            PG8_BAR; PG8_WAIT_L(0); PG8_MMA(0, 1, At, B1); PG8_BAR;
            PG8_LDA(At, 0, 1); PG8_STAGE(PG8_SA(0, 0), a2, voffA);
            PG8_BAR; PG8_WAIT_L(0); PG8_MMA(1, 0, At, B0); PG8_BAR; PG8_SCHED;
            PG8_STAGE(PG8_SB(0, 1), b2 + hstep, voffB);
            PG8_WAIT_V(6); PG8_BAR; PG8_MMA(1, 1, At, B1); PG8_BAR;
            PG8_LDB(B0, 1, 0); PG8_SCHED; PG8_LDA(At, 1, 0); PG8_STAGE(PG8_SA(0, 1), a2 + hstep, voffA);
            PG8_WAIT_L(8); PG8_BAR; PG8_WAIT_L(0); PG8_MMA(0, 0, At, B0); PG8_BAR; PG8_SCHED;
            PG8_LDB(B1, 1, 1); PG8_STAGE(PG8_SB(1, 0), b3, voffB);
            PG8_BAR; PG8_WAIT_L(0); PG8_MMA(0, 1, At, B1); PG8_BAR;
            PG8_LDA(At, 1, 1); PG8_STAGE(PG8_SA(1, 0), a3, voffA);
            PG8_BAR; PG8_WAIT_L(0); PG8_MMA(1, 0, At, B0); PG8_BAR; PG8_SCHED;
            PG8_STAGE(PG8_SB(1, 1), b3 + hstep, voffB);
            PG8_WAIT_V(6); PG8_BAR; PG8_MMA(1, 1, At, B1); PG8_BAR;
            }
        }
        if constexpr (ALIGN_EPI) { if (wr == 0) PG8_BAR; }
        E(acc, cur, wr, wc, fr, fq);
        if (!has_next) break;
        if (nxt.pass == 0) {
#pragma unroll
        for (int a = 0; a < 2; ++a)
#pragma unroll
            for (int b = 0; b < 2; ++b)
#pragma unroll
                for (int m = 0; m < 4; ++m)
#pragma unroll
                    for (int n = 0; n < 2; ++n) acc[a][b][m][n] = (f32x4){0.f, 0.f, 0.f, 0.f};
        }
        cur = nxt; cA = nA; cB = nB; ++ui;
        if constexpr (ALIGN_EPI) { if (wr == 1) PG8_BAR; }
    }
    PG8_WAIT_V(0);
    if constexpr (!ALIGN_EPI) { if (wr == 0) PG8_BAR; }
    PG8_BAR;
#undef PG8_SA
#undef PG8_SB
#undef PG8_STAGE
#undef PG8_LDA
#undef PG8_LDB
#undef PG8_MMA
#undef PG8_WAIT_V
#undef PG8_WAIT_L
#undef PG8_BAR
#undef PG8_SCHED
#undef PG8_ABASE
#undef PG8_BBASE
#undef PG8_NEXT
}

typedef f32x4 (&AccRef)[2][2][4][2];
#define EPI_ROW(u, ai, m) ((u).pm * BM + (ai) * HALF + wr * 64 + (m) * 16 + fr)
#define EPI_COLW (wc * 32 + fq * 8)

#define EPI_RS(ss, row) __builtin_amdgcn_rsqf((ss)[row] * (1.0f / 1024.0f) + 1e-6f)
struct EpiGU {
    bf16_t* O; int ldo; const float* ss;
    __device__ __forceinline__ void operator()(AccRef acc, const Unit& u, int wr, int wc, int fr, int fq) const {
#pragma unroll
        for (int ai = 0; ai < 2; ++ai)
#pragma unroll
            for (int m = 0; m < 4; ++m) {
                const int row = EPI_ROW(u, ai, m); const float rs = EPI_RS(ss, row);
                bf16_t* p = O + (size_t)row * ldo + u.pn * 128 + EPI_COLW;
                float h[8];
#pragma unroll
                for (int n = 0; n < 2; ++n)
#pragma unroll
                    for (int j = 0; j < 4; ++j) { const float gt = rs * acc[ai][0][m][n][j], up = rs * acc[ai][1][m][n][j]; h[n * 4 + j] = gt * sigmoidf_(gt) * up; }
                *(u32x4*)p = pack8(h);
            }
    }
};
struct EpiWinMix {
    bf16_t* Z; const float* ss;
    __device__ __forceinline__ void operator()(AccRef acc, const Unit& u, int wr, int wc, int fr, int fq) const {
        if (u.pn < 4) {
#pragma unroll
            for (int ai = 0; ai < 2; ++ai)
#pragma unroll
                for (int m = 0; m < 4; ++m) {
                    const int row = EPI_ROW(u, ai, m); const float rs = EPI_RS(ss, row);
                    bf16_t* p = Z + (size_t)row * ZMW + u.pn * 128 + EPI_COLW;
                    float h[8];
#pragma unroll
                    for (int n = 0; n < 2; ++n)
#pragma unroll
                        for (int j = 0; j < 4; ++j) h[n * 4 + j] = rs * acc[ai][0][m][n][j] * sigmoidf_(rs * acc[ai][1][m][n][j]);
                    *(u32x4*)p = pack8(h);
                }
        } else {
#pragma unroll
            for (int ai = 0; ai < 2; ++ai)
#pragma unroll
                for (int m = 0; m < 4; ++m) {
                    const int row = EPI_ROW(u, ai, m); const float rs = EPI_RS(ss, row);
                    bf16_t* p = Z + (size_t)row * ZMW + 512 + (u.pn - 4) * 256 + EPI_COLW;
#pragma unroll
                    for (int bj = 0; bj < 2; ++bj) {
                        float h[8];
#pragma unroll
                        for (int n = 0; n < 2; ++n)
#pragma unroll
                            for (int j = 0; j < 4; ++j) h[n * 4 + j] = rs * acc[ai][bj][m][n][j];
                        *(u32x4*)(p + bj * HALF) = pack8(h);
                    }
                }
        }
    }
};
struct EpiGates {
    bf16_t* Z; const float* bias; const float* ss;
    __device__ __forceinline__ void operator()(AccRef acc, const Unit& u, int wr, int wc, int fr, int fq) const {
        const int col0 = u.pn * 256 + EPI_COLW;
        f32x4 bv[2][2];
#pragma unroll
        for (int bj = 0; bj < 2; ++bj)
#pragma unroll
            for (int n = 0; n < 2; ++n) bv[bj][n] = *(const f32x4*)(bias + col0 + bj * HALF + n * 4);
#pragma unroll
        for (int ai = 0; ai < 2; ++ai)
#pragma unroll
            for (int m = 0; m < 4; ++m) {
                const int row = EPI_ROW(u, ai, m); const float rs = EPI_RS(ss, row);
                bf16_t* p = Z + (size_t)row * ZGW + col0;
#pragma unroll
                for (int bj = 0; bj < 2; ++bj) {
                    float h[8];
#pragma unroll
                    for (int n = 0; n < 2; ++n)
#pragma unroll
                        for (int j = 0; j < 4; ++j) h[n * 4 + j] = sigmoidf_(rs * acc[ai][bj][m][n][j] + bv[bj][n][j]);
                    *(u32x4*)(p + bj * HALF) = pack8(h);
                }
            }
    }
};
struct EpiScale {
    bf16_t* O; int ldo; const float* scale;
    __device__ __forceinline__ void operator()(AccRef acc, const Unit& u, int wr, int wc, int fr, int fq) const {
        const int col0 = u.pn * 256 + EPI_COLW;
        f32x4 bv[2][2];
#pragma unroll
        for (int bj = 0; bj < 2; ++bj)
#pragma unroll
            for (int n = 0; n < 2; ++n) bv[bj][n] = *(const f32x4*)(scale + col0 + bj * HALF + n * 4);
#pragma unroll
        for (int ai = 0; ai < 2; ++ai)
#pragma unroll
            for (int m = 0; m < 4; ++m) {
                bf16_t* p = O + (size_t)EPI_ROW(u, ai, m) * ldo + col0;
#pragma unroll
                for (int bj = 0; bj < 2; ++bj) {
                    float h[8];
#pragma unroll
                    for (int n = 0; n < 2; ++n)
#pragma unroll
                        for (int j = 0; j < 4; ++j) h[n * 4 + j] = acc[ai][bj][m][n][j] * bv[bj][n][j];
                    *(u32x4*)(p + bj * HALF) = pack8(h);
                }
            }
    }
};
struct EpiRes {
    float* H; bf16_t* NBo; float* sso; float s, sw;
    __device__ __forceinline__ void operator()(AccRef acc, const Unit& u, int wr, int wc, int fr, int fq) const {
        const int col0 = u.pn * 256 + EPI_COLW;
#pragma unroll
        for (int ai = 0; ai < 2; ++ai)
#pragma unroll
            for (int m = 0; m < 4; ++m) {
                const int row = EPI_ROW(u, ai, m);
                float* p = H + (size_t)row * D + col0;
                float q = 0.f;
#pragma unroll
                for (int bj = 0; bj < 2; ++bj) {
                    float h[8];
#pragma unroll
                    for (int n = 0; n < 2; ++n) { f32x4* qp = (f32x4*)(p + bj * HALF + n * 4); f32x4 v = *qp; v += acc[ai][bj][m][n] * s; *qp = v;
#pragma unroll
                        for (int j = 0; j < 4; ++j) { h[n * 4 + j] = v[j]; q += v[j] * v[j]; } }
                    *(u32x4*)(NBo + (size_t)row * D + col0 + bj * HALF) = pack8(h);
                }
                q += __shfl_xor(q, 16); q += __shfl_xor(q, 32);
                if (fq == 0) atomicAdd(sso + row, q * sw);
            }
    }
};
struct EpiT {
    float* T;
    __device__ __forceinline__ void operator()(AccRef acc, const Unit& u, int wr, int wc, int fr, int fq) const {
        const int col0 = u.pn * 256 + EPI_COLW;
#pragma unroll
        for (int ai = 0; ai < 2; ++ai)
#pragma unroll
            for (int m = 0; m < 4; ++m) {
                float* p = T + (size_t)EPI_ROW(u, ai, m) * D + col0;
#pragma unroll
                for (int bj = 0; bj < 2; ++bj)
#pragma unroll
                    for (int n = 0; n < 2; ++n) *(f32x4*)(p + bj * HALF + n * 4) = acc[ai][bj][m][n];
            }
    }
};
struct EpiPE {
    float* H; const float* T; float s; const float* ss; bf16_t* NBo; float* sso;
    __device__ __forceinline__ void operator()(AccRef acc, const Unit& u, int wr, int wc, int fr, int fq) const {
        const int col0 = u.pn * 256 + EPI_COLW;
#pragma unroll
        for (int ai = 0; ai < 2; ++ai)
#pragma unroll
            for (int m = 0; m < 4; ++m) {
                const int row = EPI_ROW(u, ai, m); const float rs = EPI_RS(ss, row);
                const size_t off = (size_t)row * D + col0;
                float q = 0.f;
#pragma unroll
                for (int bj = 0; bj < 2; ++bj) {
                    float h[8];
#pragma unroll
                    for (int n = 0; n < 2; ++n) {
                        f32x4* qp = (f32x4*)(H + off + bj * HALF + n * 4); const f32x4 t = *(const f32x4*)(T + off + bj * HALF + n * 4); f32x4 v = *qp;
#pragma unroll
                        for (int j = 0; j < 4; ++j) { v[j] += s * sigmoidf_(rs * acc[ai][bj][m][n][j]) * t[j]; h[n * 4 + j] = v[j]; q += v[j] * v[j]; }
                        *qp = v;
                    }
                    *(u32x4*)(NBo + off + bj * HALF) = pack8(h);
                }
                q += __shfl_xor(q, 16); q += __shfl_xor(q, 32);
                if (fq == 0) atomicAdd(sso + row, q * s);
            }
    }
};
struct EpiMerge {
    const bf16_t* ZG; bf16_t* O;
    __device__ __forceinline__ void operator()(AccRef acc, const Unit& u, int wr, int wc, int fr, int fq) const {
        const int col0 = u.pn * 256 + EPI_COLW;
#pragma unroll
        for (int ai = 0; ai < 2; ++ai)
#pragma unroll
            for (int m = 0; m < 4; ++m) {
                const size_t row = (size_t)EPI_ROW(u, ai, m);
                const bf16_t* gp = ZG + row * ZGW + u.pass * 1024 + col0;
#pragma unroll
                for (int bj = 0; bj < 2; ++bj) {
                    float g0[8], f[8];
                    unpack8(*(const u32x4*)(gp + bj * HALF), g0);
                    if (u.pass < 2) {
                        float g1[8]; unpack8(*(const u32x4*)(gp + 1024 + bj * HALF), g1);
#pragma unroll
                        for (int e = 0; e < 8; ++e) f[e] = fmaxf(g0[e], 1e-30f) * __builtin_amdgcn_rcpf(fmaxf(g1[e], 1e-30f));
                    } else {
#pragma unroll
                        for (int e = 0; e < 8; ++e) f[e] = fmaxf(g0[e], 1e-30f);
                    }
#pragma unroll
                    for (int n = 0; n < 2; ++n)
#pragma unroll
                        for (int j = 0; j < 4; ++j) acc[ai][bj][m][n][j] *= f[n * 4 + j];
                    if (u.pass == 2) {
                        float h[8];
#pragma unroll
                        for (int n = 0; n < 2; ++n)
#pragma unroll
                            for (int j = 0; j < 4; ++j) h[n * 4 + j] = acc[ai][bj][m][n][j];
                        *(u32x4*)(O + row * D + col0 + bj * HALF) = pack8(h);
                    }
                }
            }
    }
};

struct EpiMergeWT {
    const bf16_t* ZG; bf16_t* O; unsigned* cntM; int samel2;
    __device__ __forceinline__ void operator()(AccRef acc, const Unit& u, int wr, int wc, int fr, int fq) const {
        const int col0 = u.pn * 256 + EPI_COLW;
        const __amdgpu_buffer_rsrc_t rm = __builtin_amdgcn_make_buffer_rsrc((void*)O, 0, (int)((size_t)18432 * D * 2), 0x00020000);
#pragma unroll
        for (int ai = 0; ai < 2; ++ai)
#pragma unroll
            for (int m = 0; m < 4; ++m) {
                const size_t row = (size_t)EPI_ROW(u, ai, m);
                const bf16_t* gp = ZG + row * ZGW + u.pass * 1024 + col0;
#pragma unroll
                for (int bj = 0; bj < 2; ++bj) {
                    float g0[8], f[8];
                    unpack8(*(const u32x4*)(gp + bj * HALF), g0);
                    if (u.pass < 2) {
                        float g1[8]; unpack8(*(const u32x4*)(gp + 1024 + bj * HALF), g1);
#pragma unroll
                        for (int e = 0; e < 8; ++e) f[e] = fmaxf(g0[e], 1e-30f) * __builtin_amdgcn_rcpf(fmaxf(g1[e], 1e-30f));
                    } else {
#pragma unroll
                        for (int e = 0; e < 8; ++e) f[e] = fmaxf(g0[e], 1e-30f);
                    }
#pragma unroll
                    for (int n = 0; n < 2; ++n)
#pragma unroll
                        for (int j = 0; j < 4; ++j) acc[ai][bj][m][n][j] *= f[n * 4 + j];
                    if (u.pass == 2) {
                        float h[8];
#pragma unroll
                        for (int n = 0; n < 2; ++n)
#pragma unroll
                            for (int j = 0; j < 4; ++j) h[n * 4 + j] = acc[ai][bj][m][n][j];
                        HANDOFF_STORE(pack8(h), rm, (unsigned)((row * D + col0 + bj * HALF) * 2), samel2);
                    }
                }
            }
        if (u.pass == 2) {
            asm volatile("s_waitcnt vmcnt(0)" ::: "memory");
            if ((threadIdx.x & 63) == 0) (void)__hip_atomic_fetch_add(cntM + 16 * u.pm, 1u, __ATOMIC_RELAXED, __HIP_MEMORY_SCOPE_AGENT);
        }
    }
};

struct FfnUnit { int kind, pm, pn; };
__device__ __forceinline__ bool ffn_next(int i, int G, int c, bool pe, FfnUnit& u) {
    if (G == 256) {
        const int x = c & 7, vc = c >> 3;
        const int ngu = vc < 4 ? 4 : (vc < 18 ? 7 : 6), ndn = vc < 4 ? 2 : 1;
        if (i < ngu) {
            const int t = i < 4 ? 32 * i + vc : (i < 6 ? 128 + 28 * (i - 4) + (vc - 4) : 184 + (vc - 4));
            u.kind = 0;
            if (t < 88) { u.pm = 9 * x + (t & 3); u.pn = t >> 2; }
            else if (t < 176) { u.pm = 9 * x + 4 + ((t - 88) & 3); u.pn = (t - 88) >> 2; }
            else { u.pm = 9 * x + 8; u.pn = t - 176; }
            return true;
        }
        const int k = i - ngu;
        if (k < ndn) { const int d = vc < 4 ? 4 * k + vc : (vc < 18 ? 22 + (vc - 4) : 8 + (vc - 18));
            u.kind = 1; u.pm = 9 * x + (d >> 2); u.pn = d & 3; return true; }
        if (!pe || vc < 18) return false;
        const int e = (vc - 18) + 14 * (k - ndn); if (k - ndn >= 3 || e >= 36) return false;
        u.kind = 2; u.pm = 9 * x + (e >> 2); u.pn = e & 3; return true;
    }
    const int ngu = (1584 - c + G - 1) / G;
    if (i < ngu) { const int t = i * G + c; u.kind = 0; u.pm = t / 22; u.pn = t - 22 * u.pm; return true; }
    const int ndn = (288 - c + G - 1) / G, i1 = i - ngu;
    if (i1 < ndn) { const int t = i1 * G + c; u.kind = 1; u.pm = t >> 2; u.pn = t & 3; return true; }
    if (!pe) return false;
    const int t = (i1 - ndn) * G + c; if (t >= 288) return false;
    u.kind = 2; u.pm = t >> 2; u.pn = t & 3; return true;
}
struct FfnArgs { const bf16_t* Agu; const bf16_t* Bgu; bf16_t* HID; const bf16_t* Bdn; const float* ss_in; float* H; bf16_t* NBo; float* sso; unsigned* cnt; const float* x0; const float* x1; const bf16_t* Ape; const bf16_t* Bpe; float* T; float s, sw; };

__device__ __forceinline__ void ffn_phase(LAS unsigned char* lds, int tid_in, const FfnArgs& fa) {
    int tid_ = tid_in; asm volatile("" : "+v"(tid_));
    const int tid = tid_, wid = __builtin_amdgcn_readfirstlane(tid >> 6), lane = tid & 63, wr = wid >> 2, wc = wid & 3, fr = lane & 15, fq = lane >> 4;
    constexpr int K0 = 1024, K1 = 2816, K2 = 256;
    const bool pe = fa.Ape != nullptr;
    unsigned vA[3][2], vB[3][2];
#pragma unroll
    for (int i = 0; i < 2; ++i) { int R, C; stage_rc(tid * 16 + i * 8192, R, C); const int Rb = (R & ~31) + perm32(R & 31);
        vA[0][i] = (unsigned)(R * K0 + C) * 2u; vB[0][i] = (unsigned)(Rb * K0 + C) * 2u; vA[1][i] = (unsigned)(R * K1 + C) * 2u; vB[1][i] = (unsigned)(Rb * K1 + C) * 2u; vA[2][i] = (unsigned)(R * K2 + C) * 2u; vB[2][i] = (unsigned)(Rb * K2 + C) * 2u; }
    constexpr size_t kstep = (size_t)(BK * 2);
    const unsigned ldsw = (unsigned)wid * 1024u;
    const int aoff = lds_byte(wr * 64 + fr, fq * 8), boff = lds_byte(wc * 32 + fr, fq * 8);
#define PG8_SA(b, h) (((b) * 2 + (h)) * HTB)
#define PG8_SB(b, h) ((4 + (b) * 2 + (h)) * HTB)
#define PG8_STAGE(bufoff, gbase, v0, v1) do { \
        __builtin_amdgcn_global_load_lds((const unsigned*)((const char*)(gbase) + (v0)), (LAS unsigned*)(lds + (bufoff) + ldsw), 16, 0, 0); \
        __builtin_amdgcn_global_load_lds((const unsigned*)((const char*)(gbase) + (v1)), (LAS unsigned*)(lds + (bufoff) + ldsw + 8192), 16, 0, 0); } while (0)
#define PG8_LDA(dst, b, h) do { _Pragma("unroll") for (int m = 0; m < 4; ++m) _Pragma("unroll") for (int k = 0; k < 2; ++k) dst[m][k] = *(const LAS bf16x8*)(lds + PG8_SA(b, h) + aoff + m * 2048 + k * 1024); } while (0)
#define PG8_LDB(dst, b, h) do { _Pragma("unroll") for (int n = 0; n < 2; ++n) _Pragma("unroll") for (int k = 0; k < 2; ++k) dst[n][k] = *(const LAS bf16x8*)(lds + PG8_SB(b, h) + boff + n * 2048 + k * 1024); } while (0)
#define PG8_MMA(ai, bj, At, Bt) do { __builtin_amdgcn_s_setprio(1); _Pragma("unroll") for (int m = 0; m < 4; ++m) _Pragma("unroll") for (int n = 0; n < 2; ++n) _Pragma("unroll") for (int k = 0; k < 2; ++k) \
        acc[ai][bj][m][n] = __builtin_amdgcn_mfma_f32_16x16x32_bf16(Bt[n][k], At[m][k], acc[ai][bj][m][n], 0, 0, 0); __builtin_amdgcn_s_setprio(0); } while (0)
#define PG8_WAIT_V(n) asm volatile("s_waitcnt vmcnt(" #n ")" ::: "memory")
#define PG8_WAIT_L(n) asm volatile("s_waitcnt lgkmcnt(" #n ")" ::: "memory")
#define PG8_BAR __builtin_amdgcn_s_barrier()
#define PG8_SCHED __builtin_amdgcn_sched_barrier(0)
#define FFN_READY(u) do { if ((u).kind == 1) { \
        if (wid == 0) { unsigned* w_ = fa.cnt + 16 * (u).pm; unsigned sp_ = 0; \
            while ((unsigned)__builtin_amdgcn_readfirstlane(__hip_atomic_load(w_, __ATOMIC_RELAXED, __HIP_MEMORY_SCOPE_AGENT)) < 176u) { __builtin_amdgcn_s_sleep(2); if (++sp_ > (1u << 24)) break; } \
            __builtin_amdgcn_fence(__ATOMIC_ACQUIRE, "agent"); asm volatile("s_waitcnt vmcnt(0)" ::: "memory"); } \
        asm volatile("" ::: "memory"); __builtin_amdgcn_s_barrier(); asm volatile("" ::: "memory"); } } while (0)
    int sG = (int)gridDim.x, sC = (int)__builtin_amdgcn_readfirstlane((int)*(volatile LAS unsigned*)(lds + LDS_BYTES - 8)); asm volatile("" : "+s"(sG), "+s"(sC));
    FfnUnit cur, nxt; int ui = 0;
    if (!ffn_next(0, sG, sC, pe, cur)) return;
    f32x4 acc[2][2][4][2];
    bf16x8 At[4][2], B0[2][2], B1[2][2];
#define FFN_K(u) ((u).kind == 0 ? K0 : ((u).kind == 1 ? K1 : K2))
#define FFN_UA(u) ((const char*)((u).kind == 0 ? fa.Agu : ((u).kind == 1 ? (const bf16_t*)fa.HID : fa.Ape)) + (size_t)(u).pm * (size_t)(256 * 2) * FFN_K(u))
#define FFN_UB(u) ((const char*)((u).kind == 0 ? fa.Bgu : ((u).kind == 1 ? fa.Bdn : fa.Bpe)) + (size_t)(u).pn * (size_t)(256 * 2) * FFN_K(u))
#define FFN_V(arr, u, i) ((u).kind == 0 ? arr[0][i] : ((u).kind == 1 ? arr[1][i] : arr[2][i]))
    for (;;) {
#pragma unroll
    for (int a = 0; a < 2; ++a)
#pragma unroll
        for (int b = 0; b < 2; ++b)
#pragma unroll
            for (int m = 0; m < 4; ++m)
#pragma unroll
                for (int n = 0; n < 2; ++n) acc[a][b][m][n] = (f32x4){0.f, 0.f, 0.f, 0.f};
    const char* cA = FFN_UA(cur); const char* cB = FFN_UB(cur);
    size_t chs = (size_t)HALF * 2 * FFN_K(cur);
    unsigned cvA0 = FFN_V(vA, cur, 0), cvA1 = FFN_V(vA, cur, 1), cvB0 = FFN_V(vB, cur, 0), cvB1 = FFN_V(vB, cur, 1);
    int nt = FFN_K(cur) / BK;
    FFN_READY(cur);
    PG8_STAGE(PG8_SB(0, 0), cB, cvB0, cvB1); PG8_STAGE(PG8_SB(0, 1), cB + chs, cvB0, cvB1); PG8_STAGE(PG8_SA(0, 0), cA, cvA0, cvA1); PG8_STAGE(PG8_SA(0, 1), cA + chs, cvA0, cvA1);
    if (wr == 1) PG8_BAR;
    PG8_WAIT_V(2); PG8_BAR;
    PG8_STAGE(PG8_SB(1, 0), cB + kstep, cvB0, cvB1); PG8_STAGE(PG8_SA(1, 0), cA + kstep, cvA0, cvA1); PG8_STAGE(PG8_SB(1, 1), cB + chs + kstep, cvB0, cvB1);
    PG8_WAIT_V(6); PG8_BAR;
    for (;;) {
        bool has_next = ffn_next(ui + 1, sG, sC, pe, nxt);
        if (has_next && nxt.kind != cur.kind) has_next = false;
        if (!has_next) nxt = cur;
        const char* nA = FFN_UA(nxt); const char* nB = FFN_UB(nxt);
        const size_t nhs = (size_t)HALF * 2 * FFN_K(nxt);
        const unsigned nvA0 = FFN_V(vA, nxt, 0), nvA1 = FFN_V(vA, nxt, 1), nvB0 = FFN_V(vB, nxt, 0), nvB1 = FFN_V(vB, nxt, 1);
#pragma unroll 1
        for (int t = 0; t < nt; t += 2) {
            const bool last = (t == nt - 2);
            const char* a1 = cA + (size_t)(t + 1) * kstep;
            const char* a2 = last ? nA : cA + (size_t)(t + 2) * kstep; const char* b2 = last ? nB : cB + (size_t)(t + 2) * kstep;
            const char* a3 = a2 + kstep; const char* b3 = b2 + kstep;
            const size_t hs2 = last ? nhs : chs;
            const unsigned sA0 = last ? nvA0 : cvA0, sA1 = last ? nvA1 : cvA1, sB0 = last ? nvB0 : cvB0, sB1 = last ? nvB1 : cvB1;
            if (last && has_next) FFN_READY(nxt);
            PG8_LDB(B0, 0, 0); PG8_LDB(B1, 0, 1); PG8_SCHED; PG8_LDA(At, 0, 0); PG8_STAGE(PG8_SA(1, 1), a1 + chs, cvA0, cvA1);
            PG8_WAIT_V(8); PG8_WAIT_L(0); PG8_BAR; PG8_MMA(0, 0, At, B0); PG8_MMA(0, 1, At, B1); PG8_BAR; PG8_SCHED;
            PG8_LDA(At, 0, 1); PG8_STAGE(PG8_SB(0, 0), b2, sB0, sB1); PG8_STAGE(PG8_SB(0, 1), b2 + hs2, sB0, sB1); PG8_STAGE(PG8_SA(0, 0), a2, sA0, sA1);
            PG8_WAIT_V(8); PG8_WAIT_L(0); PG8_BAR; PG8_MMA(1, 0, At, B0); PG8_MMA(1, 1, At, B1); PG8_BAR; PG8_SCHED;
            PG8_LDB(B0, 1, 0); PG8_LDB(B1, 1, 1); PG8_SCHED; PG8_LDA(At, 1, 0); PG8_STAGE(PG8_SA(0, 1), a2 + hs2, sA0, sA1);
            PG8_WAIT_V(8); PG8_WAIT_L(0); PG8_BAR; PG8_MMA(0, 0, At, B0); PG8_MMA(0, 1, At, B1); PG8_BAR; PG8_SCHED;
            PG8_LDA(At, 1, 1); PG8_STAGE(PG8_SB(1, 0), b3, sB0, sB1); PG8_STAGE(PG8_SB(1, 1), b3 + hs2, sB0, sB1); PG8_STAGE(PG8_SA(1, 0), a3, sA0, sA1);
            PG8_WAIT_V(8); PG8_WAIT_L(0); PG8_BAR; PG8_MMA(1, 0, At, B0); PG8_MMA(1, 1, At, B1); PG8_BAR; PG8_SCHED;
        }
        if (wr == 0) PG8_BAR;
        if (cur.kind == 0) {
            const bool samel2 = SAME_L2(lds);
            const __amdgpu_buffer_rsrc_t hrs = __builtin_amdgcn_make_buffer_rsrc((void*)fa.HID, 0, (int)((size_t)18432 * 2816 * 2), 0x00020000);
#pragma unroll
            for (int ai = 0; ai < 2; ++ai)
#pragma unroll
                for (int m = 0; m < 4; ++m) {
                    const int row = cur.pm * BM + ai * HALF + wr * 64 + m * 16 + fr; const float rs = EPI_RS(fa.ss_in, row);
                    typedef float f32x2 __attribute__((ext_vector_type(2)));
                    u32x4 hw;
#pragma unroll
                    for (int n = 0; n < 2; ++n)
#pragma unroll
                        for (int jp = 0; jp < 2; ++jp) {
                            f32x2 gv = {acc[ai][0][m][n][2 * jp], acc[ai][0][m][n][2 * jp + 1]}, uv = {acc[ai][1][m][n][2 * jp], acc[ai][1][m][n][2 * jp + 1]};
                            gv *= rs; uv *= rs;
                            const f32x2 ar = gv * (-1.4426950408889634f);
                            f32x2 ev; ev.x = __builtin_amdgcn_exp2f(ar.x); ev.y = __builtin_amdgcn_exp2f(ar.y);
                            const f32x2 dv = ev + 1.0f;
                            f32x2 rv; rv.x = __builtin_amdgcn_rcpf(dv.x); rv.y = __builtin_amdgcn_rcpf(dv.y);
                            const f32x2 hv = (gv * uv) * rv;
                            hw[n * 2 + jp] = cvt_pk_bf16(hv.x, hv.y);
                        }
                    HANDOFF_STORE(hw, hrs, (unsigned)(((size_t)row * 2816 + cur.pn * 128 + wc * 32 + fq * 8) * 2), samel2);
                }
            asm volatile("s_waitcnt vmcnt(0)" ::: "memory");
            if (lane == 0) (void)__hip_atomic_fetch_add(fa.cnt + 16 * cur.pm, 1u, __ATOMIC_RELAXED, __HIP_MEMORY_SCOPE_AGENT);
        } else if (cur.kind == 2) {
            const int col0 = cur.pn * 256 + wc * 32 + fq * 8;
#pragma unroll
            for (int ai = 0; ai < 2; ++ai)
#pragma unroll
                for (int m = 0; m < 4; ++m) {
                    float* p = fa.T + (size_t)(cur.pm * BM + ai * HALF + wr * 64 + m * 16 + fr) * D + col0;
#pragma unroll
                    for (int bj = 0; bj < 2; ++bj)
#pragma unroll
                        for (int n = 0; n < 2; ++n) *(f32x4*)(p + bj * HALF + n * 4) = acc[ai][bj][m][n];
                }
        } else {
            const int col0 = cur.pn * 256 + wc * 32 + fq * 8;
#pragma unroll
            for (int ai = 0; ai < 2; ++ai)
#pragma unroll
                for (int m = 0; m < 4; ++m) {
                    const int row = cur.pm * BM + ai * HALF + wr * 64 + m * 16 + fr;
                    float* p = fa.H + (size_t)row * D + col0;
                    const float* rp = fa.x0 ? (row < MP ? fa.x0 + (size_t)row * D : fa.x1 + (size_t)(row - MP) * D) + col0 : p;
                    float q = 0.f;
#pragma unroll
                    for (int bj = 0; bj < 2; ++bj) {
                        float h[8];
#pragma unroll
                        for (int n = 0; n < 2; ++n) { f32x4* qp = (f32x4*)(p + bj * HALF + n * 4); f32x4 v = *(const f32x4*)(rp + bj * HALF + n * 4); v += acc[ai][bj][m][n] * fa.s; *qp = v;
#pragma unroll
                            for (int j = 0; j < 4; ++j) { h[n * 4 + j] = v[j]; q += v[j] * v[j]; } }
                        *(u32x4*)(fa.NBo + (size_t)row * D + col0 + bj * HALF) = pack8(h);
                    }
                    q += __shfl_xor(q, 16); q += __shfl_xor(q, 32);
                    if (fq == 0) atomicAdd(fa.sso + row, q * fa.sw);
                }
        }
        if (!has_next) break;
#pragma unroll
        for (int a = 0; a < 2; ++a)
#pragma unroll
            for (int b = 0; b < 2; ++b)
#pragma unroll
                for (int m = 0; m < 4; ++m)
#pragma unroll
                    for (int n = 0; n < 2; ++n) acc[a][b][m][n] = (f32x4){0.f, 0.f, 0.f, 0.f};
        cur = nxt; cA = nA; cB = nB; chs = nhs; cvA0 = nvA0; cvA1 = nvA1; cvB0 = nvB0; cvB1 = nvB1; nt = FFN_K(cur) / BK; ++ui;
        if (wr == 1) PG8_BAR;
    }
    PG8_WAIT_V(0);
    PG8_BAR;
    ++ui; if (!ffn_next(ui, sG, sC, pe, cur)) break;
    }
#undef PG8_SA
#undef PG8_SB
#undef PG8_STAGE
#undef PG8_LDA
#undef PG8_LDB
#undef PG8_MMA
#undef PG8_WAIT_V
#undef PG8_WAIT_L
#undef PG8_BAR
#undef PG8_SCHED
#undef FFN_READY
#undef FFN_UA
#undef FFN_UB
#undef FFN_K
#undef FFN_V
}

constexpr int TAIL_MAXU = 8;
__device__ const unsigned short TAIL_SCHED[32][TAIL_MAXU] = {
    {0x100,0x20,0x44,0x62,0x7a,0x262,0x360,0xffff},
    {0x101,0x21,0x45,0x63,0x7b,0x263,0x361,0xffff},
    {0x110,0x22,0x46,0x64,0x230,0x320,0xffff,0xffff},
    {0x111,0x23,0x47,0x65,0x231,0x321,0xffff,0xffff},
    {0x0,0x28,0x202,0x86,0x280,0x380,0xffff,0xffff},
    {0x1,0x29,0x203,0x87,0x281,0x381,0xffff,0xffff},
    {0x2,0x2a,0x50,0x180,0x232,0x322,0xffff,0xffff},
    {0x3,0x2b,0x51,0x181,0x233,0x323,0xffff,0xffff},
    {0x4,0x140,0x48,0x66,0x80,0x270,0x362,0xffff},
    {0x5,0x141,0x49,0x67,0x81,0x271,0x363,0xffff},
    {0x6,0x30,0x52,0x220,0x282,0x382,0xffff,0xffff},
    {0x7,0x31,0x53,0x221,0x283,0x383,0xffff,0xffff},
    {0x8,0x32,0x54,0x222,0x302,0x370,0xffff,0xffff},
    {0x9,0x33,0x55,0x223,0x303,0x371,0xffff,0xffff},
    {0xa,0x34,0x56,0x70,0x240,0x330,0xffff,0xffff},
    {0xb,0x35,0x57,0x71,0x241,0x331,0xffff,0xffff},
    {0x120,0x24,0x4a,0x68,0x82,0x272,0x372,0xffff},
    {0x121,0x25,0x4b,0x69,0x83,0x273,0x373,0xffff},
    {0x10,0x36,0x58,0x72,0x242,0x332,0xffff,0xffff},
    {0x11,0x37,0x59,0x73,0x243,0x333,0xffff,0xffff},
    {0x12,0x38,0x5a,0x74,0x250,0x340,0xffff,0xffff},
    {0x13,0x39,0x5b,0x75,0x251,0x341,0xffff,0xffff},
    {0x14,0x3a,0x170,0x6a,0x84,0x300,0x350,0xffff},
    {0x15,0x3b,0x171,0x6b,0x85,0x301,0x351,0xffff},
    {0x16,0x150,0x160,0x60,0x76,0x252,0x342,0xffff},
    {0x17,0x151,0x161,0x61,0x77,0x253,0x343,0xffff},
    {0x18,0x40,0x210,0x88,0x310,0xffff,0xffff,0xffff},
    {0x19,0x41,0x211,0x89,0x311,0xffff,0xffff,0xffff},
    {0x1a,0x42,0x212,0x8a,0x312,0xffff,0xffff,0xffff},
    {0x1b,0x43,0x213,0x8b,0x313,0xffff,0xffff,0xffff},
    {0x130,0x26,0x200,0x78,0x260,0x352,0xffff,0xffff},
    {0x131,0x27,0x201,0x79,0x261,0x353,0xffff,0xffff}
};

struct TU { int kind, pass, pm, pn; };
__device__ __forceinline__ bool tail_unit(int i, int G, int c, TU& u) {
    u.pass = 0;
    if (G == 256) {
        if (i >= TAIL_MAXU) return false;
        const unsigned e = TAIL_SCHED[c >> 3][i]; if (e == 0xffffu) return false;
        u.kind = (int)(e >> 8); u.pm = 9 * (c & 7) + (int)((e >> 4) & 15u); u.pn = (int)(e & 15u); return true;
    }
    const int n0 = (1008 - c + G - 1) / G;
    if (i < n0) { const int t = i * G + c; if (t < 864) { u.kind = 0; u.pm = t / 12; u.pn = t - 12 * u.pm; } else { u.kind = 1; u.pm = (t - 864) >> 1; u.pn = (t - 864) & 1; } return true; }
    const int n1 = (288 - c + G - 1) / G; const int i1 = i - n0;
    if (i1 < n1) { const int t = i1 * G + c; u.kind = 2; u.pm = t >> 2; u.pn = t & 3; return true; }
    const int t = (i1 - n1) * G + c; if (t >= 288) return false;
    u.kind = 3; u.pm = t >> 2; u.pn = t & 3; return true;
}
struct TailArgs { unsigned char* ws; float* H; const float* gbias; const float* pscale; const float* ss_in; float* sso; unsigned* cntA; unsigned* cntM; float s; };

__device__ __forceinline__ void tail_phase(LAS unsigned char* lds, int tid_in, const TailArgs& ta) {
    int tid_ = tid_in; asm volatile("" : "+v"(tid_));
    const int tid = tid_, wid = __builtin_amdgcn_readfirstlane(tid >> 6), lane = tid & 63, wr = wid >> 2, wc = wid & 3, fr = lane & 15, fq = lane >> 4;
    constexpr int K0 = 1024, K1 = 512;
    constexpr size_t kstep = (size_t)(BK * 2);
    const unsigned ldsw = (unsigned)wid * 1024u;
#define PG8_SA(b, h) (((b) * 2 + (h)) * HTB)
#define PG8_SB(b, h) ((4 + (b) * 2 + (h)) * HTB)
#define PG8_STAGE(bufoff, gbase, v0, v1) do { \
        __builtin_amdgcn_global_load_lds((const unsigned*)((const char*)(gbase) + (v0)), (LAS unsigned*)(lds + (bufoff) + ldsw), 16, 0, 0); \
        __builtin_amdgcn_global_load_lds((const unsigned*)((const char*)(gbase) + (v1)), (LAS unsigned*)(lds + (bufoff) + ldsw + 8192), 16, 0, 0); } while (0)
#define PG8_LDA(dst, b, h) do { _Pragma("unroll") for (int m = 0; m < 4; ++m) _Pragma("unroll") for (int k = 0; k < 2; ++k) dst[m][k] = *(const LAS bf16x8*)(lds + PG8_SA(b, h) + aoff + m * 2048 + k * 1024); } while (0)
#define PG8_LDB(dst, b, h) do { _Pragma("unroll") for (int n = 0; n < 2; ++n) _Pragma("unroll") for (int k = 0; k < 2; ++k) dst[n][k] = *(const LAS bf16x8*)(lds + PG8_SB(b, h) + boff + n * 2048 + k * 1024); } while (0)
#define PG8_MMA(ai, bj, At, Bt) do { __builtin_amdgcn_s_setprio(1); _Pragma("unroll") for (int m = 0; m < 4; ++m) _Pragma("unroll") for (int n = 0; n < 2; ++n) _Pragma("unroll") for (int k = 0; k < 2; ++k) \
        acc[ai][bj][m][n] = __builtin_amdgcn_mfma_f32_16x16x32_bf16(Bt[n][k], At[m][k], acc[ai][bj][m][n], 0, 0, 0); __builtin_amdgcn_s_setprio(0); } while (0)
#define PG8_WAIT_V(n) asm volatile("s_waitcnt vmcnt(" #n ")" ::: "memory")
#define PG8_WAIT_L(n) asm volatile("s_waitcnt lgkmcnt(" #n ")" ::: "memory")
#define PG8_BAR __builtin_amdgcn_s_barrier()
#define PG8_SCHED __builtin_amdgcn_sched_barrier(0)
#define TL_DEP(u) (((u).kind == 2 && (u).pass == 0) || (u).kind == 3)
#define TL_READY(u) do { if (TL_DEP(u)) { \
        if (wid == 0) { unsigned* w_ = ((u).kind == 2 ? ta.cntA : ta.cntM) + 16 * (u).pm; const unsigned need_ = (u).kind == 2 ? 112u : 32u; unsigned sp_ = 0; \
            while ((unsigned)__builtin_amdgcn_readfirstlane(__hip_atomic_load(w_, __ATOMIC_RELAXED, __HIP_MEMORY_SCOPE_AGENT)) < need_) { __builtin_amdgcn_s_sleep(2); if (++sp_ > (1u << 24)) break; } \
            __builtin_amdgcn_fence(__ATOMIC_ACQUIRE, "agent"); asm volatile("s_waitcnt vmcnt(0)" ::: "memory"); } \
        asm volatile("" ::: "memory"); __builtin_amdgcn_s_barrier(); asm volatile("" ::: "memory"); } } while (0)
#define TL_K(u) (((u).kind == 0 || (u).kind == 3) ? K0 : K1)
#define TL_ABASE(u) ((const char*)ta.ws + ((u).kind == 0 ? WS_NB : (u).kind == 1 ? WS_X + 2 * XSZ : (u).kind == 3 ? WS_NB2 : ((u).pass == 0 ? WS_X : (u).pass == 1 ? WS_X + XSZ : WS_X + 3 * XSZ)))
#define TL_BBASE(u) ((const char*)ta.ws + WS_W + 2 * ((u).kind == 0 ? W_IG : (u).kind == 1 ? W_PBD : (u).kind == 3 ? W_O : ((u).pass == 0 ? W_CA : (u).pass == 1 ? W_SB : W_PC)))
#define TL_UA(u) (TL_ABASE(u) + (size_t)(u).pm * (size_t)(256 * 2) * TL_K(u))
#define TL_UB(u) (TL_BBASE(u) + (size_t)(u).pn * (size_t)(256 * 2) * TL_K(u))
    constexpr size_t XSZ = (size_t)18432 * 512 * 2;
    int sG = (int)gridDim.x, sC = (int)__builtin_amdgcn_readfirstlane((int)*(volatile LAS unsigned*)(lds + LDS_BYTES - 8)); asm volatile("" : "+s"(sG), "+s"(sC));
    TU cur, nxt; int ui = 0;
    if (!tail_unit(0, sG, sC, cur)) return;
    f32x4 acc[2][2][4][2];
    bf16x8 At[4][2], B0[2][2], B1[2][2];
    for (;;) {
    if (cur.kind == 2) {
        TL_READY(cur);
        { const Gemm g{(const bf16_t*)(ta.ws + WS_X), (const bf16_t*)(ta.ws + WS_X + XSZ), (const bf16_t*)(ta.ws + WS_X + 3 * XSZ),
                       (const bf16_t*)(ta.ws + WS_W) + W_CA, (const bf16_t*)(ta.ws + WS_W) + W_SB, (const bf16_t*)(ta.ws + WS_W) + W_PC};
          const EpiMergeWT E{(const bf16_t*)(ta.ws + WS_BIG), (bf16_t*)(ta.ws + WS_NB2), ta.cntM, (int)SAME_L2(lds)};
          int tm_; asm volatile("v_mbcnt_lo_u32_b32 %0, -1, 0\n\tv_mbcnt_hi_u32_b32 %0, -1, %0" : "=v"(tm_));
          gemm_phase<EpiMergeWT, D, 512, 3, true, true, true>(lds, tm_ + wid * 64, g, E, cur.pm, cur.pn); }
        ++ui; if (!tail_unit(ui, sG, sC, cur)) break;
        continue;
    }
    int tl_; asm volatile("v_mbcnt_lo_u32_b32 %0, -1, 0\n\tv_mbcnt_hi_u32_b32 %0, -1, %0" : "=v"(tl_)); tl_ += wid * 64;
    unsigned vA[2][2], vB[2][2];
#pragma unroll
    for (int i = 0; i < 2; ++i) { int R, C; stage_rc(tl_ * 16 + i * 8192, R, C); const int Rb = (R & ~31) + perm32(R & 31);
        vA[0][i] = (unsigned)(R * K0 + C) * 2u; vB[0][i] = (unsigned)(Rb * K0 + C) * 2u; vA[1][i] = (unsigned)(R * K1 + C) * 2u; vB[1][i] = (unsigned)(Rb * K1 + C) * 2u; }
    const int aoff = lds_byte(wr * 64 + (tl_ & 15), ((tl_ & 63) >> 4) * 8), boff = lds_byte(wc * 32 + (tl_ & 15), ((tl_ & 63) >> 4) * 8);
#pragma unroll
    for (int a = 0; a < 2; ++a)
#pragma unroll
        for (int b = 0; b < 2; ++b)
#pragma unroll
            for (int m = 0; m < 4; ++m)
#pragma unroll
                for (int n = 0; n < 2; ++n) acc[a][b][m][n] = (f32x4){0.f, 0.f, 0.f, 0.f};
    const char* cA = TL_UA(cur); const char* cB = TL_UB(cur);
    size_t chs = (size_t)HALF * 2 * TL_K(cur);
    bool ck = TL_K(cur) == K1;
    unsigned cvA0 = ck ? vA[1][0] : vA[0][0], cvA1 = ck ? vA[1][1] : vA[0][1], cvB0 = ck ? vB[1][0] : vB[0][0], cvB1 = ck ? vB[1][1] : vB[0][1];
    int nt = TL_K(cur) / BK;
    TL_READY(cur);
    PG8_STAGE(PG8_SB(0, 0), cB, cvB0, cvB1); PG8_STAGE(PG8_SB(0, 1), cB + chs, cvB0, cvB1); PG8_STAGE(PG8_SA(0, 0), cA, cvA0, cvA1); PG8_STAGE(PG8_SA(0, 1), cA + chs, cvA0, cvA1);
    if (wr == 1) PG8_BAR;
    PG8_WAIT_V(2); PG8_BAR;
    PG8_STAGE(PG8_SB(1, 0), cB + kstep, cvB0, cvB1); PG8_STAGE(PG8_SA(1, 0), cA + kstep, cvA0, cvA1); PG8_STAGE(PG8_SB(1, 1), cB + chs + kstep, cvB0, cvB1);
    PG8_WAIT_V(6); PG8_BAR;
    bool more;
    for (;;) {
        more = tail_unit(ui + 1, sG, sC, nxt);
        const bool has_next = more && !TL_DEP(nxt);
        if (!has_next) nxt = cur;
        const char* nA = TL_UA(nxt); const char* nB = TL_UB(nxt);
        const size_t nhs = (size_t)HALF * 2 * TL_K(nxt);
        const bool nk = TL_K(nxt) == K1;
        const unsigned nvA0 = nk ? vA[1][0] : vA[0][0], nvA1 = nk ? vA[1][1] : vA[0][1], nvB0 = nk ? vB[1][0] : vB[0][0], nvB1 = nk ? vB[1][1] : vB[0][1];
#pragma unroll 1
        for (int t = 0; t < nt; t += 2) {
            const bool last = (t == nt - 2);
            const char* a1 = cA + (size_t)(t + 1) * kstep;
            const char* a2 = last ? nA : cA + (size_t)(t + 2) * kstep; const char* b2 = last ? nB : cB + (size_t)(t + 2) * kstep;
            const char* a3 = a2 + kstep; const char* b3 = b2 + kstep;
            const size_t hs2 = last ? nhs : chs;
            const unsigned sA0 = last ? nvA0 : cvA0, sA1 = last ? nvA1 : cvA1, sB0 = last ? nvB0 : cvB0, sB1 = last ? nvB1 : cvB1;
            PG8_LDB(B0, 0, 0); PG8_LDB(B1, 0, 1); PG8_SCHED; PG8_LDA(At, 0, 0); PG8_STAGE(PG8_SA(1, 1), a1 + chs, cvA0, cvA1);
            PG8_WAIT_V(8); PG8_WAIT_L(0); PG8_BAR; PG8_MMA(0, 0, At, B0); PG8_MMA(0, 1, At, B1); PG8_BAR; PG8_SCHED;
            PG8_LDA(At, 0, 1); PG8_STAGE(PG8_SB(0, 0), b2, sB0, sB1); PG8_STAGE(PG8_SB(0, 1), b2 + hs2, sB0, sB1); PG8_STAGE(PG8_SA(0, 0), a2, sA0, sA1);
            PG8_WAIT_V(8); PG8_WAIT_L(0); PG8_BAR; PG8_MMA(1, 0, At, B0); PG8_MMA(1, 1, At, B1); PG8_BAR; PG8_SCHED;
            PG8_LDB(B0, 1, 0); PG8_LDB(B1, 1, 1); PG8_SCHED; PG8_LDA(At, 1, 0); PG8_STAGE(PG8_SA(0, 1), a2 + hs2, sA0, sA1);
            PG8_WAIT_V(8); PG8_WAIT_L(0); PG8_BAR; PG8_MMA(0, 0, At, B0); PG8_MMA(0, 1, At, B1); PG8_BAR; PG8_SCHED;
            PG8_LDA(At, 1, 1); PG8_STAGE(PG8_SB(1, 0), b3, sB0, sB1); PG8_STAGE(PG8_SB(1, 1), b3 + hs2, sB0, sB1); PG8_STAGE(PG8_SA(1, 0), a3, sA0, sA1);
            PG8_WAIT_V(8); PG8_WAIT_L(0); PG8_BAR; PG8_MMA(1, 0, At, B0); PG8_MMA(1, 1, At, B1); PG8_BAR; PG8_SCHED;
        }
        if (wr == 0) PG8_BAR;
        const int colw = wc * 32 + fq * 8;
        if (cur.kind == 0) {
            const bool samel2 = SAME_L2(lds);
            const __amdgpu_buffer_rsrc_t rz = __builtin_amdgcn_make_buffer_rsrc((void*)(ta.ws + WS_BIG), 0, (int)((size_t)18432 * ZGW * 2), 0x00020000);
            const int col0 = cur.pn * 256 + colw;
#pragma unroll
            for (int ai = 0; ai < 2; ++ai)
#pragma unroll
                for (int m = 0; m < 4; ++m) {
                    const int row = cur.pm * BM + ai * HALF + wr * 64 + m * 16 + fr; const float rs = EPI_RS(ta.ss_in, row);
#pragma unroll
                    for (int bj = 0; bj < 2; ++bj) {
                        float h[8];
#pragma unroll
                        for (int n = 0; n < 2; ++n)
#pragma unroll
                            for (int j = 0; j < 4; ++j) h[n * 4 + j] = sigmoidf_(rs * acc[ai][bj][m][n][j] + ta.gbias[col0 + bj * HALF + n * 4 + j]);
                        HANDOFF_STORE(pack8(h), rz, (unsigned)(((size_t)row * ZGW + col0 + bj * HALF) * 2), samel2);
                    }
                    asm volatile("" ::: "memory");
                }
            asm volatile("s_waitcnt vmcnt(0)" ::: "memory");
            if (lane == 0) (void)__hip_atomic_fetch_add(ta.cntA + 16 * cur.pm, 1u, __ATOMIC_RELAXED, __HIP_MEMORY_SCOPE_AGENT);
        } else if (cur.kind == 1) {
            const bool samel2 = SAME_L2(lds);
            const __amdgpu_buffer_rsrc_t rx = __builtin_amdgcn_make_buffer_rsrc((void*)(ta.ws + WS_X + 3 * XSZ), 0, (int)XSZ, 0x00020000);
            const int col0 = cur.pn * 256 + colw;
#pragma unroll
            for (int ai = 0; ai < 2; ++ai)
#pragma unroll
                for (int m = 0; m < 4; ++m) {
                    const int row = cur.pm * BM + ai * HALF + wr * 64 + m * 16 + fr;
#pragma unroll
                    for (int bj = 0; bj < 2; ++bj) {
                        float h[8];
#pragma unroll
                        for (int n = 0; n < 2; ++n)
#pragma unroll
                            for (int j = 0; j < 4; ++j) h[n * 4 + j] = acc[ai][bj][m][n][j] * ta.pscale[col0 + bj * HALF + n * 4 + j];
                        HANDOFF_STORE(pack8(h), rx, (unsigned)(((size_t)row * XW + col0 + bj * HALF) * 2), samel2);
                    }
                    asm volatile("" ::: "memory");
                }
            asm volatile("s_waitcnt vmcnt(0)" ::: "memory");
            if (lane == 0) (void)__hip_atomic_fetch_add(ta.cntA + 16 * cur.pm, 1u, __ATOMIC_RELAXED, __HIP_MEMORY_SCOPE_AGENT);
        } else {
            const int col0 = cur.pn * 256 + colw;
            bf16_t* NBo = (bf16_t*)(ta.ws + WS_NB);
#pragma unroll
            for (int ai = 0; ai < 2; ++ai)
#pragma unroll
                for (int m = 0; m < 4; ++m) {
                    const int row = cur.pm * BM + ai * HALF + wr * 64 + m * 16 + fr;
                    float* p = ta.H + (size_t)row * D + col0;
                    float q = 0.f;
#pragma unroll
                    for (int bj = 0; bj < 2; ++bj) {
                        float h[8];
#pragma unroll
                        for (int n = 0; n < 2; ++n) { f32x4* qp = (f32x4*)(p + bj * HALF + n * 4); f32x4 v = *qp; v += acc[ai][bj][m][n] * ta.s; *qp = v;
#pragma unroll
                            for (int j = 0; j < 4; ++j) { h[n * 4 + j] = v[j]; q += v[j] * v[j]; } }
                        *(u32x4*)(NBo + (size_t)row * D + col0 + bj * HALF) = pack8(h);
                    }
                    q += __shfl_xor(q, 16); q += __shfl_xor(q, 32);
                    if (fq == 0) atomicAdd(ta.sso + row, q * ta.s);
                    asm volatile("" ::: "memory");
                }
        }
        if (!has_next) break;
        {
#pragma unroll
        for (int a = 0; a < 2; ++a)
#pragma unroll
            for (int b = 0; b < 2; ++b)
#pragma unroll
                for (int m = 0; m < 4; ++m)
#pragma unroll
                    for (int n = 0; n < 2; ++n) acc[a][b][m][n] = (f32x4){0.f, 0.f, 0.f, 0.f};
        }
        ++ui;
        cur = nxt; cA = nA; cB = nB; chs = nhs; cvA0 = nvA0; cvA1 = nvA1; cvB0 = nvB0; cvB1 = nvB1; nt = TL_K(cur) / BK;
        if (wr == 1) PG8_BAR;
    }
    PG8_WAIT_V(0);
    PG8_BAR;
    if (!more) break;
    ++ui; tail_unit(ui, sG, sC, cur);
    }
#undef PG8_SA
#undef PG8_SB
#undef PG8_STAGE
#undef PG8_LDA
#undef PG8_LDB
#undef PG8_MMA
#undef PG8_WAIT_V
#undef PG8_WAIT_L
#undef PG8_BAR
#undef PG8_SCHED
#undef TL_DEP
#undef TL_READY
#undef TL_K
#undef TL_ABASE
#undef TL_BBASE
#undef TL_UA
#undef TL_UB
}
}

struct Args { const float* in[35]; float* out; unsigned char* ws; int ph_lo, ph_hi; };
static_assert(sizeof(Args) == 35 * 8 + 8 + 8 + 8, "Args has no padding");

typedef const Args __attribute__((address_space(4)))* ArgsP;
__device__ __forceinline__ ArgsP get_args() { ArgsP p = (ArgsP)__builtin_amdgcn_kernarg_segment_ptr(); asm volatile("" : "+s"(p)); return p; }
struct Ctx {
    LAS unsigned char* lds;
    int tid, lane, wave, gw, nW, bx, gx;
    float* H; float* SS; bf16_t* W; bf16_t* PB; bf16_t* NB; bf16_t* NB2; unsigned char* BIG; bf16_t* XA; bf16_t* XB; bf16_t* XD; bf16_t* XC;
};

__device__ __forceinline__ const float* x_row(ArgsP a, int r) { return r < MP ? a->in[0] + (size_t)r * D : a->in[1] + (size_t)(r - MP) * D; }
__device__ __forceinline__ const float* p_row(const float* pp, const float* ps, int L, int r) { return r < MP ? pp + ((size_t)L * MP + r) * DPLE : ps + ((size_t)L * MS + (r - MP)) * DPLE; }

template <int MODE>
__device__ __forceinline__ void norm_phase(const Ctx& c, const float* gain) {
    const int lane = c.lane;
    ArgsP ap = get_args();
    if (MODE == 0) { for (size_t i = (size_t)c.bx * 512 + c.tid; i < (size_t)8 * M; i += (size_t)c.gx * 512) c.SS[M + i] = 0.f; }
    f32x4 gv[4];
#pragma unroll
    for (int i = 0; i < 4; ++i) gv[i] = (MODE == 2) ? *(const f32x4*)(gain + i * 256 + lane * 4) : (f32x4){1.f, 1.f, 1.f, 1.f};
    for (int r0 = c.gw; r0 < M; r0 += 3 * c.nW) {
        f32x4 v[3][4]; float ss[3]; float rsv[3];
#pragma unroll
        for (int k = 0; k < 3; ++k) {
            const int r = r0 + k * c.nW; ss[k] = 0.f; rsv[k] = 0.f;
            if (r < M) {
                const float* src = (MODE == 0) ? x_row(ap, r) : c.H + (size_t)r * D;
#pragma unroll
                for (int i = 0; i < 4; ++i) v[k][i] = *(const f32x4*)(src + i * 256 + lane * 4);
                if (MODE == 2) rsv[k] = c.SS[(size_t)8 * M + r];
            } else {
#pragma unroll
                for (int i = 0; i < 4; ++i) v[k][i] = (f32x4){0.f, 0.f, 0.f, 0.f};
            }
        }
#pragma unroll
        for (int k = 0; k < 3; ++k) {
            const int r = r0 + k * c.nW;
            if (r < M) {
                if (MODE == 0) {
#pragma unroll
                    for (int i = 0; i < 4; ++i) ss[k] += v[k][i][0] * v[k][i][0] + v[k][i][1] * v[k][i][1] + v[k][i][2] * v[k][i][2] + v[k][i][3] * v[k][i][3];
                    ss[k] = wave_sum(ss[k]);
                    if (lane == 0) c.SS[r] = ss[k];
#pragma unroll
                    for (int i = 0; i < 4; ++i) {
                        u32x2 w; w.x = cvt_pk_bf16(v[k][i][0], v[k][i][1]); w.y = cvt_pk_bf16(v[k][i][2], v[k][i][3]); *(u32x2*)(c.NB2 + (size_t)r * D + i * 256 + lane * 4) = w;
                    }
                } else {
                    const float rs = __builtin_amdgcn_rsqf(rsv[k] * (1.0f / D) + EPS);
#pragma unroll
                    for (int i = 0; i < 4; ++i) *(f32x4*)(c.H + (size_t)r * D + i * 256 + lane * 4) = v[k][i] * rs * gv[i];
                }
            }
        }
    }
}

__device__ __forceinline__ void prep_phase(const Ctx& c, int L, int it_lo, int it_hi, int b0, int bstride, bool do_tables) {
    ArgsP a = get_args();
    LAS unsigned* Tw = (LAS unsigned*)c.lds;
    const int tid = c.tid, lane = c.lane, wave = c.wave;
    if (b0 >= 0) for (int it = it_lo + b0; it < it_hi; it += bstride) {
        int r = it; const float* s0; const float* s1; const float* gain = nullptr; int ld, K, c0, c1, t, kc; size_t dsto;
        if (r < 352) { t = r >> 4; kc = r & 15; s0 = a->in[7] + (size_t)L * D * FF; s1 = a->in[8] + (size_t)L * D * FF; gain = a->in[6] + L * D; ld = FF; K = D; c0 = c1 = t * 128; dsto = W_GU1; }
        else if ((r -= 352) < 176) { t = r / 44; kc = r - t * 44; s0 = s1 = a->in[9] + (size_t)L * FF * D; ld = D; K = FF; c0 = t * 256; c1 = c0 + 128; dsto = W_D1; }
        else if ((r -= 176) < 160) { t = r >> 4; kc = r & 15; s0 = s1 = a->in[11] + (size_t)L * D * 5632; gain = a->in[10] + L * D; ld = 5632; K = D;
            if (t < 4) { c0 = t * 128; c1 = 512 + t * 128; } else { c0 = t * 256; c1 = c0 + 128; } dsto = W_IM; }
        else if ((r -= 160) < 192) { t = r >> 4; kc = r & 15; s0 = s1 = a->in[11] + (size_t)L * D * 5632; gain = a->in[10] + L * D; ld = 5632; K = D; c0 = 2560 + t * 256; c1 = c0 + 128; dsto = W_IG; }
        else if ((r -= 192) < 32) { t = r >> 3; kc = r & 7; s0 = s1 = a->in[17] + (size_t)L * 512 * D; ld = D; K = 512; c0 = t * 256; c1 = c0 + 128; dsto = W_CA; }
        else if ((r -= 32) < 32) { t = r >> 3; kc = r & 7; s0 = s1 = a->in[22] + (size_t)L * 512 * D; ld = D; K = 512; c0 = t * 256; c1 = c0 + 128; dsto = W_SB; }
        else if ((r -= 32) < 32) { t = r >> 3; kc = r & 7; s0 = s1 = a->in[25] + (size_t)L * 512 * D; ld = D; K = 512; c0 = t * 256; c1 = c0 + 128; dsto = W_PC; }
        else if ((r -= 32) < 64) { t = r >> 4; kc = r & 15; s0 = s1 = a->in[26] + (size_t)L * D * D; ld = D; K = D; c0 = t * 256; c1 = c0 + 128; dsto = W_O; }
        else if ((r -= 64) < 352) { t = r >> 4; kc = r & 15; s0 = a->in[28] + (size_t)L * D * FF; s1 = a->in[29] + (size_t)L * D * FF; gain = a->in[27] + L * D; ld = FF; K = D; c0 = c1 = t * 128; dsto = W_GU2; }
        else if ((r -= 352) < 176) { t = r / 44; kc = r - t * 44; s0 = s1 = a->in[30] + (size_t)L * FF * D; ld = D; K = FF; c0 = t * 256; c1 = c0 + 128; dsto = W_D2; }
        else if ((r -= 176) < 64) { t = r >> 4; kc = r & 15; s0 = s1 = a->in[32] + (size_t)L * D * D; gain = a->in[31] + L * D; ld = D; K = D; c0 = t * 256; c1 = c0 + 128; dsto = W_PG; }
        else { r -= 64; t = r >> 2; kc = r & 3; s0 = s1 = a->in[33] + (size_t)L * DPLE * D; ld = D; K = DPLE; c0 = t * 256; c1 = c0 + 128; dsto = W_PE; }
        const int k0 = kc * 64, d0 = t * 256;
        {
            const int hf = lane >> 5, c4 = (lane & 31) * 4;
            const float* sp = (hf ? s1 + c1 : s0 + c0) + (size_t)(k0 + wave * 8) * ld + c4;
            f32x4 v[8];
#pragma unroll
            for (int rr = 0; rr < 8; ++rr) v[rr] = *(const f32x4*)(sp + (size_t)rr * ld);
            if (gain) {
#pragma unroll
                for (int rr = 0; rr < 8; ++rr) v[rr] *= gain[k0 + wave * 8 + rr];
            }
            const int nb = hf * 128 + c4;
#pragma unroll
            for (int p = 0; p < 4; ++p)
#pragma unroll
                for (int i = 0; i < 4; ++i) Tw[(nb + i) * 33 + wave * 4 + p] = cvt_pk_bf16(v[2 * p][i], v[2 * p + 1][i]);
        }
        __syncthreads();
        bf16_t* dst = c.W + dsto;
        {
            const int n = tid >> 1, hk = tid & 1;
            bf16_t* dp = dst + (size_t)(d0 + n) * K + k0 + 32 * hk;
#pragma unroll
            for (int jq = 0; jq < 4; ++jq) {
                u32x4 w; w.x = Tw[n * 33 + 16 * hk + 4 * jq]; w.y = Tw[n * 33 + 16 * hk + 4 * jq + 1]; w.z = Tw[n * 33 + 16 * hk + 4 * jq + 2]; w.w = Tw[n * 33 + 16 * hk + 4 * jq + 3];
                *(u32x4*)(dp + 8 * jq) = w;
            }
        }
        __syncthreads();
    }
    if (!do_tables) return;
    if (b0 < 0) return;
    const size_t gtid = (size_t)b0 * 512 + tid, gstride = (size_t)bstride * 512;
    const float* pw = a->in[23] + (size_t)L * 4 * 128 * 128;
    for (size_t i = gtid; i < 512 * 512; i += gstride) { const int n = (int)(i >> 9), k = (int)(i & 511);
        c.W[W_PBD + i] = ((n >> 7) == (k >> 7)) ? f2bf(pw[((size_t)(n >> 7) * 128 + (k & 127)) * 128 + (n & 127)]) : (bf16_t)0; }
    const float* wsrc = a->in[20] + (size_t)L * 4 * 128 * 128;
    for (size_t i = gtid; i < 65536; i += gstride) { const int ii = (int)((i >> 7) & 127), jj = (int)(i & 127); c.W[W_WS + i] = (jj <= ii) ? f2bf(wsrc[i]) : (bf16_t)0; }
    const float* pp = a->in[2]; const float* ps = a->in[3];
    for (size_t i = gtid; i < (size_t)M * 64; i += gstride) { const int r = (int)(i >> 6), c4 = (int)(i & 63);
        const f32x4 v = *(const f32x4*)(p_row(pp, ps, L, r) + c4 * 4); u32x2 w; w.x = cvt_pk_bf16(v[0], v[1]); w.y = cvt_pk_bf16(v[2], v[3]); *(u32x2*)(c.PB + (size_t)r * DPLE + c4 * 4) = w; }
}

__device__ __forceinline__ void load_bf8(const bf16_t* p, float (&x)[8]) { unpack8(*(const u32x4*)p, x); }

#ifndef MIX_REP_SKIP
#define MIX_REP_SKIP 0
#endif
__device__ __forceinline__ void mix_phase(const Ctx& c, int L, int qsel) {
    const int skip = (qsel & 1) ? MIX_REP_SKIP : 0;
    ArgsP a = get_args();
    const bf16_t* ZM = (const bf16_t*)c.BIG;
    const int tid = c.tid, lane = c.lane, wave = c.wave, fr = lane & 15, fq = lane >> 4;
    float* out = a->out;
    unsigned* qctr = (unsigned*)(a->ws + WS_BAR) + 4096 + 128 * qsel;
    volatile LAS unsigned* qslot = (volatile LAS unsigned*)(c.lds + 65536);
    if (!(skip & 1)) for (int b = c.bx; b < 160; b += c.gx) {
        const int row0 = b < 128 ? b * 128 : MP + (b - 128) * 64, R = b < 128 ? 128 : 64;
        LAS unsigned char* vnT = c.lds;
        const float* lg = a->in[18] + L * 512; const float* lb = a->in[19] + L * 512;
        float gch[8], bch[8];
#pragma unroll
        for (int e = 0; e < 8; ++e) { gch[e] = lg[lane + 64 * e]; bch[e] = lb[lane + 64 * e]; }
        float* vout = nullptr;
        if (b < 128) { if ((b & 63) == 63) vout = out + O_VP + ((size_t)(L * 2 + (b >> 6)) * 128) * 512; }
        else vout = out + O_VS + ((size_t)(L * 32 + (b - 128)) * 64) * 512;
        for (int grp = wave; grp < 16; grp += 8) {
            const int j0 = grp * 8;
            if (j0 >= R) {
#pragma unroll
                for (int e = 0; e < 8; ++e) *(LAS u32x4*)(vnT + (lane + 64 * e) * 272 + j0 * 2) = (u32x4){0u, 0u, 0u, 0u};
                continue;
            }
            float y[8][8];
#pragma unroll
            for (int rr = 0; rr < 8; ++rr) {
                const bf16_t* vp = ZM + (size_t)(row0 + j0 + rr) * ZMW + 1024 + lane;
                float s = 0.f;
#pragma unroll
                for (int e = 0; e < 8; ++e) { y[rr][e] = bf2f(vp[64 * e]); s += y[rr][e]; }
                const float mu = wave_sum(s) * (1.0f / 512);
                float q = 0.f;
#pragma unroll
                for (int e = 0; e < 8; ++e) { y[rr][e] -= mu; q += y[rr][e] * y[rr][e]; }
                const float rstd = __builtin_amdgcn_rsqf(wave_sum(q) * (1.0f / 512) + EPS);
#pragma unroll
                for (int e = 0; e < 8; ++e) y[rr][e] = y[rr][e] * rstd * gch[e] + bch[e];
                if (vout) {
#pragma unroll
                    for (int e = 0; e < 8; ++e) vout[(size_t)(j0 + rr) * 512 + lane + 64 * e] = y[rr][e];
                }
            }
#pragma unroll
            for (int e = 0; e < 8; ++e) {
                u32x4 w; w.x = cvt_pk_bf16(y[0][e], y[1][e]); w.y = cvt_pk_bf16(y[2][e], y[3][e]); w.z = cvt_pk_bf16(y[4][e], y[5][e]); w.w = cvt_pk_bf16(y[6][e], y[7][e]);
                *(LAS u32x4*)(vnT + (lane + 64 * e) * 272 + j0 * 2) = w;
            }
        }
        __syncthreads();
        const int ib = wave * 16, nkb = (ib + 15) / 32 + 1;
        const bf16_t* WsB = c.W + W_WS;
        const float* bs = a->in[21] + L * 512;
#pragma unroll 1
        for (int g = 0; g < 4; ++g) {
            bf16x8 af[4];
#pragma unroll
            for (int kb = 0; kb < 4; ++kb) af[kb] = *(const bf16x8*)(WsB + ((size_t)g * 128 + ib + fr) * 128 + kb * 32 + fq * 8);
            float bsv[4]; bf16_t uraw[8][4];
#pragma unroll
            for (int jj = 0; jj < 4; ++jj) bsv[jj] = bs[g * 128 + ib + fq * 4 + jj];
            if (ib < R) {
#pragma unroll
                for (int ni = 0; ni < 8; ++ni)
#pragma unroll
                    for (int jj = 0; jj < 4; ++jj) uraw[ni][jj] = ZM[(size_t)(row0 + ib + fq * 4 + jj) * ZMW + 512 + g * 128 + ni * 16 + fr];
#pragma unroll
                for (int ni = 0; ni < 8; ++ni) {
                    const int col = g * 128 + ni * 16 + fr;
                    f32x4 acc = (f32x4){0.f, 0.f, 0.f, 0.f};
#pragma unroll
                    for (int kb = 0; kb < 4; ++kb) if (kb < nkb) {
                        const bf16x8 bfr = *(const LAS bf16x8*)(vnT + col * 272 + (kb * 32 + fq * 8) * 2);
                        acc = __builtin_amdgcn_mfma_f32_16x16x32_bf16(af[kb], bfr, acc, 0, 0, 0);
                    }
#pragma unroll
                    for (int jj = 0; jj < 4; ++jj) {
                        const size_t r = (size_t)(row0 + ib + fq * 4 + jj);
                        c.XB[r * XW + col] = f2bf(bf2f(uraw[ni][jj]) * (acc[jj] + bsv[jj]));
                    }
                }
            }
        }
        __syncthreads();
    }
    __syncthreads();
    {
        LAS float* wl = (LAS float*)c.lds; const float* wg = a->in[13] + (size_t)L * 31 * 512;
        for (int i = tid; i < 31 * 512 / 4; i += 512) *(LAS f32x4*)(wl + i * 4) = *(const f32x4*)(wg + i * 4);
    }
    __syncthreads();
    {
        const LAS float* wl = (const LAS float*)c.lds;
        float dwb[8], lng[8], lnb[8];
#pragma unroll
        for (int e = 0; e < 8; ++e) { dwb[e] = a->in[14][L * 512 + lane * 8 + e]; lng[e] = a->in[15][L * 512 + lane * 8 + e]; lnb[e] = a->in[16][L * 512 + lane * 8 + e]; }
        unsigned nextv = 0; int qb = M;
        if (!(skip & 2)) { if (tid == 0) *qslot = atomicAdd(qctr, 8u); __syncthreads(); qb = (int)*qslot; __syncthreads(); }
        for (;;) {
            if (qb >= M / 4) break;
            if (tid == 0) nextv = atomicAdd(qctr, 8u);
            const int qi = qb + wave;
            const int itm = qi < MS / 4 ? MP / 4 + qi : qi - MS / 4;
            const int r0 = itm * 4;
            int seq0, trel; const float* hist = nullptr;
            if (r0 < MP) { seq0 = (r0 / SEQ) * SEQ; trel = r0 - seq0; }
            else { const int s = (r0 - MP) / DSEQ; seq0 = MP + s * DSEQ; trel = r0 - seq0; hist = a->in[4] + ((size_t)(L * 32 + s) * 30) * 512; }
            if (!hist || trel >= 30) {
                float ah[2][4][4];
#pragma unroll
                for (int hf = 0; hf < 2; ++hf) {
                    const int ch = hf * 256 + lane * 4; const unsigned choff = (unsigned)ch * 2u;
                    u32x2 raw[34];
#pragma unroll
                    for (int ri = 0; ri < 34; ++ri) { const int t = trel - 30 + ri;
                        const char* rowp = (const char*)ZM + (size_t)(seq0 + (t >= 0 ? t : 0)) * (ZMW * 2);
                        const u32x2 v = *(const u32x2*)(rowp + choff);
                        raw[ri].x = (t >= 0) ? v.x : 0u; raw[ri].y = (t >= 0) ? v.y : 0u; }
#pragma unroll
                    for (int o = 0; o < 4; ++o)
#pragma unroll
                        for (int e = 0; e < 4; ++e) ah[hf][o][e] = 0.f;
                    float xq[4][4];
#pragma unroll
                    for (int i = 0; i < 3; ++i) { xq[i][0] = bflo(raw[i].x); xq[i][1] = bfhi(raw[i].x); xq[i][2] = bflo(raw[i].y); xq[i][3] = bfhi(raw[i].y); }
                    f32x4 w0 = *(const LAS f32x4*)(wl + ch);
#pragma unroll
                    for (int k = 0; k < 31; ++k) {
                        f32x4 n0 = w0;
                        if (k < 30) n0 = *(const LAS f32x4*)(wl + (k + 1) * 512 + ch);
                        { const int i = (k + 3) & 3; xq[i][0] = bflo(raw[k + 3].x); xq[i][1] = bfhi(raw[k + 3].x); xq[i][2] = bflo(raw[k + 3].y); xq[i][3] = bfhi(raw[k + 3].y); }
#pragma unroll
                        for (int o = 0; o < 4; ++o)
#pragma unroll
                            for (int e = 0; e < 4; ++e) ah[hf][o][e] += xq[(k + o) & 3][e] * w0[e];
                        w0 = n0;
                        asm volatile("" : "+v"(ah[hf][0][0]), "+v"(ah[hf][0][1]), "+v"(ah[hf][0][2]), "+v"(ah[hf][0][3]), "+v"(ah[hf][1][0]), "+v"(ah[hf][1][1]), "+v"(ah[hf][1][2]), "+v"(ah[hf][1][3]),
                                          "+v"(ah[hf][2][0]), "+v"(ah[hf][2][1]), "+v"(ah[hf][2][2]), "+v"(ah[hf][2][3]), "+v"(ah[hf][3][0]), "+v"(ah[hf][3][1]), "+v"(ah[hf][3][2]), "+v"(ah[hf][3][3]));
                    }
                }
                const float* pdb = a->in[14] + L * 512; const float* plg = a->in[15] + L * 512; const float* plb = a->in[16] + L * 512;
                f32x4 db[2], lg2[2], lb2[2];
#pragma unroll
                for (int hf = 0; hf < 2; ++hf) { db[hf] = *(const f32x4*)(pdb + hf * 256 + lane * 4); lg2[hf] = *(const f32x4*)(plg + hf * 256 + lane * 4); lb2[hf] = *(const f32x4*)(plb + hf * 256 + lane * 4); }
#pragma unroll
                for (int o = 0; o < 4; ++o) {
                    float sm = 0.f;
#pragma unroll
                    for (int hf = 0; hf < 2; ++hf)
#pragma unroll
                        for (int e = 0; e < 4; ++e) { ah[hf][o][e] += db[hf][e]; sm += ah[hf][o][e]; }
                    const float mu = wave_sum(sm) * (1.0f / 512);
                    float q = 0.f;
#pragma unroll
                    for (int hf = 0; hf < 2; ++hf)
#pragma unroll
                        for (int e = 0; e < 4; ++e) { ah[hf][o][e] -= mu; q += ah[hf][o][e] * ah[hf][o][e]; }
                    const float rstd = __builtin_amdgcn_rsqf(wave_sum(q) * (1.0f / 512) + EPS);
#pragma unroll
                    for (int hf = 0; hf < 2; ++hf) {
                        float y4[4];
#pragma unroll
                        for (int e = 0; e < 4; ++e) { const float yv = ah[hf][o][e] * rstd * lg2[hf][e] + lb2[hf][e]; y4[e] = yv * sigmoidf_(yv); }
                        u32x2 w; w.x = cvt_pk_bf16(y4[0], y4[1]); w.y = cvt_pk_bf16(y4[2], y4[3]);
                        *(u32x2*)(c.XA + (size_t)(r0 + o) * XW + hf * 256 + lane * 4) = w;
                    }
                }
                goto a_item_done;
            }
            float acc[4][8];
#pragma unroll
            for (int o = 0; o < 4; ++o)
#pragma unroll
                for (int e = 0; e < 8; ++e) acc[o][e] = dwb[e];
            float xw[4][8];
            {
            auto ldrow = [&](int ri, float (&x)[8]) {
                const int t = trel - 30 + ri;
                if (t >= 0) load_bf8(ZM + (size_t)(seq0 + t) * ZMW + lane * 8, x);
                else { const f32x4 h0 = *(const f32x4*)(hist + (size_t)(30 + t) * 512 + lane * 8), h1 = *(const f32x4*)(hist + (size_t)(30 + t) * 512 + lane * 8 + 4);
                    x[0] = h0[0]; x[1] = h0[1]; x[2] = h0[2]; x[3] = h0[3]; x[4] = h1[0]; x[5] = h1[1]; x[6] = h1[2]; x[7] = h1[3]; }
            };
            ldrow(0, xw[0]); ldrow(1, xw[1]); ldrow(2, xw[2]);
#pragma unroll 2
            for (int kk = 0; kk < 32; kk += 4) {
#pragma unroll
                for (int k4 = 0; k4 < 4; ++k4) {
                    const int k = kk + k4;
                    if (k < 31) {
                        ldrow(k + 3, xw[(k4 + 3) & 3]);
                        const f32x4 w0 = *(const LAS f32x4*)(wl + k * 512 + lane * 8), w1 = *(const LAS f32x4*)(wl + k * 512 + lane * 8 + 4);
#pragma unroll
                        for (int o = 0; o < 4; ++o) {
#pragma unroll
                            for (int e = 0; e < 4; ++e) { acc[o][e] += xw[(k4 + o) & 3][e] * w0[e]; acc[o][e + 4] += xw[(k4 + o) & 3][e + 4] * w1[e]; }
                        }
                    }
                }
            }
            }
#pragma unroll
            for (int o = 0; o < 4; ++o) {
                float s = 0.f;
#pragma unroll
                for (int e = 0; e < 8; ++e) s += acc[o][e];
                const float mu = wave_sum(s) * (1.0f / 512);
                float q = 0.f;
#pragma unroll
                for (int e = 0; e < 8; ++e) { acc[o][e] -= mu; q += acc[o][e] * acc[o][e]; }
                const float rstd = __builtin_amdgcn_rsqf(wave_sum(q) * (1.0f / 512) + EPS);
                float h[8];
#pragma unroll
                for (int e = 0; e < 8; ++e) { const float yv = acc[o][e] * rstd * lng[e] + lnb[e]; h[e] = yv * sigmoidf_(yv); }
                *(u32x4*)(c.XA + (size_t)(r0 + o) * XW + lane * 8) = pack8(h);
            }
            a_item_done:
            if (tid == 0) *qslot = nextv;
            __syncthreads();
            qb = (int)*qslot;
            __syncthreads();
        }
    }
    {
        const int win = 2 << (lane >> 4);
        unsigned nextv = 0; int qb = M;
        if (!(skip & 4)) { if (tid == 0) *qslot = atomicAdd(qctr + 64, 8u); __syncthreads(); qb = (int)*qslot; __syncthreads(); }
        for (;;) {
            if (qb >= M / 4) break;
            if (tid == 0) nextv = atomicAdd(qctr + 64, 8u);
            const int qi = qb + wave;
            const int itm = qi < MS / 4 ? MP / 4 + qi : qi - MS / 4;
            const int r0 = itm * 4;
            int seq0, trel; const float* hist = nullptr;
            if (r0 < MP) { seq0 = (r0 / SEQ) * SEQ; trel = r0 - seq0; }
            else { const int s = (r0 - MP) / DSEQ; seq0 = MP + s * DSEQ; trel = r0 - seq0; hist = a->in[5] + ((size_t)(L * 32 + s) * 15) * 512; }
            float acc[4][8], cur[4][8];
#pragma unroll
            for (int o = 0; o < 4; ++o)
#pragma unroll
                for (int e = 0; e < 8; ++e) { acc[o][e] = 0.f; cur[o][e] = 0.f; }
#pragma unroll
            for (int ri = 0; ri < 19; ++ri) {
                const int t = trel - 15 + ri;
                float x[8];
                if (t >= 0) load_bf8(ZM + (size_t)(seq0 + t) * ZMW + 1536 + lane * 8, x);
                else if (hist) { const f32x4 h0 = *(const f32x4*)(hist + (size_t)(15 + t) * 512 + lane * 8), h1 = *(const f32x4*)(hist + (size_t)(15 + t) * 512 + lane * 8 + 4);
                    x[0] = h0[0]; x[1] = h0[1]; x[2] = h0[2]; x[3] = h0[3]; x[4] = h1[0]; x[5] = h1[1]; x[6] = h1[2]; x[7] = h1[3]; }
                else {
#pragma unroll
                    for (int e = 0; e < 8; ++e) x[e] = 0.f; }
#pragma unroll
                for (int o = 0; o < 4; ++o) {
                    const int dd = 15 + o - ri;
                    if (dd >= 0 && dd < 16) {
                        const bool inw = dd < win;
#pragma unroll
                        for (int e = 0; e < 8; ++e) acc[o][e] += inw ? x[e] : 0.f;
                        if (dd == 0) {
#pragma unroll
                            for (int e = 0; e < 8; ++e) cur[o][e] = x[e];
                        }
                    }
                }
            }
#pragma unroll
            for (int o = 0; o < 4; ++o) {
                const int cnt = hist ? win : min(trel + o + 1, win);
                const float inv = 1.0f / (float)cnt;
                float h[8];
#pragma unroll
                for (int e = 0; e < 8; ++e) h[e] = acc[o][e] * inv - cur[o][e];
                *(u32x4*)(c.XD + (size_t)(r0 + o) * XW + lane * 8) = pack8(h);
            }
            if (tid == 0) *qslot = nextv;
            __syncthreads();
            qb = (int)*qslot;
            __syncthreads();
        }
    }
    for (int idx = c.gw; idx < 34 * 45; idx += c.nW) {
        const int seq = idx / 45, k = idx - seq * 45;
        size_t srow; float* dst; int coff;
        if (k < 30) { coff = 0;
            if (seq < 2) { srow = (size_t)seq * SEQ + (SEQ - 30) + k; dst = out + O_CONVP + ((size_t)(L * 2 + seq) * 30 + k) * 512; }
            else { srow = (size_t)MP + (seq - 2) * DSEQ + (DSEQ - 30) + k; dst = out + O_CONVS + ((size_t)(L * 32 + seq - 2) * 30 + k) * 512; }
        } else { const int kk = k - 30; coff = 1536;
            if (seq < 2) { srow = (size_t)seq * SEQ + (SEQ - 15) + kk; dst = out + O_POOLP + ((size_t)(L * 2 + seq) * 15 + kk) * 512; }
            else { srow = (size_t)MP + (seq - 2) * DSEQ + (DSEQ - 15) + kk; dst = out + O_POOLS + ((size_t)(L * 32 + seq - 2) * 15 + kk) * 512; }
        }
        float x[8]; load_bf8(ZM + srow * ZMW + coff + lane * 8, x);
        *(f32x4*)(dst + lane * 8) = (f32x4){x[0], x[1], x[2], x[3]}; *(f32x4*)(dst + lane * 8 + 4) = (f32x4){x[4], x[5], x[6], x[7]};
    }
    __syncthreads();
}


#define XB_TMO      128
#define XB_XCNT(j)  (256  + 64 * (j))
#define XB_XSUB(j)  (1280 + 64 * (j))
#define XB_XGEN(j)  (2304 + 64 * (j))
#define XB_TOP      3328
#define XB_TOPGEN   3392
#define XCD_BAR_WORDS 3456
#define XB_SPIN_CAP (1u << 22)
__device__ __forceinline__ unsigned xb_ld(unsigned* p)              { return __hip_atomic_load(p, __ATOMIC_RELAXED, __HIP_MEMORY_SCOPE_AGENT); }
__device__ __forceinline__ unsigned xb_add(unsigned* p, unsigned v) { return __hip_atomic_fetch_add(p, v, __ATOMIC_RELAXED, __HIP_MEMORY_SCOPE_AGENT); }
__device__ __forceinline__ unsigned xb_xcc_id() { return (unsigned)__builtin_amdgcn_s_getreg((3 << 11) | 20) & 0xFu; }
#define XB_SPIN(cond, bar) do { unsigned _sp = 0; while (cond) { __builtin_amdgcn_s_sleep(1); \
    if ((++_sp & 255u) == 0u) { if (xb_ld(&(bar)[XB_TMO])) break; if (_sp > XB_SPIN_CAP) { atomicAdd(&(bar)[XB_TMO], 1u); break; } } } } while (0)
__device__ __forceinline__ void xcd_barrier_complete(unsigned* bar, unsigned x, unsigned& nloc, unsigned& nx) {
    const unsigned G = gridDim.x * gridDim.y * gridDim.z;
    unsigned sum, cnt, mine, sp = 0u;
    for (;;) {
        sum = 0u; cnt = 0u; mine = 0u;
#pragma unroll
        for (unsigned j = 0; j < 16; ++j) { const unsigned c = xb_ld(&bar[XB_XCNT(j)]); sum += c; cnt += (c > 0u) ? 1u : 0u; mine = (j == x) ? c : mine; }
        if (sum == G) break;
        __builtin_amdgcn_s_sleep(1);
        if ((++sp & 255u) == 0u) { if (xb_ld(&bar[XB_TMO])) break; if (sp > XB_SPIN_CAP) { atomicAdd(&bar[XB_TMO], 1u); break; } }
    }
    nloc = mine > 0u ? mine : 1u; nx = cnt > 0u ? cnt : 1u;
}
__device__ __forceinline__ void xcd_barrier(unsigned* bar, volatile LAS unsigned* st, int tid) {
    asm volatile("s_waitcnt vmcnt(0)" ::: "memory");
    __syncthreads();
    if (tid == 0) {
        __builtin_amdgcn_s_waitcnt(0);
        const unsigned x = xb_xcc_id();
        unsigned nloc = st[0], nx = st[1];
        if (nloc == 0u) { xcd_barrier_complete(bar, x, nloc, nx); st[0] = nloc; st[1] = nx;
            const unsigned G8 = (gridDim.x * gridDim.y * gridDim.z) >> 3; bool uni = ((G8 << 3) == gridDim.x * gridDim.y * gridDim.z) && nx == 8u && x < 8u;
#pragma unroll
            for (unsigned j = 0; j < 8; ++j) uni = uni && (xb_ld(&bar[XB_XCNT(j)]) == G8);
            if (uni) st[2] = st[3] * 8u + x;
            st[3] = (uni && gridDim.x == 256u) ? 1u : 0u; }
        const unsigned old = xb_add(&bar[XB_XSUB(x)], 1u);
        const unsigned gen = old / nloc;
        if (old + 1u == (gen + 1u) * nloc) {
            __builtin_amdgcn_fence(__ATOMIC_RELEASE, "agent");
            asm volatile("s_waitcnt vmcnt(0)" ::: "memory");
            const unsigned og = xb_add(&bar[XB_TOP], 1u);
            const unsigned tg = og / nx;
            if (og + 1u == (tg + 1u) * nx) xb_add(&bar[XB_TOPGEN], 1u);
            else XB_SPIN(xb_ld(&bar[XB_TOPGEN]) == tg, bar);
            __builtin_amdgcn_fence(__ATOMIC_ACQUIRE, "agent");
            xb_add(&bar[XB_XGEN(x)], 1u);
            asm volatile("s_waitcnt vmcnt(0)" ::: "memory");
        } else {
            XB_SPIN(xb_ld(&bar[XB_XGEN(x)]) == gen, bar);
            __builtin_amdgcn_fence(__ATOMIC_ACQUIRE, "agent");
            asm volatile("s_waitcnt vmcnt(0)" ::: "memory");
        }
    }
    __syncthreads();
}

constexpr int NPT = 6;
constexpr int P0N = 1 + (int)(REP_MASK & 1u), PPL = NPT + __builtin_popcount((REP_MASK >> 1) & ((1u << NPT) - 1u)), NPHASE = P0N + PPL * NLAYER + 1;

__global__ void __launch_bounds__(512, 2) fwd_kernel(Args args) {
    extern __shared__ __attribute__((aligned(16))) unsigned char lds_raw[];
    (void)args;
    LAS unsigned char* lds = (LAS unsigned char*)lds_raw;
    const int wave0 = __builtin_amdgcn_readfirstlane((int)threadIdx.x >> 6);
    const int hi = get_args()->ph_hi;
    unsigned* bar = (unsigned*)(get_args()->ws + WS_BAR);
    volatile LAS unsigned* bst = (volatile LAS unsigned*)(lds + LDS_BYTES - 16);
    if (threadIdx.x == 0) { bst[0] = 0u; bst[1] = 0u; bst[2] = blockIdx.x; bst[3] = xb_add(&bar[XB_XCNT(xb_xcc_id())], 1u); }
    __syncthreads();
#define MKCTX() Ctx c; { ArgsP ka = get_args(); int t_; asm volatile("v_mbcnt_lo_u32_b32 %0, -1, 0\n\tv_mbcnt_hi_u32_b32 %0, -1, %0" : "=v"(t_)); int wv_ = wave0, bx_ = (int)__builtin_amdgcn_readfirstlane((int)*(volatile LAS unsigned*)(lds + LDS_BYTES - 8)), gx_ = (int)gridDim.x; asm volatile("" : "+s"(wv_), "+s"(bx_), "+s"(gx_)); t_ += wv_ * 64; unsigned char* ws = ka->ws; \
        c.lds = lds; c.tid = t_; c.lane = t_ & 63; c.wave = wv_; c.bx = bx_; c.gx = gx_; c.gw = bx_ * 8 + wv_; c.nW = gx_ * 8; \
        c.H = ka->out; c.SS = (float*)ws; c.NB2 = (bf16_t*)(ws + WS_NB2); c.W = (bf16_t*)(ws + WS_W); c.PB = (bf16_t*)(ws + WS_PB); c.NB = (bf16_t*)(ws + WS_NB); c.BIG = ws + WS_BIG; \
        c.XA = (bf16_t*)(ws + WS_X); c.XB = c.XA + (size_t)M * XW; c.XD = c.XB + (size_t)M * XW; c.XC = c.XD + (size_t)M * XW; } \
        bf16_t* HID = (bf16_t*)c.BIG; bf16_t* ZM = (bf16_t*)c.BIG; bf16_t* ZG = (bf16_t*)c.BIG; float* T = (float*)c.BIG; (void)HID; (void)ZM; (void)ZG; (void)T; \

#define GEMM1(EPI, Aptr, Bptr, Nn, Kk, ...) do { pg8::Gemm g{(Aptr), (Aptr), (Aptr), (Bptr), (Bptr), (Bptr)}; \
        pg8::EPI E{__VA_ARGS__}; pg8::gemm_phase<pg8::EPI, (Nn), (Kk), 1, G_ALIGN, G_SP2>(lds, c.tid, g, E); } while (0)

#pragma unroll 1
    for (int ph = get_args()->ph_lo; ph < hi; ++ph) {
        int L = 0, j = -1, rep = 0;
        if (ph < P0N) rep = ph;
        else if (ph >= P0N + PPL * NLAYER) { L = NLAYER - 1; j = NPT; }
        else { int q = ph - P0N; L = q / PPL; q -= L * PPL;
            for (int jj = 0; jj < NPT; ++jj) { const int cnt = 1 + (int)((REP_MASK >> (jj + 1)) & 1u); if (q < cnt) { j = jj; rep = q; break; } q -= cnt; } }
        const float rsc = rep ? 0.f : 1.f, rsh = rep ? 0.f : 0.5f;
        {
#ifdef PH_ONLY
        switch (PH_ONLY) {
#else
        switch (j) {
#endif
        case -1: { MKCTX(); prep_phase(c, 0, 0, 1648, c.bx, c.gx, true); norm_phase<0>(c, nullptr); } break;
        case 0: case 4: { MKCTX(); const bool f1 = (j == 0);
            pg8::FfnArgs fa{f1 ? c.NB2 : c.NB, c.W + (f1 ? W_GU1 : W_GU2), HID, c.W + (f1 ? W_D1 : W_D2), c.SS + (size_t)(4 * L + (f1 ? 0 : 2)) * M,
                            c.H, c.NB, c.SS + (size_t)(4 * L + (f1 ? 1 : 3)) * M, (unsigned*)(get_args()->ws + WS_BAR) + 8192 + 1152 * (2 * (2 * L + (f1 ? 0 : 1)) + rep),
                            (f1 && L == 0 && !rep) ? get_args()->in[0] : nullptr, (f1 && L == 0 && !rep) ? get_args()->in[1] : nullptr,
                            f1 ? nullptr : c.PB, c.W + W_PE, (float*)c.XA, rsh, rsc};
            pg8::ffn_phase(lds, c.tid, fa); } break;
        case 1: { MKCTX(); GEMM1(EpiWinMix, c.NB, c.W + W_IM, 2560, D, ZM, c.SS + (size_t)(4 * L + 1) * M);
            if (L > 0 && !rep && c.gx > 64) prep_phase(c, L, 1568, 1632, c.bx - 208, c.gx - 208, false);
        } break;
        case 2: { MKCTX(); mix_phase(c, L, 2 * L + rep); } break;
        case 3: { MKCTX();
            unsigned* tc = (unsigned*)(get_args()->ws + WS_BAR) + 17408 + 2304 * (2 * L + rep);
            pg8::TailArgs ta{get_args()->ws, c.H, get_args()->in[12] + L * 3072, get_args()->in[24] + L * 512, c.SS + (size_t)(4 * L + 1) * M, c.SS + (size_t)(4 * L + 2) * M, tc, tc + 1152, rsc};
            pg8::tail_phase(lds, c.tid, ta); } break;
        case 5: {
            { MKCTX(); GEMM1(EpiPE, c.NB, c.W + W_PG, D, D, c.H, (const float*)c.XA, rsc, c.SS + (size_t)(4 * L + 3) * M, c.NB2, c.SS + (size_t)(4 * L + 4) * M); }
            if (L + 1 < NLAYER && !rep) { MKCTX();
                if (c.gx > 64) { prep_phase(c, L + 1, 0, 1568, c.bx - 32, c.gx - 32, false); prep_phase(c, L + 1, 1632, 1648, c.bx - 32, c.gx - 32, true); }
                else prep_phase(c, L + 1, 0, 1648, c.bx, c.gx, true); }
        } break;
        default: { MKCTX(); if (!rep) norm_phase<2>(c, get_args()->in[34]); } break;
        }
        }
        if (ph + 1 < hi) {
            if (hi < 0) cg::this_grid().sync();
            { int t_; asm volatile("v_mbcnt_lo_u32_b32 %0, -1, 0\n\tv_mbcnt_hi_u32_b32 %0, -1, %0" : "=v"(t_)); xcd_barrier(bar, bst, t_ + wave0 * 64); }
        }
    }
#undef GEMM1
#undef MKCTX
}

extern "C" void kernel_launch(void* const* d_in, const int* in_sizes, int n_in, void* d_out, int out_size, void* d_ws, size_t ws_size, hipStream_t stream) {
    static int grid = 0;
    if (grid == 0) {
        if (n_in != 35 || (size_t)out_size != O_END || ws_size < WS_END) { fprintf(stderr, "kernel_launch: unexpected shapes (n_in %d, out %d, ws %zu)\n", n_in, out_size, ws_size); grid = -1; return; }
        int dev = 0, cus = 0, per_cu = 0;
        if (hipGetDevice(&dev) != hipSuccess || hipDeviceGetAttribute(&cus, hipDeviceAttributeMultiprocessorCount, dev) != hipSuccess) { grid = -1; return; }
        if (hipFuncSetAttribute((const void*)fwd_kernel, hipFuncAttributeMaxDynamicSharedMemorySize, LDS_BYTES) != hipSuccess) { fprintf(stderr, "kernel_launch: hipFuncSetAttribute failed\n"); grid = -1; return; }
        if (hipOccupancyMaxActiveBlocksPerMultiprocessor(&per_cu, (const void*)fwd_kernel, 512, LDS_BYTES) != hipSuccess || per_cu < 1) { fprintf(stderr, "kernel_launch: occupancy query says %d\n", per_cu); per_cu = 1; }
        (void)hipGetLastError();
        grid = cus * 1;
    }
    if (grid < 0) return;
    Args a{};
    for (int i = 0; i < 35; ++i) a.in[i] = (const float*)d_in[i];
    a.out = (float*)d_out; a.ws = (unsigned char*)d_ws;
#if MK_N_LAUNCHES == 1
    (void)hipMemsetAsync((char*)d_ws + WS_BAR, 0, 131072, stream);
    a.ph_lo = 0; a.ph_hi = NPHASE;
    void* kargs[] = {&a};
    hipError_t e = hipLaunchCooperativeKernel((const void*)fwd_kernel, dim3(grid), dim3(512), kargs, LDS_BYTES, stream);
    if (e != hipSuccess) fprintf(stderr, "kernel_launch: cooperative launch failed: %s (grid %d)\n", hipGetErrorString(e), grid);
#else
    for (int ph = 0; ph < NPHASE; ++ph) {
        a.ph_lo = ph; a.ph_hi = ph + 1;
        hipLaunchKernelGGL(fwd_kernel, dim3(grid), dim3(512), LDS_BYTES, stream, a);
    }
#endif
}
```

```cpp
#include <hip/hip_runtime.h>
#include <hip/hip_cooperative_groups.h>
#include <cstdio>
#include <cstdint>
namespace cg = cooperative_groups;

#ifndef MK_N_LAUNCHES
#define MK_N_LAUNCHES 1
#endif
#ifndef REP_MASK
#define REP_MASK 0u
#endif
#ifndef G_SP2
#define G_SP2 true
#endif
#ifndef G_ALIGN
#define G_ALIGN true
#endif

#define LAS __attribute__((address_space(3)))
typedef unsigned short bf16_t;
typedef short bf16x8 __attribute__((ext_vector_type(8)));
typedef float f32x4 __attribute__((ext_vector_type(4)));
typedef unsigned u32x4 __attribute__((ext_vector_type(4)));
typedef unsigned u32x2 __attribute__((ext_vector_type(2)));

constexpr int D = 1024, FF = 2816, MP = 16384, MS = 2048, M = MP + MS, SEQ = 8192, DSEQ = 64, DPLE = 256;
constexpr int NLAYER = 2;
constexpr float EPS = 1e-6f;
constexpr int ZMW = 2048, ZGW = 3072, XW = 512;
constexpr size_t O_Y = 0, O_CONVP = (size_t)M * D, O_CONVS = O_CONVP + 2 * 2 * 30 * 512, O_POOLP = O_CONVS + 2 * 32 * 30 * 512,
                 O_POOLS = O_POOLP + 2 * 2 * 15 * 512, O_VP = O_POOLS + 2 * 32 * 15 * 512, O_VS = O_VP + 2 * 2 * 128 * 512, O_END = O_VS + 2 * 32 * 64 * 512;
constexpr size_t MiB = 1u << 20;
constexpr size_t WS_BAR = 768 * 1024, WS_W = 1 * MiB, WS_PB = 54 * MiB, WS_NB = 63 * MiB, WS_BIG = 99 * MiB, WS_X = 207 * MiB, WS_NB2 = 279 * MiB, WS_END = 315 * MiB;
constexpr size_t W_GU1 = 0, W_D1 = W_GU1 + (size_t)5632 * 1024, W_IM = W_D1 + (size_t)1024 * 2816, W_IG = W_IM + (size_t)2560 * 1024,
                 W_CA = W_IG + (size_t)3072 * 1024, W_SB = W_CA + 524288, W_PC = W_SB + 524288, W_PBD = W_PC + 524288, W_O = W_PBD + 262144,
                 W_GU2 = W_O + 1048576, W_D2 = W_GU2 + (size_t)5632 * 1024, W_PG = W_D2 + (size_t)1024 * 2816, W_PE = W_PG + 1048576,
                 W_WS = W_PE + 262144, W_TOTAL = W_WS + 65536;
static_assert(W_TOTAL * 2 <= 53 * MiB, "weight region");
constexpr int LDS_BYTES = 147456;

typedef __bf16 bf16x2_t __attribute__((ext_vector_type(2)));
__device__ __forceinline__ unsigned cvt_pk_bf16(float lo, float hi) { bf16x2_t v; v[0] = (__bf16)lo; v[1] = (__bf16)hi; return __builtin_bit_cast(unsigned, v); }
__device__ __forceinline__ bf16_t f2bf(float f) { return (bf16_t)(cvt_pk_bf16(f, 0.f) & 0xffffu); }
__device__ __forceinline__ float bf2f(bf16_t b) { return __uint_as_float(((unsigned)b) << 16); }
__device__ __forceinline__ float bflo(unsigned w) { return __uint_as_float(w << 16); }
__device__ __forceinline__ float bfhi(unsigned w) { return __uint_as_float(w & 0xffff0000u); }
__device__ __forceinline__ float sigmoidf_(float x) { return __builtin_amdgcn_rcpf(1.0f + __builtin_amdgcn_exp2f(-1.4426950408889634f * x)); }
__device__ __forceinline__ float wave_sum(float v) {
#pragma unroll
    for (int o = 32; o > 0; o >>= 1) v += __shfl_xor(v, o);
    return v;
}
__device__ __forceinline__ void unpack8(const u32x4 w, float (&x)[8]) {
    x[0] = bflo(w.x); x[1] = bfhi(w.x); x[2] = bflo(w.y); x[3] = bfhi(w.y); x[4] = bflo(w.z); x[5] = bfhi(w.z); x[6] = bflo(w.w); x[7] = bfhi(w.w);
}
__device__ __forceinline__ u32x4 pack8(const float (&x)[8]) {
    u32x4 w; w.x = cvt_pk_bf16(x[0], x[1]); w.y = cvt_pk_bf16(x[2], x[3]); w.z = cvt_pk_bf16(x[4], x[5]); w.w = cvt_pk_bf16(x[6], x[7]); return w;
}

#define HANDOFF_STORE(v, rsrc, off, samel2) do { if (samel2) __builtin_amdgcn_raw_buffer_store_b128((v), (rsrc), (off), 0, 0); else __builtin_amdgcn_raw_buffer_store_b128((v), (rsrc), (off), 0, 16); } while (0)
#define SAME_L2(ldsbase) (__builtin_amdgcn_readfirstlane((int)*(volatile LAS unsigned*)((ldsbase) + LDS_BYTES - 4)) != 0)

namespace pg8 {
constexpr int BM = 256, BK = 64, HALF = 128, HTB = HALF * BK * 2, STAGE_BYTES = 8 * HTB, NXCD = 8, WGM = 8;
__device__ __forceinline__ int lds_byte(int r, int c) { const int st = (r >> 4) * 2 + (c >> 5), rr = r & 15, cc = c & 31, ob = rr * 64 + cc * 2; return st * 1024 + (ob ^ (((ob >> 9) & 1) << 5)); }
__device__ __forceinline__ void stage_rc(int b, int& R, int& C) { const int st = b / 1024, sb = b % 1024, swz = sb ^ (((sb >> 9) & 1) << 5); R = (st >> 1) * 16 + swz / 64; C = (st & 1) * 32 + (swz % 64) / 2; }
__device__ __forceinline__ int perm32(int rho) { const int n = rho >> 4, i = rho & 15; return 8 * (i >> 2) + 4 * n + (i & 3); }

struct Unit { int pm, pn, pass; };
struct Gemm { const bf16_t* A0; const bf16_t* A1; const bf16_t* A2; const bf16_t* B0; const bf16_t* B1; const bf16_t* B2; };
template <int N_, int NPASS>
struct Sched {
    static constexpr int nM = 18432 / BM, nN = N_ / BM, nwg = nM * nN;
    __device__ __forceinline__ static bool next(int i, int G, int c, Unit& u) {
        const int ti = i / NPASS; u.pass = i - ti * NPASS;
        const int L = ti * G + c; if (L >= nwg) return false;
        int wgid = L; { constexpr int q = nwg / NXCD, r = nwg % NXCD; const int xcd = wgid % NXCD, off = wgid / NXCD; wgid = (xcd < r ? xcd * (q + 1) : r * (q + 1) + (xcd - r) * q) + off; }
        constexpr int nig = WGM * nN; const int gid = wgid / nig, fm = gid * WGM, gsz = (nM - fm) < WGM ? (nM - fm) : WGM;
        u.pm = fm + ((wgid % nig) % gsz); u.pn = (wgid % nig) / gsz; return true;
    }
};
template <class Epi, int N_, int K, int NPASS, bool ALIGN_EPI, bool SP2, bool ONE = false>
__device__ __forceinline__ void gemm_phase(LAS unsigned char* lds, int tid_in, const Gemm g, const Epi& E, int one_pm = 0, int one_pn = 0) {
    typedef Sched<N_, NPASS> S;
#define PG8_NEXT(i, u) (ONE ? ((i) < NPASS ? ((u).pm = one_pm, (u).pn = one_pn, (u).pass = (i), true) : false) : S::next((i), sG, sC, (u)))
    int tid_ = tid_in; asm volatile("" : "+v"(tid_));
    const int tid = tid_, wid = __builtin_amdgcn_readfirstlane(tid >> 6), lane = tid & 63, wr = wid >> 2, wc = wid & 3, fr = lane & 15, fq = lane >> 4;
    constexpr int nt = K / BK;
    unsigned voffA[2], voffB[2];
#pragma unroll
    for (int i = 0; i < 2; ++i) { int R, C; stage_rc(tid * 16 + i * 8192, R, C); const int Rb = (R & ~31) + perm32(R & 31);
        voffA[i] = (unsigned)(R * K + C) * 2u; voffB[i] = (unsigned)(Rb * K + C) * 2u; }
    constexpr size_t kstep = (size_t)(BK * 2);
    constexpr size_t hstep = (size_t)HALF * K * 2;
    constexpr size_t tstep = 2 * hstep;
    const unsigned ldsw = (unsigned)wid * 1024u;
    const int aoff = lds_byte(wr * 64 + fr, fq * 8), boff = lds_byte(wc * 32 + fr, fq * 8);
#define PG8_SA(b, h) (((b) * 2 + (h)) * HTB)
#define PG8_SB(b, h) ((4 + (b) * 2 + (h)) * HTB)
#define PG8_STAGE(bufoff, gbase, voff) do { _Pragma("unroll") for (int _i = 0; _i < 2; ++_i) \
        __builtin_amdgcn_global_load_lds((const unsigned*)((const char*)(gbase) + (voff)[_i]), (LAS unsigned*)(lds + (bufoff) + ldsw + _i * 8192), 16, 0, 0); } while (0)
#define PG8_LDA(dst, b, h) do { _Pragma("unroll") for (int m = 0; m < 4; ++m) _Pragma("unroll") for (int k = 0; k < 2; ++k) dst[m][k] = *(const LAS bf16x8*)(lds + PG8_SA(b, h) + aoff + m * 2048 + k * 1024); } while (0)
#define PG8_LDB(dst, b, h) do { _Pragma("unroll") for (int n = 0; n < 2; ++n) _Pragma("unroll") for (int k = 0; k < 2; ++k) dst[n][k] = *(const LAS bf16x8*)(lds + PG8_SB(b, h) + boff + n * 2048 + k * 1024); } while (0)
#define PG8_MMA(ai, bj, At, Bt) do { __builtin_amdgcn_s_setprio(1); _Pragma("unroll") for (int m = 0; m < 4; ++m) _Pragma("unroll") for (int n = 0; n < 2; ++n) _Pragma("unroll") for (int k = 0; k < 2; ++k) \
        acc[ai][bj][m][n] = __builtin_amdgcn_mfma_f32_16x16x32_bf16(Bt[n][k], At[m][k], acc[ai][bj][m][n], 0, 0, 0); __builtin_amdgcn_s_setprio(0); } while (0)
#define PG8_WAIT_V(n) asm volatile("s_waitcnt vmcnt(" #n ")" ::: "memory")
#define PG8_WAIT_L(n) asm volatile("s_waitcnt lgkmcnt(" #n ")" ::: "memory")
#define PG8_BAR __builtin_amdgcn_s_barrier()
#define PG8_SCHED __builtin_amdgcn_sched_barrier(0)
#define PG8_ABASE(u) ((const char*)((u).pass == 0 ? g.A0 : ((u).pass == 1 ? g.A1 : g.A2)))
#define PG8_BBASE(u) ((const char*)((u).pass == 0 ? g.B0 : ((u).pass == 1 ? g.B1 : g.B2)))
    Unit cur, nxt; int ui = 0;
    int sG = (int)gridDim.x, sC = (int)__builtin_amdgcn_readfirstlane((int)*(volatile LAS unsigned*)(lds + LDS_BYTES - 8)); asm volatile("" : "+s"(sG), "+s"(sC));
    if (!PG8_NEXT(0, cur)) return;
    f32x4 acc[2][2][4][2];
#pragma unroll
    for (int a = 0; a < 2; ++a)
#pragma unroll
        for (int b = 0; b < 2; ++b)
#pragma unroll
            for (int m = 0; m < 4; ++m)
#pragma unroll
                for (int n = 0; n < 2; ++n) acc[a][b][m][n] = (f32x4){0.f, 0.f, 0.f, 0.f};
    bf16x8 At[4][2], B0[2][2], B1[2][2];
    const char* cA = PG8_ABASE(cur) + (size_t)cur.pm * tstep; const char* cB = PG8_BBASE(cur) + (size_t)cur.pn * tstep;
    if constexpr (SP2) {
        PG8_STAGE(PG8_SB(0, 0), cB, voffB); PG8_STAGE(PG8_SB(0, 1), cB + hstep, voffB); PG8_STAGE(PG8_SA(0, 0), cA, voffA); PG8_STAGE(PG8_SA(0, 1), cA + hstep, voffA);
        if (wr == 1) PG8_BAR;
        PG8_WAIT_V(2); PG8_BAR;
        PG8_STAGE(PG8_SB(1, 0), cB + kstep, voffB); PG8_STAGE(PG8_SA(1, 0), cA + kstep, voffA); PG8_STAGE(PG8_SB(1, 1), cB + hstep + kstep, voffB);
        PG8_WAIT_V(6); PG8_BAR;
    } else {
        PG8_STAGE(PG8_SB(0, 0), cB, voffB); PG8_STAGE(PG8_SA(0, 0), cA, voffA); PG8_STAGE(PG8_SB(0, 1), cB + hstep, voffB); PG8_STAGE(PG8_SA(0, 1), cA + hstep, voffA);
        if (wr == 1) PG8_BAR;
        PG8_WAIT_V(4); PG8_BAR;
        PG8_STAGE(PG8_SB(1, 0), cB + kstep, voffB); PG8_STAGE(PG8_SA(1, 0), cA + kstep, voffA); PG8_STAGE(PG8_SB(1, 1), cB + hstep + kstep, voffB);
        PG8_WAIT_V(6); PG8_BAR;
    }
    for (;;) {
        const bool has_next = PG8_NEXT(ui + 1, nxt);
        const char* nA = has_next ? PG8_ABASE(nxt) + (size_t)nxt.pm * tstep : cA; const char* nB = has_next ? PG8_BBASE(nxt) + (size_t)nxt.pn * tstep : cB;
#pragma unroll 1
        for (int t = 0; t < nt; t += 2) {
            const bool last = (t == nt - 2);
            const char* a1 = cA + (size_t)(t + 1) * kstep;
            const char* a2 = last ? nA : cA + (size_t)(t + 2) * kstep; const char* b2 = last ? nB : cB + (size_t)(t + 2) * kstep;
            const char* a3 = a2 + kstep; const char* b3 = b2 + kstep;
            if constexpr (SP2) {
            PG8_LDB(B0, 0, 0); PG8_LDB(B1, 0, 1); PG8_SCHED; PG8_LDA(At, 0, 0); PG8_STAGE(PG8_SA(1, 1), a1 + hstep, voffA);
            PG8_WAIT_V(8); PG8_WAIT_L(0); PG8_BAR; PG8_MMA(0, 0, At, B0); PG8_MMA(0, 1, At, B1); PG8_BAR; PG8_SCHED;
            PG8_LDA(At, 0, 1); PG8_STAGE(PG8_SB(0, 0), b2, voffB); PG8_STAGE(PG8_SB(0, 1), b2 + hstep, voffB); PG8_STAGE(PG8_SA(0, 0), a2, voffA);
            PG8_WAIT_V(8); PG8_WAIT_L(0); PG8_BAR; PG8_MMA(1, 0, At, B0); PG8_MMA(1, 1, At, B1); PG8_BAR; PG8_SCHED;
            PG8_LDB(B0, 1, 0); PG8_LDB(B1, 1, 1); PG8_SCHED; PG8_LDA(At, 1, 0); PG8_STAGE(PG8_SA(0, 1), a2 + hstep, voffA);
            PG8_WAIT_V(8); PG8_WAIT_L(0); PG8_BAR; PG8_MMA(0, 0, At, B0); PG8_MMA(0, 1, At, B1); PG8_BAR; PG8_SCHED;
            PG8_LDA(At, 1, 1); PG8_STAGE(PG8_SB(1, 0), b3, voffB); PG8_STAGE(PG8_SB(1, 1), b3 + hstep, voffB); PG8_STAGE(PG8_SA(1, 0), a3, voffA);
            PG8_WAIT_V(8); PG8_WAIT_L(0); PG8_BAR; PG8_MMA(1, 0, At, B0); PG8_MMA(1, 1, At, B1); PG8_BAR; PG8_SCHED;
            } else {
            PG8_LDB(B0, 0, 0); PG8_SCHED; PG8_LDA(At, 0, 0); PG8_STAGE(PG8_SA(1, 1), a1 + hstep, voffA);
            PG8_WAIT_L(8); PG8_BAR; PG8_WAIT_L(0); PG8_MMA(0, 0, At, B0); PG8_BAR; PG8_SCHED;
            PG8_LDB(B1, 0, 1); PG8_STAGE(PG8_SB(0, 0), b2, voffB);
            PG8_BAR; PG8_WAIT_L(0); PG8_MMA(0, 1, At, B1); PG8_BAR;
            PG8_LDA(At, 0, 1); PG8_STAGE(PG8_SA(0, 0), a2, voffA);
            PG8_BAR; PG8_WAIT_L(0); PG8_MMA(1, 0, At, B0); PG8_BAR; PG8_SCHED;
            PG8_STAGE(PG8_SB(0, 1), b2 + hstep, voffB);
            PG8_WAIT_V(6); PG8_BAR; PG8_MMA(1, 1, At, B1); PG8_BAR;
            PG8_LDB(B0, 1, 0); PG8_SCHED; PG8_LDA(At, 1, 0); PG8_STAGE(PG8_SA(0, 1), a2 + hstep, voffA);
            PG8_WAIT_L(8); PG8_BAR; PG8_WAIT_L(0); PG8_MMA(0, 0, At, B0); PG8_BAR; PG8_SCHED;
            PG8_LDB(B1, 1, 1); PG8_STAGE(PG8_SB(1, 0), b3, voffB);
            PG8_BAR; PG8_WAIT_L(0); PG8_MMA(0, 1, At, B1); PG8_BAR;
            PG8_LDA(At, 1, 1); PG8_STAGE(PG8_SA(1, 0), a3, voffA);
            PG8_BAR; PG8_WAIT_L(0); PG8_MMA(1, 0, At, B0); PG8_BAR; PG8_SCHED;
            PG8_STAGE(PG8_SB(1, 1), b3 + hstep, voffB);
            PG8_WAIT_V(6); PG8_BAR; PG8_MMA(1, 1, At, B1); PG8_BAR;
            }
        }
        if constexpr (ALIGN_EPI) { if (wr == 0) PG8_BAR; }
        E(acc, cur, wr, wc, fr, fq);
        if (!has_next) break;
        if (nxt.pass == 0) {
#pragma unroll
        for (int a = 0; a < 2; ++a)
#pragma unroll
            for (int b = 0; b < 2; ++b)
#pragma unroll
                for (int m = 0; m < 4; ++m)
#pragma unroll
                    for (int n = 0; n < 2; ++n) acc[a][b][m][n] = (f32x4){0.f, 0.f, 0.f, 0.f};
        }
        cur = nxt; cA = nA; cB = nB; ++ui;
        if constexpr (ALIGN_EPI) { if (wr == 1) PG8_BAR; }
    }
    PG8_WAIT_V(0);
    if constexpr (!ALIGN_EPI) { if (wr == 0) PG8_BAR; }
    PG8_BAR;
#undef PG8_SA
#undef PG8_SB
#undef PG8_STAGE
#undef PG8_LDA
#undef PG8_LDB
#undef PG8_MMA
#undef PG8_WAIT_V
#undef PG8_WAIT_L
#undef PG8_BAR
#undef PG8_SCHED
#undef PG8_ABASE
#undef PG8_BBASE
#undef PG8_NEXT
}

typedef f32x4 (&AccRef)[2][2][4][2];
#define EPI_ROW(u, ai, m) ((u).pm * BM + (ai) * HALF + wr * 64 + (m) * 16 + fr)
#define EPI_COLW (wc * 32 + fq * 8)

#define EPI_RS(ss, row) __builtin_amdgcn_rsqf((ss)[row] * (1.0f / 1024.0f) + 1e-6f)
struct EpiGU {
    bf16_t* O; int ldo; const float* ss;
    __device__ __forceinline__ void operator()(AccRef acc, const Unit& u, int wr, int wc, int fr, int fq) const {
#pragma unroll
        for (int ai = 0; ai < 2; ++ai)
#pragma unroll
            for (int m = 0; m < 4; ++m) {
                const int row = EPI_ROW(u, ai, m); const float rs = EPI_RS(ss, row);
                bf16_t* p = O + (size_t)row * ldo + u.pn * 128 + EPI_COLW;
                float h[8];
#pragma unroll
                for (int n = 0; n < 2; ++n)
#pragma unroll
                    for (int j = 0; j < 4; ++j) { const float gt = rs * acc[ai][0][m][n][j], up = rs * acc[ai][1][m][n][j]; h[n * 4 + j] = gt * sigmoidf_(gt) * up; }
                *(u32x4*)p = pack8(h);
            }
    }
};
struct EpiWinMix {
    bf16_t* Z; const float* ss;
    __device__ __forceinline__ void operator()(AccRef acc, const Unit& u, int wr, int wc, int fr, int fq) const {
        if (u.pn < 4) {
#pragma unroll
            for (int ai = 0; ai < 2; ++ai)
#pragma unroll
                for (int m = 0; m < 4; ++m) {
                    const int row = EPI_ROW(u, ai, m); const float rs = EPI_RS(ss, row);
                    bf16_t* p = Z + (size_t)row * ZMW + u.pn * 128 + EPI_COLW;
                    float h[8];
#pragma unroll
                    for (int n = 0; n < 2; ++n)
#pragma unroll
                        for (int j = 0; j < 4; ++j) h[n * 4 + j] = rs * acc[ai][0][m][n][j] * sigmoidf_(rs * acc[ai][1][m][n][j]);
                    *(u32x4*)p = pack8(h);
                }
        } else {
#pragma unroll
            for (int ai = 0; ai < 2; ++ai)
#pragma unroll
                for (int m = 0; m < 4; ++m) {
                    const int row = EPI_ROW(u, ai, m); const float rs = EPI_RS(ss, row);
                    bf16_t* p = Z + (size_t)row * ZMW + 512 + (u.pn - 4) * 256 + EPI_COLW;
#pragma unroll
                    for (int bj = 0; bj < 2; ++bj) {
                        float h[8];
#pragma unroll
                        for (int n = 0; n < 2; ++n)
#pragma unroll
                            for (int j = 0; j < 4; ++j) h[n * 4 + j] = rs * acc[ai][bj][m][n][j];
                        *(u32x4*)(p + bj * HALF) = pack8(h);
                    }
                }
        }
    }
};
struct EpiGates {
    bf16_t* Z; const float* bias; const float* ss;
    __device__ __forceinline__ void operator()(AccRef acc, const Unit& u, int wr, int wc, int fr, int fq) const {
        const int col0 = u.pn * 256 + EPI_COLW;
        f32x4 bv[2][2];
#pragma unroll
        for (int bj = 0; bj < 2; ++bj)
#pragma unroll
            for (int n = 0; n < 2; ++n) bv[bj][n] = *(const f32x4*)(bias + col0 + bj * HALF + n * 4);
#pragma unroll
        for (int ai = 0; ai < 2; ++ai)
#pragma unroll
            for (int m = 0; m < 4; ++m) {
                const int row = EPI_ROW(u, ai, m); const float rs = EPI_RS(ss, row);
                bf16_t* p = Z + (size_t)row * ZGW + col0;
#pragma unroll
                for (int bj = 0; bj < 2; ++bj) {
                    float h[8];
#pragma unroll
                    for (int n = 0; n < 2; ++n)
#pragma unroll
                        for (int j = 0; j < 4; ++j) h[n * 4 + j] = sigmoidf_(rs * acc[ai][bj][m][n][j] + bv[bj][n][j]);
                    *(u32x4*)(p + bj * HALF) = pack8(h);
                }
            }
    }
};
struct EpiScale {
    bf16_t* O; int ldo; const float* scale;
    __device__ __forceinline__ void operator()(AccRef acc, const Unit& u, int wr, int wc, int fr, int fq) const {
        const int col0 = u.pn * 256 + EPI_COLW;
        f32x4 bv[2][2];
#pragma unroll
        for (int bj = 0; bj < 2; ++bj)
#pragma unroll
            for (int n = 0; n < 2; ++n) bv[bj][n] = *(const f32x4*)(scale + col0 + bj * HALF + n * 4);
#pragma unroll
        for (int ai = 0; ai < 2; ++ai)
#pragma unroll
            for (int m = 0; m < 4; ++m) {
                bf16_t* p = O + (size_t)EPI_ROW(u, ai, m) * ldo + col0;
#pragma unroll
                for (int bj = 0; bj < 2; ++bj) {
                    float h[8];
#pragma unroll
                    for (int n = 0; n < 2; ++n)
#pragma unroll
                        for (int j = 0; j < 4; ++j) h[n * 4 + j] = acc[ai][bj][m][n][j] * bv[bj][n][j];
                    *(u32x4*)(p + bj * HALF) = pack8(h);
                }
            }
    }
};
struct EpiRes {
    float* H; bf16_t* NBo; float* sso; float s, sw;
    __device__ __forceinline__ void operator()(AccRef acc, const Unit& u, int wr, int wc, int fr, int fq) const {
        const int col0 = u.pn * 256 + EPI_COLW;
#pragma unroll
        for (int ai = 0; ai < 2; ++ai)
#pragma unroll
            for (int m = 0; m < 4; ++m) {
                const int row = EPI_ROW(u, ai, m);
                float* p = H + (size_t)row * D + col0;
                float q = 0.f;
#pragma unroll
                for (int bj = 0; bj < 2; ++bj) {
                    float h[8];
#pragma unroll
                    for (int n = 0; n < 2; ++n) { f32x4* qp = (f32x4*)(p + bj * HALF + n * 4); f32x4 v = *qp; v += acc[ai][bj][m][n] * s; *qp = v;
#pragma unroll
                        for (int j = 0; j < 4; ++j) { h[n * 4 + j] = v[j]; q += v[j] * v[j]; } }
                    *(u32x4*)(NBo + (size_t)row * D + col0 + bj * HALF) = pack8(h);
                }
                q += __shfl_xor(q, 16); q += __shfl_xor(q, 32);
                if (fq == 0) atomicAdd(sso + row, q * sw);
            }
    }
};
struct EpiT {
    float* T;
    __device__ __forceinline__ void operator()(AccRef acc, const Unit& u, int wr, int wc, int fr, int fq) const {
        const int col0 = u.pn * 256 + EPI_COLW;
#pragma unroll
        for (int ai = 0; ai < 2; ++ai)
#pragma unroll
            for (int m = 0; m < 4; ++m) {
                float* p = T + (size_t)EPI_ROW(u, ai, m) * D + col0;
#pragma unroll
                for (int bj = 0; bj < 2; ++bj)
#pragma unroll
                    for (int n = 0; n < 2; ++n) *(f32x4*)(p + bj * HALF + n * 4) = acc[ai][bj][m][n];
            }
    }
};
struct EpiPE {
    float* H; const float* T; float s; const float* ss; bf16_t* NBo; float* sso;
    __device__ __forceinline__ void operator()(AccRef acc, const Unit& u, int wr, int wc, int fr, int fq) const {
        const int col0 = u.pn * 256 + EPI_COLW;
#pragma unroll
        for (int ai = 0; ai < 2; ++ai)
#pragma unroll
            for (int m = 0; m < 4; ++m) {
                const int row = EPI_ROW(u, ai, m); const float rs = EPI_RS(ss, row);
                const size_t off = (size_t)row * D + col0;
                float q = 0.f;
#pragma unroll
                for (int bj = 0; bj < 2; ++bj) {
                    float h[8], t8[8];
                    unpack8(*(const u32x4*)((const bf16_t*)T + off + bj * HALF), t8);
#pragma unroll
                    for (int n = 0; n < 2; ++n) {
                        f32x4* qp = (f32x4*)(H + off + bj * HALF + n * 4); f32x4 v = *qp;
#pragma unroll
                        for (int j = 0; j < 4; ++j) { v[j] += s * sigmoidf_(rs * acc[ai][bj][m][n][j]) * t8[n * 4 + j]; h[n * 4 + j] = v[j]; q += v[j] * v[j]; }
                        *qp = v;
                    }
                    *(u32x4*)(NBo + off + bj * HALF) = pack8(h);
                }
                q += __shfl_xor(q, 16); q += __shfl_xor(q, 32);
                if (fq == 0) atomicAdd(sso + row, q * s);
            }
    }
};
struct EpiMerge {
    const bf16_t* ZG; bf16_t* O;
    __device__ __forceinline__ void operator()(AccRef acc, const Unit& u, int wr, int wc, int fr, int fq) const {
        const int col0 = u.pn * 256 + EPI_COLW;
#pragma unroll
        for (int ai = 0; ai < 2; ++ai)
#pragma unroll
            for (int m = 0; m < 4; ++m) {
                const size_t row = (size_t)EPI_ROW(u, ai, m);
                const bf16_t* gp = ZG + row * ZGW + u.pass * 1024 + col0;
#pragma unroll
                for (int bj = 0; bj < 2; ++bj) {
                    float g0[8], f[8];
                    unpack8(*(const u32x4*)(gp + bj * HALF), g0);
                    if (u.pass < 2) {
                        float g1[8]; unpack8(*(const u32x4*)(gp + 1024 + bj * HALF), g1);
#pragma unroll
                        for (int e = 0; e < 8; ++e) f[e] = fmaxf(g0[e], 1e-30f) * __builtin_amdgcn_rcpf(fmaxf(g1[e], 1e-30f));
                    } else {
#pragma unroll
                        for (int e = 0; e < 8; ++e) f[e] = fmaxf(g0[e], 1e-30f);
                    }
#pragma unroll
                    for (int n = 0; n < 2; ++n)
#pragma unroll
                        for (int j = 0; j < 4; ++j) acc[ai][bj][m][n][j] *= f[n * 4 + j];
                    if (u.pass == 2) {
                        float h[8];
#pragma unroll
                        for (int n = 0; n < 2; ++n)
#pragma unroll
                            for (int j = 0; j < 4; ++j) h[n * 4 + j] = acc[ai][bj][m][n][j];
                        *(u32x4*)(O + row * D + col0 + bj * HALF) = pack8(h);
                    }
                }
            }
    }
};

struct EpiMergeWT {
    const bf16_t* ZG; bf16_t* O; unsigned* cntM; int samel2;
    __device__ __forceinline__ void operator()(AccRef acc, const Unit& u, int wr, int wc, int fr, int fq) const {
        const int col0 = u.pn * 256 + EPI_COLW;
        const __amdgpu_buffer_rsrc_t rm = __builtin_amdgcn_make_buffer_rsrc((void*)O, 0, (int)((size_t)18432 * D * 2), 0x00020000);
#pragma unroll
        for (int ai = 0; ai < 2; ++ai)
#pragma unroll
            for (int m = 0; m < 4; ++m) {
                const size_t row = (size_t)EPI_ROW(u, ai, m);
                const bf16_t* gp = ZG + row * ZGW + u.pass * 1024 + col0;
#pragma unroll
                for (int bj = 0; bj < 2; ++bj) {
                    float g0[8], f[8];
                    unpack8(*(const u32x4*)(gp + bj * HALF), g0);
                    if (u.pass < 2) {
                        float g1[8]; unpack8(*(const u32x4*)(gp + 1024 + bj * HALF), g1);
#pragma unroll
                        for (int e = 0; e < 8; ++e) f[e] = fmaxf(g0[e], 1e-30f) * __builtin_amdgcn_rcpf(fmaxf(g1[e], 1e-30f));
                    } else {
#pragma unroll
                        for (int e = 0; e < 8; ++e) f[e] = fmaxf(g0[e], 1e-30f);
                    }
#pragma unroll
                    for (int n = 0; n < 2; ++n)
#pragma unroll
                        for (int j = 0; j < 4; ++j) acc[ai][bj][m][n][j] *= f[n * 4 + j];
                    if (u.pass == 2) {
                        float h[8];
#pragma unroll
                        for (int n = 0; n < 2; ++n)
#pragma unroll
                            for (int j = 0; j < 4; ++j) h[n * 4 + j] = acc[ai][bj][m][n][j];
                        HANDOFF_STORE(pack8(h), rm, (unsigned)((row * D + col0 + bj * HALF) * 2), samel2);
                    }
                }
            }
        if (u.pass == 2) {
            asm volatile("s_waitcnt vmcnt(0)" ::: "memory");
            if ((threadIdx.x & 63) == 0) (void)__hip_atomic_fetch_add(cntM + 16 * u.pm, 1u, __ATOMIC_RELAXED, __HIP_MEMORY_SCOPE_AGENT);
        }
    }
};

struct FfnUnit { int kind, pm, pn; };
__device__ __forceinline__ bool ffn_next(int i, int G, int c, bool pe, FfnUnit& u) {
    if (G == 256) {
        const int x = c & 7, vc = c >> 3;
        const int ngu = vc < 4 ? 4 : (vc < 18 ? 7 : 6), ndn = vc < 4 ? 2 : 1;
        if (i < ngu) {
            const int t = i < 4 ? 32 * i + vc : (i < 6 ? 128 + 28 * (i - 4) + (vc - 4) : 184 + (vc - 4));
            u.kind = 0;
            if (t < 88) { u.pm = 9 * x + (t & 3); u.pn = t >> 2; }
            else if (t < 176) { u.pm = 9 * x + 4 + ((t - 88) & 3); u.pn = (t - 88) >> 2; }
            else { u.pm = 9 * x + 8; u.pn = t - 176; }
            return true;
        }
        const int k = i - ngu;
        if (k < ndn) { const int d = vc < 4 ? 4 * k + vc : (vc < 18 ? 22 + (vc - 4) : 8 + (vc - 18));
            u.kind = 1; u.pm = 9 * x + (d >> 2); u.pn = d & 3; return true; }
        if (!pe || vc < 18) return false;
        const int e = (vc - 18) + 14 * (k - ndn); if (k - ndn >= 3 || e >= 36) return false;
        u.kind = 2; u.pm = 9 * x + (e >> 2); u.pn = e & 3; return true;
    }
    const int ngu = (1584 - c + G - 1) / G;
    if (i < ngu) { const int t = i * G + c; u.kind = 0; u.pm = t / 22; u.pn = t - 22 * u.pm; return true; }
    const int ndn = (288 - c + G - 1) / G, i1 = i - ngu;
    if (i1 < ndn) { const int t = i1 * G + c; u.kind = 1; u.pm = t >> 2; u.pn = t & 3; return true; }
    if (!pe) return false;
    const int t = (i1 - ndn) * G + c; if (t >= 288) return false;
    u.kind = 2; u.pm = t >> 2; u.pn = t & 3; return true;
}
struct FfnArgs { const bf16_t* Agu; const bf16_t* Bgu; bf16_t* HID; const bf16_t* Bdn; const float* ss_in; float* H; bf16_t* NBo; float* sso; unsigned* cnt; const float* x0; const float* x1; const bf16_t* Ape; const bf16_t* Bpe; float* T; float s, sw; };

__device__ __forceinline__ void ffn_phase(LAS unsigned char* lds, int tid_in, const FfnArgs& fa) {
    int tid_ = tid_in; asm volatile("" : "+v"(tid_));
    const int tid = tid_, wid = __builtin_amdgcn_readfirstlane(tid >> 6), lane = tid & 63, wr = wid >> 2, wc = wid & 3, fr = lane & 15, fq = lane >> 4;
    constexpr int K0 = 1024, K1 = 2816, K2 = 256;
    const bool pe = fa.Ape != nullptr;
    unsigned vA[3][2], vB[3][2];
#pragma unroll
    for (int i = 0; i < 2; ++i) { int R, C; stage_rc(tid * 16 + i * 8192, R, C); const int Rb = (R & ~31) + perm32(R & 31);
        vA[0][i] = (unsigned)(R * K0 + C) * 2u; vB[0][i] = (unsigned)(Rb * K0 + C) * 2u; vA[1][i] = (unsigned)(R * K1 + C) * 2u; vB[1][i] = (unsigned)(Rb * K1 + C) * 2u; vA[2][i] = (unsigned)(R * K2 + C) * 2u; vB[2][i] = (unsigned)(Rb * K2 + C) * 2u; }
    constexpr size_t kstep = (size_t)(BK * 2);
    const unsigned ldsw = (unsigned)wid * 1024u;
    const int aoff = lds_byte(wr * 64 + fr, fq * 8), boff = lds_byte(wc * 32 + fr, fq * 8);
#define PG8_SA(b, h) (((b) * 2 + (h)) * HTB)
#define PG8_SB(b, h) ((4 + (b) * 2 + (h)) * HTB)
#define PG8_STAGE(bufoff, gbase, v0, v1) do { \
        __builtin_amdgcn_global_load_lds((const unsigned*)((const char*)(gbase) + (v0)), (LAS unsigned*)(lds + (bufoff) + ldsw), 16, 0, 0); \
        __builtin_amdgcn_global_load_lds((const unsigned*)((const char*)(gbase) + (v1)), (LAS unsigned*)(lds + (bufoff) + ldsw + 8192), 16, 0, 0); } while (0)
#define PG8_LDA(dst, b, h) do { _Pragma("unroll") for (int m = 0; m < 4; ++m) _Pragma("unroll") for (int k = 0; k < 2; ++k) dst[m][k] = *(const LAS bf16x8*)(lds + PG8_SA(b, h) + aoff + m * 2048 + k * 1024); } while (0)
#define PG8_LDB(dst, b, h) do { _Pragma("unroll") for (int n = 0; n < 2; ++n) _Pragma("unroll") for (int k = 0; k < 2; ++k) dst[n][k] = *(const LAS bf16x8*)(lds + PG8_SB(b, h) + boff + n * 2048 + k * 1024); } while (0)
#define PG8_MMA(ai, bj, At, Bt) do { __builtin_amdgcn_s_setprio(1); _Pragma("unroll") for (int m = 0; m < 4; ++m) _Pragma("unroll") for (int n = 0; n < 2; ++n) _Pragma("unroll") for (int k = 0; k < 2; ++k) \
        acc[ai][bj][m][n] = __builtin_amdgcn_mfma_f32_16x16x32_bf16(Bt[n][k], At[m][k], acc[ai][bj][m][n], 0, 0, 0); __builtin_amdgcn_s_setprio(0); } while (0)
#define PG8_WAIT_V(n) asm volatile("s_waitcnt vmcnt(" #n ")" ::: "memory")
#define PG8_WAIT_L(n) asm volatile("s_waitcnt lgkmcnt(" #n ")" ::: "memory")
#define PG8_BAR __builtin_amdgcn_s_barrier()
#define PG8_SCHED __builtin_amdgcn_sched_barrier(0)
#define FFN_READY(u) do { if ((u).kind == 1) { \
        if (wid == 0) { unsigned* w_ = fa.cnt + 16 * (u).pm; unsigned sp_ = 0; \
            while ((unsigned)__builtin_amdgcn_readfirstlane(__hip_atomic_load(w_, __ATOMIC_RELAXED, __HIP_MEMORY_SCOPE_AGENT)) < 176u) { __builtin_amdgcn_s_sleep(2); if (++sp_ > (1u << 24)) break; } \
            __builtin_amdgcn_fence(__ATOMIC_ACQUIRE, "agent"); asm volatile("s_waitcnt vmcnt(0)" ::: "memory"); } \
        asm volatile("" ::: "memory"); __builtin_amdgcn_s_barrier(); asm volatile("" ::: "memory"); } } while (0)
    int sG = (int)gridDim.x, sC = (int)__builtin_amdgcn_readfirstlane((int)*(volatile LAS unsigned*)(lds + LDS_BYTES - 8)); asm volatile("" : "+s"(sG), "+s"(sC));
    FfnUnit cur, nxt; int ui = 0;
    if (!ffn_next(0, sG, sC, pe, cur)) return;
    f32x4 acc[2][2][4][2];
    bf16x8 At[4][2], B0[2][2], B1[2][2];
#define FFN_K(u) ((u).kind == 0 ? K0 : ((u).kind == 1 ? K1 : K2))
#define FFN_UA(u) ((const char*)((u).kind == 0 ? fa.Agu : ((u).kind == 1 ? (const bf16_t*)fa.HID : fa.Ape)) + (size_t)(u).pm * (size_t)(256 * 2) * FFN_K(u))
#define FFN_UB(u) ((const char*)((u).kind == 0 ? fa.Bgu : ((u).kind == 1 ? fa.Bdn : fa.Bpe)) + (size_t)(u).pn * (size_t)(256 * 2) * FFN_K(u))
#define FFN_V(arr, u, i) ((u).kind == 0 ? arr[0][i] : ((u).kind == 1 ? arr[1][i] : arr[2][i]))
    for (;;) {
#pragma unroll
    for (int a = 0; a < 2; ++a)
#pragma unroll
        for (int b = 0; b < 2; ++b)
#pragma unroll
            for (int m = 0; m < 4; ++m)
#pragma unroll
                for (int n = 0; n < 2; ++n) acc[a][b][m][n] = (f32x4){0.f, 0.f, 0.f, 0.f};
    const char* cA = FFN_UA(cur); const char* cB = FFN_UB(cur);
    size_t chs = (size_t)HALF * 2 * FFN_K(cur);
    unsigned cvA0 = FFN_V(vA, cur, 0), cvA1 = FFN_V(vA, cur, 1), cvB0 = FFN_V(vB, cur, 0), cvB1 = FFN_V(vB, cur, 1);
    int nt = FFN_K(cur) / BK;
    FFN_READY(cur);
    PG8_STAGE(PG8_SB(0, 0), cB, cvB0, cvB1); PG8_STAGE(PG8_SB(0, 1), cB + chs, cvB0, cvB1); PG8_STAGE(PG8_SA(0, 0), cA, cvA0, cvA1); PG8_STAGE(PG8_SA(0, 1), cA + chs, cvA0, cvA1);
    if (wr == 1) PG8_BAR;
    PG8_WAIT_V(2); PG8_BAR;
    PG8_STAGE(PG8_SB(1, 0), cB + kstep, cvB0, cvB1); PG8_STAGE(PG8_SA(1, 0), cA + kstep, cvA0, cvA1); PG8_STAGE(PG8_SB(1, 1), cB + chs + kstep, cvB0, cvB1);
    PG8_WAIT_V(6); PG8_BAR;
    for (;;) {
        bool has_next = ffn_next(ui + 1, sG, sC, pe, nxt);
        if (has_next && nxt.kind != cur.kind) has_next = false;
        if (!has_next) nxt = cur;
        const char* nA = FFN_UA(nxt); const char* nB = FFN_UB(nxt);
        const size_t nhs = (size_t)HALF * 2 * FFN_K(nxt);
        const unsigned nvA0 = FFN_V(vA, nxt, 0), nvA1 = FFN_V(vA, nxt, 1), nvB0 = FFN_V(vB, nxt, 0), nvB1 = FFN_V(vB, nxt, 1);
#pragma unroll 1
        for (int t = 0; t < nt; t += 2) {
            const bool last = (t == nt - 2);
            const char* a1 = cA + (size_t)(t + 1) * kstep;
            const char* a2 = last ? nA : cA + (size_t)(t + 2) * kstep; const char* b2 = last ? nB : cB + (size_t)(t + 2) * kstep;
            const char* a3 = a2 + kstep; const char* b3 = b2 + kstep;
            const size_t hs2 = last ? nhs : chs;
            const unsigned sA0 = last ? nvA0 : cvA0, sA1 = last ? nvA1 : cvA1, sB0 = last ? nvB0 : cvB0, sB1 = last ? nvB1 : cvB1;
            if (last && has_next) FFN_READY(nxt);
            PG8_LDB(B0, 0, 0); PG8_LDB(B1, 0, 1); PG8_SCHED; PG8_LDA(At, 0, 0); PG8_STAGE(PG8_SA(1, 1), a1 + chs, cvA0, cvA1);
            PG8_WAIT_V(8); PG8_WAIT_L(0); PG8_BAR; PG8_MMA(0, 0, At, B0); PG8_MMA(0, 1, At, B1); PG8_BAR; PG8_SCHED;
            PG8_LDA(At, 0, 1); PG8_STAGE(PG8_SB(0, 0), b2, sB0, sB1); PG8_STAGE(PG8_SB(0, 1), b2 + hs2, sB0, sB1); PG8_STAGE(PG8_SA(0, 0), a2, sA0, sA1);
            PG8_WAIT_V(8); PG8_WAIT_L(0); PG8_BAR; PG8_MMA(1, 0, At, B0); PG8_MMA(1, 1, At, B1); PG8_BAR; PG8_SCHED;
            PG8_LDB(B0, 1, 0); PG8_LDB(B1, 1, 1); PG8_SCHED; PG8_LDA(At, 1, 0); PG8_STAGE(PG8_SA(0, 1), a2 + hs2, sA0, sA1);
            PG8_WAIT_V(8); PG8_WAIT_L(0); PG8_BAR; PG8_MMA(0, 0, At, B0); PG8_MMA(0, 1, At, B1); PG8_BAR; PG8_SCHED;
            PG8_LDA(At, 1, 1); PG8_STAGE(PG8_SB(1, 0), b3, sB0, sB1); PG8_STAGE(PG8_SB(1, 1), b3 + hs2, sB0, sB1); PG8_STAGE(PG8_SA(1, 0), a3, sA0, sA1);
            PG8_WAIT_V(8); PG8_WAIT_L(0); PG8_BAR; PG8_MMA(1, 0, At, B0); PG8_MMA(1, 1, At, B1); PG8_BAR; PG8_SCHED;
        }
        if (wr == 0) PG8_BAR;
        if (cur.kind == 0) {
            const bool samel2 = SAME_L2(lds);
            const __amdgpu_buffer_rsrc_t hrs = __builtin_amdgcn_make_buffer_rsrc((void*)fa.HID, 0, (int)((size_t)18432 * 2816 * 2), 0x00020000);
#pragma unroll
            for (int ai = 0; ai < 2; ++ai)
#pragma unroll
                for (int m = 0; m < 4; ++m) {
                    const int row = cur.pm * BM + ai * HALF + wr * 64 + m * 16 + fr; const float rs = EPI_RS(fa.ss_in, row);
                    typedef float f32x2 __attribute__((ext_vector_type(2)));
                    u32x4 hw;
#pragma unroll
                    for (int n = 0; n < 2; ++n)
#pragma unroll
                        for (int jp = 0; jp < 2; ++jp) {
                            f32x2 gv = {acc[ai][0][m][n][2 * jp], acc[ai][0][m][n][2 * jp + 1]}, uv = {acc[ai][1][m][n][2 * jp], acc[ai][1][m][n][2 * jp + 1]};
                            gv *= rs; uv *= rs;
                            const f32x2 ar = gv * (-1.4426950408889634f);
                            f32x2 ev; ev.x = __builtin_amdgcn_exp2f(ar.x); ev.y = __builtin_amdgcn_exp2f(ar.y);
                            const f32x2 dv = ev + 1.0f;
                            f32x2 rv; rv.x = __builtin_amdgcn_rcpf(dv.x); rv.y = __builtin_amdgcn_rcpf(dv.y);
                            const f32x2 hv = (gv * uv) * rv;
                            hw[n * 2 + jp] = cvt_pk_bf16(hv.x, hv.y);
                        }
                    HANDOFF_STORE(hw, hrs, (unsigned)(((size_t)row * 2816 + cur.pn * 128 + wc * 32 + fq * 8) * 2), samel2);
                }
            asm volatile("s_waitcnt vmcnt(0)" ::: "memory");
            if (lane == 0) (void)__hip_atomic_fetch_add(fa.cnt + 16 * cur.pm, 1u, __ATOMIC_RELAXED, __HIP_MEMORY_SCOPE_AGENT);
        } else if (cur.kind == 2) {
            const int col0 = cur.pn * 256 + wc * 32 + fq * 8;
#pragma unroll
            for (int ai = 0; ai < 2; ++ai)
#pragma unroll
                for (int m = 0; m < 4; ++m) {
                    bf16_t* p = (bf16_t*)fa.T + (size_t)(cur.pm * BM + ai * HALF + wr * 64 + m * 16 + fr) * D + col0;
#pragma unroll
                    for (int bj = 0; bj < 2; ++bj) {
                        float h[8];
#pragma unroll
                        for (int n = 0; n < 2; ++n)
#pragma unroll
                            for (int j = 0; j < 4; ++j) h[n * 4 + j] = acc[ai][bj][m][n][j];
                        *(u32x4*)(p + bj * HALF) = pack8(h);
                    }
                }
        } else {
            const int col0 = cur.pn * 256 + wc * 32 + fq * 8;
#pragma unroll
            for (int ai = 0; ai < 2; ++ai)
#pragma unroll
                for (int m = 0; m < 4; ++m) {
                    const int row = cur.pm * BM + ai * HALF + wr * 64 + m * 16 + fr;
                    float* p = fa.H + (size_t)row * D + col0;
                    const float* rp = fa.x0 ? (row < MP ? fa.x0 + (size_t)row * D : fa.x1 + (size_t)(row - MP) * D) + col0 : p;
                    float q = 0.f;
#pragma unroll
                    for (int bj = 0; bj < 2; ++bj) {
                        float h[8];
#pragma unroll
                        for (int n = 0; n < 2; ++n) { f32x4* qp = (f32x4*)(p + bj * HALF + n * 4); f32x4 v = *(const f32x4*)(rp + bj * HALF + n * 4); v += acc[ai][bj][m][n] * fa.s; *qp = v;
#pragma unroll
                            for (int j = 0; j < 4; ++j) { h[n * 4 + j] = v[j]; q += v[j] * v[j]; } }
                        *(u32x4*)(fa.NBo + (size_t)row * D + col0 + bj * HALF) = pack8(h);
                    }
                    q += __shfl_xor(q, 16); q += __shfl_xor(q, 32);
                    if (fq == 0) atomicAdd(fa.sso + row, q * fa.sw);
                }
        }
        if (!has_next) break;
#pragma unroll
        for (int a = 0; a < 2; ++a)
#pragma unroll
            for (int b = 0; b < 2; ++b)
#pragma unroll
                for (int m = 0; m < 4; ++m)
#pragma unroll
                    for (int n = 0; n < 2; ++n) acc[a][b][m][n] = (f32x4){0.f, 0.f, 0.f, 0.f};
        cur = nxt; cA = nA; cB = nB; chs = nhs; cvA0 = nvA0; cvA1 = nvA1; cvB0 = nvB0; cvB1 = nvB1; nt = FFN_K(cur) / BK; ++ui;
        if (wr == 1) PG8_BAR;
    }
    PG8_WAIT_V(0);
    PG8_BAR;
    ++ui; if (!ffn_next(ui, sG, sC, pe, cur)) break;
    }
#undef PG8_SA
#undef PG8_SB
#undef PG8_STAGE
#undef PG8_LDA
#undef PG8_LDB
#undef PG8_MMA
#undef PG8_WAIT_V
#undef PG8_WAIT_L
#undef PG8_BAR
#undef PG8_SCHED
#undef FFN_READY
#undef FFN_UA
#undef FFN_UB
#undef FFN_K
#undef FFN_V
}

constexpr int TAIL_MAXU = 8;
__device__ const unsigned short TAIL_SCHED[32][TAIL_MAXU] = {
    {0x100,0x20,0x44,0x62,0x7a,0x262,0x360,0xffff},
    {0x101,0x21,0x45,0x63,0x7b,0x263,0x361,0xffff},
    {0x110,0x22,0x46,0x64,0x230,0x320,0xffff,0xffff},
    {0x111,0x23,0x47,0x65,0x231,0x321,0xffff,0xffff},
    {0x0,0x28,0x202,0x86,0x280,0x380,0xffff,0xffff},
    {0x1,0x29,0x203,0x87,0x281,0x381,0xffff,0xffff},
    {0x2,0x2a,0x50,0x180,0x232,0x322,0xffff,0xffff},
    {0x3,0x2b,0x51,0x181,0x233,0x323,0xffff,0xffff},
    {0x4,0x140,0x48,0x66,0x80,0x270,0x362,0xffff},
    {0x5,0x141,0x49,0x67,0x81,0x271,0x363,0xffff},
    {0x6,0x30,0x52,0x220,0x282,0x382,0xffff,0xffff},
    {0x7,0x31,0x53,0x221,0x283,0x383,0xffff,0xffff},
    {0x8,0x32,0x54,0x222,0x302,0x370,0xffff,0xffff},
    {0x9,0x33,0x55,0x223,0x303,0x371,0xffff,0xffff},
    {0xa,0x34,0x56,0x70,0x240,0x330,0xffff,0xffff},
    {0xb,0x35,0x57,0x71,0x241,0x331,0xffff,0xffff},
    {0x120,0x24,0x4a,0x68,0x82,0x272,0x372,0xffff},
    {0x121,0x25,0x4b,0x69,0x83,0x273,0x373,0xffff},
    {0x10,0x36,0x58,0x72,0x242,0x332,0xffff,0xffff},
    {0x11,0x37,0x59,0x73,0x243,0x333,0xffff,0xffff},
    {0x12,0x38,0x5a,0x74,0x250,0x340,0xffff,0xffff},
    {0x13,0x39,0x5b,0x75,0x251,0x341,0xffff,0xffff},
    {0x14,0x3a,0x170,0x6a,0x84,0x300,0x350,0xffff},
    {0x15,0x3b,0x171,0x6b,0x85,0x301,0x351,0xffff},
    {0x16,0x150,0x160,0x60,0x76,0x252,0x342,0xffff},
    {0x17,0x151,0x161,0x61,0x77,0x253,0x343,0xffff},
    {0x18,0x40,0x210,0x88,0x310,0xffff,0xffff,0xffff},
    {0x19,0x41,0x211,0x89,0x311,0xffff,0xffff,0xffff},
    {0x1a,0x42,0x212,0x8a,0x312,0xffff,0xffff,0xffff},
    {0x1b,0x43,0x213,0x8b,0x313,0xffff,0xffff,0xffff},
    {0x130,0x26,0x200,0x78,0x260,0x352,0xffff,0xffff},
    {0x131,0x27,0x201,0x79,0x261,0x353,0xffff,0xffff}
};

struct TU { int kind, pass, pm, pn; };
__device__ __forceinline__ bool tail_unit(int i, int G, int c, TU& u) {
    u.pass = 0;
    if (G == 256) {
        if (i >= TAIL_MAXU) return false;
        const unsigned e = TAIL_SCHED[c >> 3][i]; if (e == 0xffffu) return false;
        u.kind = (int)(e >> 8); u.pm = 9 * (c & 7) + (int)((e >> 4) & 15u); u.pn = (int)(e & 15u); return true;
    }
    const int n0 = (1008 - c + G - 1) / G;
    if (i < n0) { const int t = i * G + c; if (t < 864) { u.kind = 0; u.pm = t / 12; u.pn = t - 12 * u.pm; } else { u.kind = 1; u.pm = (t - 864) >> 1; u.pn = (t - 864) & 1; } return true; }
    const int n1 = (288 - c + G - 1) / G; const int i1 = i - n0;
    if (i1 < n1) { const int t = i1 * G + c; u.kind = 2; u.pm = t >> 2; u.pn = t & 3; return true; }
    const int t = (i1 - n1) * G + c; if (t >= 288) return false;
    u.kind = 3; u.pm = t >> 2; u.pn = t & 3; return true;
}
struct TailArgs { unsigned char* ws; float* H; const float* gbias; const float* pscale; const float* ss_in; float* sso; unsigned* cntA; unsigned* cntM; float s; };

__device__ __forceinline__ void tail_phase(LAS unsigned char* lds, int tid_in, const TailArgs& ta) {
    int tid_ = tid_in; asm volatile("" : "+v"(tid_));
    const int tid = tid_, wid = __builtin_amdgcn_readfirstlane(tid >> 6), lane = tid & 63, wr = wid >> 2, wc = wid & 3, fr = lane & 15, fq = lane >> 4;
    constexpr int K0 = 1024, K1 = 512;
    constexpr size_t kstep = (size_t)(BK * 2);
    const unsigned ldsw = (unsigned)wid * 1024u;
#define PG8_SA(b, h) (((b) * 2 + (h)) * HTB)
#define PG8_SB(b, h) ((4 + (b) * 2 + (h)) * HTB)
#define PG8_STAGE(bufoff, gbase, v0, v1) do { \
        __builtin_amdgcn_global_load_lds((const unsigned*)((const char*)(gbase) + (v0)), (LAS unsigned*)(lds + (bufoff) + ldsw), 16, 0, 0); \
        __builtin_amdgcn_global_load_lds((const unsigned*)((const char*)(gbase) + (v1)), (LAS unsigned*)(lds + (bufoff) + ldsw + 8192), 16, 0, 0); } while (0)
#define PG8_LDA(dst, b, h) do { _Pragma("unroll") for (int m = 0; m < 4; ++m) _Pragma("unroll") for (int k = 0; k < 2; ++k) dst[m][k] = *(const LAS bf16x8*)(lds + PG8_SA(b, h) + aoff + m * 2048 + k * 1024); } while (0)
#define PG8_LDB(dst, b, h) do { _Pragma("unroll") for (int n = 0; n < 2; ++n) _Pragma("unroll") for (int k = 0; k < 2; ++k) dst[n][k] = *(const LAS bf16x8*)(lds + PG8_SB(b, h) + boff + n * 2048 + k * 1024); } while (0)
#define PG8_MMA(ai, bj, At, Bt) do { __builtin_amdgcn_s_setprio(1); _Pragma("unroll") for (int m = 0; m < 4; ++m) _Pragma("unroll") for (int n = 0; n < 2; ++n) _Pragma("unroll") for (int k = 0; k < 2; ++k) \
        acc[ai][bj][m][n] = __builtin_amdgcn_mfma_f32_16x16x32_bf16(Bt[n][k], At[m][k], acc[ai][bj][m][n], 0, 0, 0); __builtin_amdgcn_s_setprio(0); } while (0)
#define PG8_WAIT_V(n) asm volatile("s_waitcnt vmcnt(" #n ")" ::: "memory")
#define PG8_WAIT_L(n) asm volatile("s_waitcnt lgkmcnt(" #n ")" ::: "memory")
#define PG8_BAR __builtin_amdgcn_s_barrier()
#define PG8_SCHED __builtin_amdgcn_sched_barrier(0)
#define TL_DEP(u) (((u).kind == 2 && (u).pass == 0) || (u).kind == 3)
#define TL_READY(u) do { if (TL_DEP(u)) { \
        if (wid == 0) { unsigned* w_ = ((u).kind == 2 ? ta.cntA : ta.cntM) + 16 * (u).pm; const unsigned need_ = (u).kind == 2 ? 112u : 32u; unsigned sp_ = 0; \
            while ((unsigned)__builtin_amdgcn_readfirstlane(__hip_atomic_load(w_, __ATOMIC_RELAXED, __HIP_MEMORY_SCOPE_AGENT)) < need_) { __builtin_amdgcn_s_sleep(2); if (++sp_ > (1u << 24)) break; } \
            __builtin_amdgcn_fence(__ATOMIC_ACQUIRE, "agent"); asm volatile("s_waitcnt vmcnt(0)" ::: "memory"); } \
        asm volatile("" ::: "memory"); __builtin_amdgcn_s_barrier(); asm volatile("" ::: "memory"); } } while (0)
#define TL_K(u) (((u).kind == 0 || (u).kind == 3) ? K0 : K1)
#define TL_ABASE(u) ((const char*)ta.ws + ((u).kind == 0 ? WS_NB : (u).kind == 1 ? WS_X + 2 * XSZ : (u).kind == 3 ? WS_NB2 : ((u).pass == 0 ? WS_X : (u).pass == 1 ? WS_X + XSZ : WS_X + 3 * XSZ)))
#define TL_BBASE(u) ((const char*)ta.ws + WS_W + 2 * ((u).kind == 0 ? W_IG : (u).kind == 1 ? W_PBD : (u).kind == 3 ? W_O : ((u).pass == 0 ? W_CA : (u).pass == 1 ? W_SB : W_PC)))
#define TL_UA(u) (TL_ABASE(u) + (size_t)(u).pm * (size_t)(256 * 2) * TL_K(u))
#define TL_UB(u) (TL_BBASE(u) + (size_t)(u).pn * (size_t)(256 * 2) * TL_K(u))
    constexpr size_t XSZ = (size_t)18432 * 512 * 2;
    int sG = (int)gridDim.x, sC = (int)__builtin_amdgcn_readfirstlane((int)*(volatile LAS unsigned*)(lds + LDS_BYTES - 8)); asm volatile("" : "+s"(sG), "+s"(sC));
    TU cur, nxt; int ui = 0;
    if (!tail_unit(0, sG, sC, cur)) return;
    f32x4 acc[2][2][4][2];
    bf16x8 At[4][2], B0[2][2], B1[2][2];
    for (;;) {
    if (cur.kind == 2) {
        TL_READY(cur);
        { const Gemm g{(const bf16_t*)(ta.ws + WS_X), (const bf16_t*)(ta.ws + WS_X + XSZ), (const bf16_t*)(ta.ws + WS_X + 3 * XSZ),
                       (const bf16_t*)(ta.ws + WS_W) + W_CA, (const bf16_t*)(ta.ws + WS_W) + W_SB, (const bf16_t*)(ta.ws + WS_W) + W_PC};
          const EpiMergeWT E{(const bf16_t*)(ta.ws + WS_BIG), (bf16_t*)(ta.ws + WS_NB2), ta.cntM, (int)SAME_L2(lds)};
          int tm_; asm volatile("v_mbcnt_lo_u32_b32 %0, -1, 0\n\tv_mbcnt_hi_u32_b32 %0, -1, %0" : "=v"(tm_));
          gemm_phase<EpiMergeWT, D, 512, 3, true, true, true>(lds, tm_ + wid * 64, g, E, cur.pm, cur.pn); }
        ++ui; if (!tail_unit(ui, sG, sC, cur)) break;
        continue;
    }
    int tl_; asm volatile("v_mbcnt_lo_u32_b32 %0, -1, 0\n\tv_mbcnt_hi_u32_b32 %0, -1, %0" : "=v"(tl_)); tl_ += wid * 64;
    unsigned vA[2][2], vB[2][2];
#pragma unroll
    for (int i = 0; i < 2; ++i) { int R, C; stage_rc(tl_ * 16 + i * 8192, R, C); const int Rb = (R & ~31) + perm32(R & 31);
        vA[0][i] = (unsigned)(R * K0 + C) * 2u; vB[0][i] = (unsigned)(Rb * K0 + C) * 2u; vA[1][i] = (unsigned)(R * K1 + C) * 2u; vB[1][i] = (unsigned)(Rb * K1 + C) * 2u; }
    const int aoff = lds_byte(wr * 64 + (tl_ & 15), ((tl_ & 63) >> 4) * 8), boff = lds_byte(wc * 32 + (tl_ & 15), ((tl_ & 63) >> 4) * 8);
#pragma unroll
    for (int a = 0; a < 2; ++a)
#pragma unroll
        for (int b = 0; b < 2; ++b)
#pragma unroll
            for (int m = 0; m < 4; ++m)
#pragma unroll
                for (int n = 0; n < 2; ++n) acc[a][b][m][n] = (f32x4){0.f, 0.f, 0.f, 0.f};
    const char* cA = TL_UA(cur); const char* cB = TL_UB(cur);
    size_t chs = (size_t)HALF * 2 * TL_K(cur);
    bool ck = TL_K(cur) == K1;
    unsigned cvA0 = ck ? vA[1][0] : vA[0][0], cvA1 = ck ? vA[1][1] : vA[0][1], cvB0 = ck ? vB[1][0] : vB[0][0], cvB1 = ck ? vB[1][1] : vB[0][1];
    int nt = TL_K(cur) / BK;
    TL_READY(cur);
    PG8_STAGE(PG8_SB(0, 0), cB, cvB0, cvB1); PG8_STAGE(PG8_SB(0, 1), cB + chs, cvB0, cvB1); PG8_STAGE(PG8_SA(0, 0), cA, cvA0, cvA1); PG8_STAGE(PG8_SA(0, 1), cA + chs, cvA0, cvA1);
    if (wr == 1) PG8_BAR;
    PG8_WAIT_V(2); PG8_BAR;
    PG8_STAGE(PG8_SB(1, 0), cB + kstep, cvB0, cvB1); PG8_STAGE(PG8_SA(1, 0), cA + kstep, cvA0, cvA1); PG8_STAGE(PG8_SB(1, 1), cB + chs + kstep, cvB0, cvB1);
    PG8_WAIT_V(6); PG8_BAR;
    bool more;
    for (;;) {
        more = tail_unit(ui + 1, sG, sC, nxt);
        const bool has_next = more && !TL_DEP(nxt);
        if (!has_next) nxt = cur;
        const char* nA = TL_UA(nxt); const char* nB = TL_UB(nxt);
        const size_t nhs = (size_t)HALF * 2 * TL_K(nxt);
        const bool nk = TL_K(nxt) == K1;
        const unsigned nvA0 = nk ? vA[1][0] : vA[0][0], nvA1 = nk ? vA[1][1] : vA[0][1], nvB0 = nk ? vB[1][0] : vB[0][0], nvB1 = nk ? vB[1][1] : vB[0][1];
#pragma unroll 1
        for (int t = 0; t < nt; t += 2) {
            const bool last = (t == nt - 2);
            const char* a1 = cA + (size_t)(t + 1) * kstep;
            const char* a2 = last ? nA : cA + (size_t)(t + 2) * kstep; const char* b2 = last ? nB : cB + (size_t)(t + 2) * kstep;
            const char* a3 = a2 + kstep; const char* b3 = b2 + kstep;
            const size_t hs2 = last ? nhs : chs;
            const unsigned sA0 = last ? nvA0 : cvA0, sA1 = last ? nvA1 : cvA1, sB0 = last ? nvB0 : cvB0, sB1 = last ? nvB1 : cvB1;
            PG8_LDB(B0, 0, 0); PG8_LDB(B1, 0, 1); PG8_SCHED; PG8_LDA(At, 0, 0); PG8_STAGE(PG8_SA(1, 1), a1 + chs, cvA0, cvA1);
            PG8_WAIT_V(8); PG8_WAIT_L(0); PG8_BAR; PG8_MMA(0, 0, At, B0); PG8_MMA(0, 1, At, B1); PG8_BAR; PG8_SCHED;
            PG8_LDA(At, 0, 1); PG8_STAGE(PG8_SB(0, 0), b2, sB0, sB1); PG8_STAGE(PG8_SB(0, 1), b2 + hs2, sB0, sB1); PG8_STAGE(PG8_SA(0, 0), a2, sA0, sA1);
            PG8_WAIT_V(8); PG8_WAIT_L(0); PG8_BAR; PG8_MMA(1, 0, At, B0); PG8_MMA(1, 1, At, B1); PG8_BAR; PG8_SCHED;
            PG8_LDB(B0, 1, 0); PG8_LDB(B1, 1, 1); PG8_SCHED; PG8_LDA(At, 1, 0); PG8_STAGE(PG8_SA(0, 1), a2 + hs2, sA0, sA1);
            PG8_WAIT_V(8); PG8_WAIT_L(0); PG8_BAR; PG8_MMA(0, 0, At, B0); PG8_MMA(0, 1, At, B1); PG8_BAR; PG8_SCHED;
            PG8_LDA(At, 1, 1); PG8_STAGE(PG8_SB(1, 0), b3, sB0, sB1); PG8_STAGE(PG8_SB(1, 1), b3 + hs2, sB0, sB1); PG8_STAGE(PG8_SA(1, 0), a3, sA0, sA1);
            PG8_WAIT_V(8); PG8_WAIT_L(0); PG8_BAR; PG8_MMA(1, 0, At, B0); PG8_MMA(1, 1, At, B1); PG8_BAR; PG8_SCHED;
        }
        if (wr == 0) PG8_BAR;
        const int colw = wc * 32 + fq * 8;
        if (cur.kind == 0) {
            const bool samel2 = SAME_L2(lds);
            const __amdgpu_buffer_rsrc_t rz = __builtin_amdgcn_make_buffer_rsrc((void*)(ta.ws + WS_BIG), 0, (int)((size_t)18432 * ZGW * 2), 0x00020000);
            const int col0 = cur.pn * 256 + colw;
#pragma unroll
            for (int ai = 0; ai < 2; ++ai)
#pragma unroll
                for (int m = 0; m < 4; ++m) {
                    const int row = cur.pm * BM + ai * HALF + wr * 64 + m * 16 + fr; const float rs = EPI_RS(ta.ss_in, row);
#pragma unroll
                    for (int bj = 0; bj < 2; ++bj) {
                        float h[8];
#pragma unroll
                        for (int n = 0; n < 2; ++n)
#pragma unroll
                            for (int j = 0; j < 4; ++j) h[n * 4 + j] = sigmoidf_(rs * acc[ai][bj][m][n][j] + ta.gbias[col0 + bj * HALF + n * 4 + j]);
                        HANDOFF_STORE(pack8(h), rz, (unsigned)(((size_t)row * ZGW + col0 + bj * HALF) * 2), samel2);
                    }
                    asm volatile("" ::: "memory");
                }
            asm volatile("s_waitcnt vmcnt(0)" ::: "memory");
            if (lane == 0) (void)__hip_atomic_fetch_add(ta.cntA + 16 * cur.pm, 1u, __ATOMIC_RELAXED, __HIP_MEMORY_SCOPE_AGENT);
        } else if (cur.kind == 1) {
            const bool samel2 = SAME_L2(lds);
            const __amdgpu_buffer_rsrc_t rx = __builtin_amdgcn_make_buffer_rsrc((void*)(ta.ws + WS_X + 3 * XSZ), 0, (int)XSZ, 0x00020000);
            const int col0 = cur.pn * 256 + colw;
#pragma unroll
            for (int ai = 0; ai < 2; ++ai)
#pragma unroll
                for (int m = 0; m < 4; ++m) {
                    const int row = cur.pm * BM + ai * HALF + wr * 64 + m * 16 + fr;
#pragma unroll
                    for (int bj = 0; bj < 2; ++bj) {
                        float h[8];
#pragma unroll
                        for (int n = 0; n < 2; ++n)
#pragma unroll
                            for (int j = 0; j < 4; ++j) h[n * 4 + j] = acc[ai][bj][m][n][j] * ta.pscale[col0 + bj * HALF + n * 4 + j];
                        HANDOFF_STORE(pack8(h), rx, (unsigned)(((size_t)row * XW + col0 + bj * HALF) * 2), samel2);
                    }
                    asm volatile("" ::: "memory");
                }
            asm volatile("s_waitcnt vmcnt(0)" ::: "memory");
            if (lane == 0) (void)__hip_atomic_fetch_add(ta.cntA + 16 * cur.pm, 1u, __ATOMIC_RELAXED, __HIP_MEMORY_SCOPE_AGENT);
        } else {
            const int col0 = cur.pn * 256 + colw;
            bf16_t* NBo = (bf16_t*)(ta.ws + WS_NB);
#pragma unroll
            for (int ai = 0; ai < 2; ++ai)
#pragma unroll
                for (int m = 0; m < 4; ++m) {
                    const int row = cur.pm * BM + ai * HALF + wr * 64 + m * 16 + fr;
                    float* p = ta.H + (size_t)row * D + col0;
                    float q = 0.f;
#pragma unroll
                    for (int bj = 0; bj < 2; ++bj) {
                        float h[8];
#pragma unroll
                        for (int n = 0; n < 2; ++n) { f32x4* qp = (f32x4*)(p + bj * HALF + n * 4); f32x4 v = *qp; v += acc[ai][bj][m][n] * ta.s; *qp = v;
#pragma unroll
                            for (int j = 0; j < 4; ++j) { h[n * 4 + j] = v[j]; q += v[j] * v[j]; } }
                        *(u32x4*)(NBo + (size_t)row * D + col0 + bj * HALF) = pack8(h);
                    }
                    q += __shfl_xor(q, 16); q += __shfl_xor(q, 32);
                    if (fq == 0) atomicAdd(ta.sso + row, q * ta.s);
                    asm volatile("" ::: "memory");
                }
        }
        if (!has_next) break;
        {
#pragma unroll
        for (int a = 0; a < 2; ++a)
#pragma unroll
            for (int b = 0; b < 2; ++b)
#pragma unroll
                for (int m = 0; m < 4; ++m)
#pragma unroll
                    for (int n = 0; n < 2; ++n) acc[a][b][m][n] = (f32x4){0.f, 0.f, 0.f, 0.f};
        }
        ++ui;
        cur = nxt; cA = nA; cB = nB; chs = nhs; cvA0 = nvA0; cvA1 = nvA1; cvB0 = nvB0; cvB1 = nvB1; nt = TL_K(cur) / BK;
        if (wr == 1) PG8_BAR;
    }
    PG8_WAIT_V(0);
    PG8_BAR;
    if (!more) break;
    ++ui; tail_unit(ui, sG, sC, cur);
    }
#undef PG8_SA
#undef PG8_SB
#undef PG8_STAGE
#undef PG8_LDA
#undef PG8_LDB
#undef PG8_MMA
#undef PG8_WAIT_V
#undef PG8_WAIT_L
#undef PG8_BAR
#undef PG8_SCHED
#undef TL_DEP
#undef TL_READY
#undef TL_K
#undef TL_ABASE
#undef TL_BBASE
#undef TL_UA
#undef TL_UB
}
}

struct Args { const float* in[35]; float* out; unsigned char* ws; int ph_lo, ph_hi; };
static_assert(sizeof(Args) == 35 * 8 + 8 + 8 + 8, "Args has no padding");

typedef const Args __attribute__((address_space(4)))* ArgsP;
__device__ __forceinline__ ArgsP get_args() { ArgsP p = (ArgsP)__builtin_amdgcn_kernarg_segment_ptr(); asm volatile("" : "+s"(p)); return p; }
struct Ctx {
    LAS unsigned char* lds;
    int tid, lane, wave, gw, nW, bx, gx;
    float* H; float* SS; bf16_t* W; bf16_t* PB; bf16_t* NB; bf16_t* NB2; unsigned char* BIG; bf16_t* XA; bf16_t* XB; bf16_t* XD; bf16_t* XC;
};

__device__ __forceinline__ const float* x_row(ArgsP a, int r) { return r < MP ? a->in[0] + (size_t)r * D : a->in[1] + (size_t)(r - MP) * D; }
__device__ __forceinline__ const float* p_row(const float* pp, const float* ps, int L, int r) { return r < MP ? pp + ((size_t)L * MP + r) * DPLE : ps + ((size_t)L * MS + (r - MP)) * DPLE; }

template <int MODE>
__device__ __forceinline__ void norm_phase(const Ctx& c, const float* gain) {
    const int lane = c.lane;
    ArgsP ap = get_args();
    if (MODE == 0) { for (size_t i = (size_t)c.bx * 512 + c.tid; i < (size_t)8 * M; i += (size_t)c.gx * 512) c.SS[M + i] = 0.f; }
    f32x4 gv[4];
#pragma unroll
    for (int i = 0; i < 4; ++i) gv[i] = (MODE == 2) ? *(const f32x4*)(gain + i * 256 + lane * 4) : (f32x4){1.f, 1.f, 1.f, 1.f};
    for (int r = c.gw; r < M; r += c.nW) {
        const float* src = (MODE == 0) ? x_row(ap, r) : c.H + (size_t)r * D;
        f32x4 v[4]; float ss = 0.f;
#pragma unroll
        for (int i = 0; i < 4; ++i) { v[i] = *(const f32x4*)(src + i * 256 + lane * 4); ss += v[i][0] * v[i][0] + v[i][1] * v[i][1] + v[i][2] * v[i][2] + v[i][3] * v[i][3]; }
        if (MODE == 0) {
            ss = wave_sum(ss);
            if (lane == 0) c.SS[r] = ss;
#pragma unroll
            for (int i = 0; i < 4; ++i) {
                u32x2 w; w.x = cvt_pk_bf16(v[i][0], v[i][1]); w.y = cvt_pk_bf16(v[i][2], v[i][3]); *(u32x2*)(c.NB2 + (size_t)r * D + i * 256 + lane * 4) = w;
            }
        } else {
            const float rs = __builtin_amdgcn_rsqf(c.SS[(size_t)8 * M + r] * (1.0f / D) + EPS);
#pragma unroll
            for (int i = 0; i < 4; ++i) *(f32x4*)(c.H + (size_t)r * D + i * 256 + lane * 4) = v[i] * rs * gv[i];
        }
    }
}

__device__ __forceinline__ void prep_phase(const Ctx& c, int L, int it_lo, int it_hi, int b0, int bstride, bool do_tables) {
    ArgsP a = get_args();
    LAS unsigned* Tw = (LAS unsigned*)c.lds;
    const int tid = c.tid, lane = c.lane, wave = c.wave;
    if (b0 >= 0) for (int it = it_lo + b0; it < it_hi; it += bstride) {
        int r = it; const float* s0; const float* s1; const float* gain = nullptr; int ld, K, c0, c1, t, kc; size_t dsto;
        if (r < 352) { t = r >> 4; kc = r & 15; s0 = a->in[7] + (size_t)L * D * FF; s1 = a->in[8] + (size_t)L * D * FF; gain = a->in[6] + L * D; ld = FF; K = D; c0 = c1 = t * 128; dsto = W_GU1; }
        else if ((r -= 352) < 176) { t = r / 44; kc = r - t * 44; s0 = s1 = a->in[9] + (size_t)L * FF * D; ld = D; K = FF; c0 = t * 256; c1 = c0 + 128; dsto = W_D1; }
        else if ((r -= 176) < 160) { t = r >> 4; kc = r & 15; s0 = s1 = a->in[11] + (size_t)L * D * 5632; gain = a->in[10] + L * D; ld = 5632; K = D;
            if (t < 4) { c0 = t * 128; c1 = 512 + t * 128; } else { c0 = t * 256; c1 = c0 + 128; } dsto = W_IM; }
        else if ((r -= 160) < 192) { t = r >> 4; kc = r & 15; s0 = s1 = a->in[11] + (size_t)L * D * 5632; gain = a->in[10] + L * D; ld = 5632; K = D; c0 = 2560 + t * 256; c1 = c0 + 128; dsto = W_IG; }
        else if ((r -= 192) < 32) { t = r >> 3; kc = r & 7; s0 = s1 = a->in[17] + (size_t)L * 512 * D; ld = D; K = 512; c0 = t * 256; c1 = c0 + 128; dsto = W_CA; }
        else if ((r -= 32) < 32) { t = r >> 3; kc = r & 7; s0 = s1 = a->in[22] + (size_t)L * 512 * D; ld = D; K = 512; c0 = t * 256; c1 = c0 + 128; dsto = W_SB; }
        else if ((r -= 32) < 32) { t = r >> 3; kc = r & 7; s0 = s1 = a->in[25] + (size_t)L * 512 * D; ld = D; K = 512; c0 = t * 256; c1 = c0 + 128; dsto = W_PC; }
        else if ((r -= 32) < 64) { t = r >> 4; kc = r & 15; s0 = s1 = a->in[26] + (size_t)L * D * D; ld = D; K = D; c0 = t * 256; c1 = c0 + 128; dsto = W_O; }
        else if ((r -= 64) < 352) { t = r >> 4; kc = r & 15; s0 = a->in[28] + (size_t)L * D * FF; s1 = a->in[29] + (size_t)L * D * FF; gain = a->in[27] + L * D; ld = FF; K = D; c0 = c1 = t * 128; dsto = W_GU2; }
        else if ((r -= 352) < 176) { t = r / 44; kc = r - t * 44; s0 = s1 = a->in[30] + (size_t)L * FF * D; ld = D; K = FF; c0 = t * 256; c1 = c0 + 128; dsto = W_D2; }
        else if ((r -= 176) < 64) { t = r >> 4; kc = r & 15; s0 = s1 = a->in[32] + (size_t)L * D * D; gain = a->in[31] + L * D; ld = D; K = D; c0 = t * 256; c1 = c0 + 128; dsto = W_PG; }
        else { r -= 64; t = r >> 2; kc = r & 3; s0 = s1 = a->in[33] + (size_t)L * DPLE * D; ld = D; K = DPLE; c0 = t * 256; c1 = c0 + 128; dsto = W_PE; }
        const int k0 = kc * 64, d0 = t * 256;
        {
            const int hf = lane >> 5, c4 = (lane & 31) * 4;
            const float* sp = (hf ? s1 + c1 : s0 + c0) + (size_t)(k0 + wave * 8) * ld + c4;
            f32x4 v[8];
#pragma unroll
            for (int rr = 0; rr < 8; ++rr) v[rr] = *(const f32x4*)(sp + (size_t)rr * ld);
            if (gain) {
#pragma unroll
                for (int rr = 0; rr < 8; ++rr) v[rr] *= gain[k0 + wave * 8 + rr];
            }
            const int nb = hf * 128 + c4;
#pragma unroll
            for (int p = 0; p < 4; ++p)
#pragma unroll
                for (int i = 0; i < 4; ++i) Tw[(nb + i) * 33 + wave * 4 + p] = cvt_pk_bf16(v[2 * p][i], v[2 * p + 1][i]);
        }
        __syncthreads();
        bf16_t* dst = c.W + dsto;
        {
            const int n = tid >> 1, hk = tid & 1;
            bf16_t* dp = dst + (size_t)(d0 + n) * K + k0 + 32 * hk;
#pragma unroll
            for (int jq = 0; jq < 4; ++jq) {
                u32x4 w; w.x = Tw[n * 33 + 16 * hk + 4 * jq]; w.y = Tw[n * 33 + 16 * hk + 4 * jq + 1]; w.z = Tw[n * 33 + 16 * hk + 4 * jq + 2]; w.w = Tw[n * 33 + 16 * hk + 4 * jq + 3];
                *(u32x4*)(dp + 8 * jq) = w;
            }
        }
        __syncthreads();
    }
    if (!do_tables) return;
    if (b0 < 0) return;
    const size_t gtid = (size_t)b0 * 512 + tid, gstride = (size_t)bstride * 512;
    const float* pw = a->in[23] + (size_t)L * 4 * 128 * 128;
    for (size_t i = gtid; i < 512 * 512; i += gstride) { const int n = (int)(i >> 9), k = (int)(i & 511);
        c.W[W_PBD + i] = ((n >> 7) == (k >> 7)) ? f2bf(pw[((size_t)(n >> 7) * 128 + (k & 127)) * 128 + (n & 127)]) : (bf16_t)0; }
    const float* wsrc = a->in[20] + (size_t)L * 4 * 128 * 128;
    for (size_t i = gtid; i < 65536; i += gstride) { const int ii = (int)((i >> 7) & 127), jj = (int)(i & 127); c.W[W_WS + i] = (jj <= ii) ? f2bf(wsrc[i]) : (bf16_t)0; }
    const float* pp = a->in[2]; const float* ps = a->in[3];
    for (size_t i = gtid; i < (size_t)M * 64; i += gstride) { const int r = (int)(i >> 6), c4 = (int)(i & 63);
        const f32x4 v = *(const f32x4*)(p_row(pp, ps, L, r) + c4 * 4); u32x2 w; w.x = cvt_pk_bf16(v[0], v[1]); w.y = cvt_pk_bf16(v[2], v[3]); *(u32x2*)(c.PB + (size_t)r * DPLE + c4 * 4) = w; }
}

__device__ __forceinline__ void load_bf8(const bf16_t* p, float (&x)[8]) { unpack8(*(const u32x4*)p, x); }

#ifndef MIX_REP_SKIP
#define MIX_REP_SKIP 0
#endif
__device__ __forceinline__ void mix_phase(const Ctx& c, int L, int qsel) {
    const int skip = (qsel & 1) ? MIX_REP_SKIP : 0;
    ArgsP a = get_args();
    const bf16_t* ZM = (const bf16_t*)c.BIG;
    const int tid = c.tid, lane = c.lane, wave = c.wave, fr = lane & 15, fq = lane >> 4;
    float* out = a->out;
    unsigned* qctr = (unsigned*)(a->ws + WS_BAR) + 4096 + 128 * qsel;
    volatile LAS unsigned* qslot = (volatile LAS unsigned*)(c.lds + 65536);
    if (!(skip & 1)) for (int b = c.bx; b < 160; b += c.gx) {
        const int row0 = b < 128 ? b * 128 : MP + (b - 128) * 64, R = b < 128 ? 128 : 64;
        LAS unsigned char* vnT = c.lds;
        const float* lg = a->in[18] + L * 512; const float* lb = a->in[19] + L * 512;
        float gch[8], bch[8];
#pragma unroll
        for (int e = 0; e < 8; ++e) { gch[e] = lg[lane + 64 * e]; bch[e] = lb[lane + 64 * e]; }
        float* vout = nullptr;
        if (b < 128) { if ((b & 63) == 63) vout = out + O_VP + ((size_t)(L * 2 + (b >> 6)) * 128) * 512; }
        else vout = out + O_VS + ((size_t)(L * 32 + (b - 128)) * 64) * 512;
        for (int grp = wave; grp < 16; grp += 8) {
            const int j0 = grp * 8;
            if (j0 >= R) {
#pragma unroll
                for (int e = 0; e < 8; ++e) *(LAS u32x4*)(vnT + (lane + 64 * e) * 272 + j0 * 2) = (u32x4){0u, 0u, 0u, 0u};
                continue;
            }
            float y[8][8];
#pragma unroll
            for (int rr = 0; rr < 8; ++rr) {
                const bf16_t* vp = ZM + (size_t)(row0 + j0 + rr) * ZMW + 1024 + lane;
                float s = 0.f;
#pragma unroll
                for (int e = 0; e < 8; ++e) { y[rr][e] = bf2f(vp[64 * e]); s += y[rr][e]; }
                const float mu = wave_sum(s) * (1.0f / 512);
                float q = 0.f;
#pragma unroll
                for (int e = 0; e < 8; ++e) { y[rr][e] -= mu; q += y[rr][e] * y[rr][e]; }
                const float rstd = __builtin_amdgcn_rsqf(wave_sum(q) * (1.0f / 512) + EPS);
#pragma unroll
                for (int e = 0; e < 8; ++e) y[rr][e] = y[rr][e] * rstd * gch[e] + bch[e];
                if (vout) {
#pragma unroll
                    for (int e = 0; e < 8; ++e) vout[(size_t)(j0 + rr) * 512 + lane + 64 * e] = y[rr][e];
                }
            }
#pragma unroll
            for (int e = 0; e < 8; ++e) {
                u32x4 w; w.x = cvt_pk_bf16(y[0][e], y[1][e]); w.y = cvt_pk_bf16(y[2][e], y[3][e]); w.z = cvt_pk_bf16(y[4][e], y[5][e]); w.w = cvt_pk_bf16(y[6][e], y[7][e]);
                *(LAS u32x4*)(vnT + (lane + 64 * e) * 272 + j0 * 2) = w;
            }
        }
        __syncthreads();
        const int ib = wave * 16, nkb = (ib + 15) / 32 + 1;
        const bf16_t* WsB = c.W + W_WS;
        const float* bs = a->in[21] + L * 512;
#pragma unroll 1
        for (int g = 0; g < 4; ++g) {
            bf16x8 af[4];
#pragma unroll
            for (int kb = 0; kb < 4; ++kb) af[kb] = *(const bf16x8*)(WsB + ((size_t)g * 128 + ib + fr) * 128 + kb * 32 + fq * 8);
            float bsv[4]; bf16_t uraw[8][4];
#pragma unroll
            for (int jj = 0; jj < 4; ++jj) bsv[jj] = bs[g * 128 + ib + fq * 4 + jj];
            if (ib < R) {
#pragma unroll
                for (int ni = 0; ni < 8; ++ni)
#pragma unroll
                    for (int jj = 0; jj < 4; ++jj) uraw[ni][jj] = ZM[(size_t)(row0 + ib + fq * 4 + jj) * ZMW + 512 + g * 128 + ni * 16 + fr];
#pragma unroll
                for (int ni = 0; ni < 8; ++ni) {
                    const int col = g * 128 + ni * 16 + fr;
                    f32x4 acc = (f32x4){0.f, 0.f, 0.f, 0.f};
#pragma unroll
                    for (int kb = 0; kb < 4; ++kb) if (kb < nkb) {
                        const bf16x8 bfr = *(const LAS bf16x8*)(vnT + col * 272 + (kb * 32 + fq * 8) * 2);
                        acc = __builtin_amdgcn_mfma_f32_16x16x32_bf16(af[kb], bfr, acc, 0, 0, 0);
                    }
#pragma unroll
                    for (int jj = 0; jj < 4; ++jj) {
                        const size_t r = (size_t)(row0 + ib + fq * 4 + jj);
                        c.XB[r * XW + col] = f2bf(bf2f(uraw[ni][jj]) * (acc[jj] + bsv[jj]));
                    }
                }
            }
        }
        __syncthreads();
    }
    __syncthreads();
    {
        LAS float* wl = (LAS float*)c.lds; const float* wg = a->in[13] + (size_t)L * 31 * 512;
        for (int i = tid; i < 31 * 512 / 4; i += 512) *(LAS f32x4*)(wl + i * 4) = *(const f32x4*)(wg + i * 4);
    }
    __syncthreads();
    {
        const LAS float* wl = (const LAS float*)c.lds;
        float dwb[8], lng[8], lnb[8];
#pragma unroll
        for (int e = 0; e < 8; ++e) { dwb[e] = a->in[14][L * 512 + lane * 8 + e]; lng[e] = a->in[15][L * 512 + lane * 8 + e]; lnb[e] = a->in[16][L * 512 + lane * 8 + e]; }
        unsigned nextv = 0; int qb = M;
        if (!(skip & 2)) { if (tid == 0) *qslot = atomicAdd(qctr, 8u); __syncthreads(); qb = (int)*qslot; __syncthreads(); }
        for (;;) {
            if (qb >= M / 4) break;
            if (tid == 0) nextv = atomicAdd(qctr, 8u);
            const int qi = qb + wave;
            const int itm = qi < MS / 4 ? MP / 4 + qi : qi - MS / 4;
            const int r0 = itm * 4;
            int seq0, trel; const float* hist = nullptr;
            if (r0 < MP) { seq0 = (r0 / SEQ) * SEQ; trel = r0 - seq0; }
            else { const int s = (r0 - MP) / DSEQ; seq0 = MP + s * DSEQ; trel = r0 - seq0; hist = a->in[4] + ((size_t)(L * 32 + s) * 30) * 512; }
            if (!hist || trel >= 30) {
                float ah[2][4][4];
#pragma unroll
                for (int hf = 0; hf < 2; ++hf) {
                    const int ch = hf * 256 + lane * 4; const unsigned choff = (unsigned)ch * 2u;
                    u32x2 raw[34];
#pragma unroll
                    for (int ri = 0; ri < 34; ++ri) { const int t = trel - 30 + ri;
                        const char* rowp = (const char*)ZM + (size_t)(seq0 + (t >= 0 ? t : 0)) * (ZMW * 2);
                        const u32x2 v = *(const u32x2*)(rowp + choff);
                        raw[ri].x = (t >= 0) ? v.x : 0u; raw[ri].y = (t >= 0) ? v.y : 0u; }
#pragma unroll
                    for (int o = 0; o < 4; ++o)
#pragma unroll
                        for (int e = 0; e < 4; ++e) ah[hf][o][e] = 0.f;
                    float xq[4][4];
#pragma unroll
                    for (int i = 0; i < 3; ++i) { xq[i][0] = bflo(raw[i].x); xq[i][1] = bfhi(raw[i].x); xq[i][2] = bflo(raw[i].y); xq[i][3] = bfhi(raw[i].y); }
                    f32x4 w0 = *(const LAS f32x4*)(wl + ch);
#pragma unroll
                    for (int k = 0; k < 31; ++k) {
                        f32x4 n0 = w0;
                        if (k < 30) n0 = *(const LAS f32x4*)(wl + (k + 1) * 512 + ch);
                        { const int i = (k + 3) & 3; xq[i][0] = bflo(raw[k + 3].x); xq[i][1] = bfhi(raw[k + 3].x); xq[i][2] = bflo(raw[k + 3].y); xq[i][3] = bfhi(raw[k + 3].y); }
#pragma unroll
                        for (int o = 0; o < 4; ++o)
#pragma unroll
                            for (int e = 0; e < 4; ++e) ah[hf][o][e] += xq[(k + o) & 3][e] * w0[e];
                        w0 = n0;
                        asm volatile("" : "+v"(ah[hf][0][0]), "+v"(ah[hf][0][1]), "+v"(ah[hf][0][2]), "+v"(ah[hf][0][3]), "+v"(ah[hf][1][0]), "+v"(ah[hf][1][1]), "+v"(ah[hf][1][2]), "+v"(ah[hf][1][3]),
                                          "+v"(ah[hf][2][0]), "+v"(ah[hf][2][1]), "+v"(ah[hf][2][2]), "+v"(ah[hf][2][3]), "+v"(ah[hf][3][0]), "+v"(ah[hf][3][1]), "+v"(ah[hf][3][2]), "+v"(ah[hf][3][3]));
                    }
                }
                const float* pdb = a->in[14] + L * 512; const float* plg = a->in[15] + L * 512; const float* plb = a->in[16] + L * 512;
                f32x4 db[2], lg2[2], lb2[2];
#pragma unroll
                for (int hf = 0; hf < 2; ++hf) { db[hf] = *(const f32x4*)(pdb + hf * 256 + lane * 4); lg2[hf] = *(const f32x4*)(plg + hf * 256 + lane * 4); lb2[hf] = *(const f32x4*)(plb + hf * 256 + lane * 4); }
#pragma unroll
                for (int o = 0; o < 4; ++o) {
                    float sm = 0.f;
#pragma unroll
                    for (int hf = 0; hf < 2; ++hf)
#pragma unroll
                        for (int e = 0; e < 4; ++e) { ah[hf][o][e] += db[hf][e]; sm += ah[hf][o][e]; }
                    const float mu = wave_sum(sm) * (1.0f / 512);
                    float q = 0.f;
#pragma unroll
                    for (int hf = 0; hf < 2; ++hf)
#pragma unroll
                        for (int e = 0; e < 4; ++e) { ah[hf][o][e] -= mu; q += ah[hf][o][e] * ah[hf][o][e]; }
                    const float rstd = __builtin_amdgcn_rsqf(wave_sum(q) * (1.0f / 512) + EPS);
#pragma unroll
                    for (int hf = 0; hf < 2; ++hf) {
                        float y4[4];
#pragma unroll
                        for (int e = 0; e < 4; ++e) { const float yv = ah[hf][o][e] * rstd * lg2[hf][e] + lb2[hf][e]; y4[e] = yv * sigmoidf_(yv); }
                        u32x2 w; w.x = cvt_pk_bf16(y4[0], y4[1]); w.y = cvt_pk_bf16(y4[2], y4[3]);
                        *(u32x2*)(c.XA + (size_t)(r0 + o) * XW + hf * 256 + lane * 4) = w;
                    }
                }
                goto a_item_done;
            }
            float acc[4][8];
#pragma unroll
            for (int o = 0; o < 4; ++o)
#pragma unroll
                for (int e = 0; e < 8; ++e) acc[o][e] = dwb[e];
            float xw[4][8];
            {
            auto ldrow = [&](int ri, float (&x)[8]) {
                const int t = trel - 30 + ri;
                if (t >= 0) load_bf8(ZM + (size_t)(seq0 + t) * ZMW + lane * 8, x);
                else { const f32x4 h0 = *(const f32x4*)(hist + (size_t)(30 + t) * 512 + lane * 8), h1 = *(const f32x4*)(hist + (size_t)(30 + t) * 512 + lane * 8 + 4);
                    x[0] = h0[0]; x[1] = h0[1]; x[2] = h0[2]; x[3] = h0[3]; x[4] = h1[0]; x[5] = h1[1]; x[6] = h1[2]; x[7] = h1[3]; }
            };
            ldrow(0, xw[0]); ldrow(1, xw[1]); ldrow(2, xw[2]);
#pragma unroll 2
            for (int kk = 0; kk < 32; kk += 4) {
#pragma unroll
                for (int k4 = 0; k4 < 4; ++k4) {
                    const int k = kk + k4;
                    if (k < 31) {
                        ldrow(k + 3, xw[(k4 + 3) & 3]);
                        const f32x4 w0 = *(const LAS f32x4*)(wl + k * 512 + lane * 8), w1 = *(const LAS f32x4*)(wl + k * 512 + lane * 8 + 4);
#pragma unroll
                        for (int o = 0; o < 4; ++o) {
#pragma unroll
                            for (int e = 0; e < 4; ++e) { acc[o][e] += xw[(k4 + o) & 3][e] * w0[e]; acc[o][e + 4] += xw[(k4 + o) & 3][e + 4] * w1[e]; }
                        }
                    }
                }
            }
            }
#pragma unroll
            for (int o = 0; o < 4; ++o) {
                float s = 0.f;
#pragma unroll
                for (int e = 0; e < 8; ++e) s += acc[o][e];
                const float mu = wave_sum(s) * (1.0f / 512);
                float q = 0.f;
#pragma unroll
                for (int e = 0; e < 8; ++e) { acc[o][e] -= mu; q += acc[o][e] * acc[o][e]; }
                const float rstd = __builtin_amdgcn_rsqf(wave_sum(q) * (1.0f / 512) + EPS);
                float h[8];
#pragma unroll
                for (int e = 0; e < 8; ++e) { const float yv = acc[o][e] * rstd * lng[e] + lnb[e]; h[e] = yv * sigmoidf_(yv); }
                *(u32x4*)(c.XA + (size_t)(r0 + o) * XW + lane * 8) = pack8(h);
            }
            a_item_done:
            if (tid == 0) *qslot = nextv;
            __syncthreads();
            qb = (int)*qslot;
            __syncthreads();
        }
    }
    {
        const int win = 2 << (lane >> 4);
        unsigned nextv = 0; int qb = M;
        if (!(skip & 4)) { if (tid == 0) *qslot = atomicAdd(qctr + 64, 8u); __syncthreads(); qb = (int)*qslot; __syncthreads(); }
        for (;;) {
            if (qb >= M / 4) break;
            if (tid == 0) nextv = atomicAdd(qctr + 64, 8u);
            const int qi = qb + wave;
            const int itm = qi < MS / 4 ? MP / 4 + qi : qi - MS / 4;
            const int r0 = itm * 4;
            int seq0, trel; const float* hist = nullptr;
            if (r0 < MP) { seq0 = (r0 / SEQ) * SEQ; trel = r0 - seq0; }
            else { const int s = (r0 - MP) / DSEQ; seq0 = MP + s * DSEQ; trel = r0 - seq0; hist = a->in[5] + ((size_t)(L * 32 + s) * 15) * 512; }
            float acc[4][8], cur[4][8];
#pragma unroll
            for (int o = 0; o < 4; ++o)
#pragma unroll
                for (int e = 0; e < 8; ++e) { acc[o][e] = 0.f; cur[o][e] = 0.f; }
#pragma unroll
            for (int ri = 0; ri < 19; ++ri) {
                const int t = trel - 15 + ri;
                float x[8];
                if (t >= 0) load_bf8(ZM + (size_t)(seq0 + t) * ZMW + 1536 + lane * 8, x);
                else if (hist) { const f32x4 h0 = *(const f32x4*)(hist + (size_t)(15 + t) * 512 + lane * 8), h1 = *(const f32x4*)(hist + (size_t)(15 + t) * 512 + lane * 8 + 4);
                    x[0] = h0[0]; x[1] = h0[1]; x[2] = h0[2]; x[3] = h0[3]; x[4] = h1[0]; x[5] = h1[1]; x[6] = h1[2]; x[7] = h1[3]; }
                else {
#pragma unroll
                    for (int e = 0; e < 8; ++e) x[e] = 0.f; }
#pragma unroll
                for (int o = 0; o < 4; ++o) {
                    const int dd = 15 + o - ri;
                    if (dd >= 0 && dd < 16) {
                        const bool inw = dd < win;
#pragma unroll
                        for (int e = 0; e < 8; ++e) acc[o][e] += inw ? x[e] : 0.f;
                        if (dd == 0) {
#pragma unroll
                            for (int e = 0; e < 8; ++e) cur[o][e] = x[e];
                        }
                    }
                }
            }
#pragma unroll
            for (int o = 0; o < 4; ++o) {
                const int cnt = hist ? win : min(trel + o + 1, win);
                const float inv = 1.0f / (float)cnt;
                float h[8];
#pragma unroll
                for (int e = 0; e < 8; ++e) h[e] = acc[o][e] * inv - cur[o][e];
                *(u32x4*)(c.XD + (size_t)(r0 + o) * XW + lane * 8) = pack8(h);
            }
            if (tid == 0) *qslot = nextv;
            __syncthreads();
            qb = (int)*qslot;
            __syncthreads();
        }
    }
    for (int idx = c.gw; idx < 34 * 45; idx += c.nW) {
        const int seq = idx / 45, k = idx - seq * 45;
        size_t srow; float* dst; int coff;
        if (k < 30) { coff = 0;
            if (seq < 2) { srow = (size_t)seq * SEQ + (SEQ - 30) + k; dst = out + O_CONVP + ((size_t)(L * 2 + seq) * 30 + k) * 512; }
            else { srow = (size_t)MP + (seq - 2) * DSEQ + (DSEQ - 30) + k; dst = out + O_CONVS + ((size_t)(L * 32 + seq - 2) * 30 + k) * 512; }
        } else { const int kk = k - 30; coff = 1536;
            if (seq < 2) { srow = (size_t)seq * SEQ + (SEQ - 15) + kk; dst = out + O_POOLP + ((size_t)(L * 2 + seq) * 15 + kk) * 512; }
            else { srow = (size_t)MP + (seq - 2) * DSEQ + (DSEQ - 15) + kk; dst = out + O_POOLS + ((size_t)(L * 32 + seq - 2) * 15 + kk) * 512; }
        }
        float x[8]; load_bf8(ZM + srow * ZMW + coff + lane * 8, x);
        *(f32x4*)(dst + lane * 8) = (f32x4){x[0], x[1], x[2], x[3]}; *(f32x4*)(dst + lane * 8 + 4) = (f32x4){x[4], x[5], x[6], x[7]};
    }
    __syncthreads();
}


#define XB_TMO      128
#define XB_XCNT(j)  (256  + 64 * (j))
#define XB_XSUB(j)  (1280 + 64 * (j))
#define XB_XGEN(j)  (2304 + 64 * (j))
#define XB_TOP      3328
#define XB_TOPGEN   3392
#define XCD_BAR_WORDS 3456
#define XB_SPIN_CAP (1u << 22)
__device__ __forceinline__ unsigned xb_ld(unsigned* p)              { return __hip_atomic_load(p, __ATOMIC_RELAXED, __HIP_MEMORY_SCOPE_AGENT); }
__device__ __forceinline__ unsigned xb_add(unsigned* p, unsigned v) { return __hip_atomic_fetch_add(p, v, __ATOMIC_RELAXED, __HIP_MEMORY_SCOPE_AGENT); }
__device__ __forceinline__ unsigned xb_xcc_id() { return (unsigned)__builtin_amdgcn_s_getreg((3 << 11) | 20) & 0xFu; }
#define XB_SPIN(cond, bar) do { unsigned _sp = 0; while (cond) { __builtin_amdgcn_s_sleep(1); \
    if ((++_sp & 255u) == 0u) { if (xb_ld(&(bar)[XB_TMO])) break; if (_sp > XB_SPIN_CAP) { atomicAdd(&(bar)[XB_TMO], 1u); break; } } } } while (0)
__device__ __forceinline__ void xcd_barrier_complete(unsigned* bar, unsigned x, unsigned& nloc, unsigned& nx) {
    const unsigned G = gridDim.x * gridDim.y * gridDim.z;
    unsigned sum, cnt, mine, sp = 0u;
    for (;;) {
        sum = 0u; cnt = 0u; mine = 0u;
#pragma unroll
        for (unsigned j = 0; j < 16; ++j) { const unsigned c = xb_ld(&bar[XB_XCNT(j)]); sum += c; cnt += (c > 0u) ? 1u : 0u; mine = (j == x) ? c : mine; }
        if (sum == G) break;
        __builtin_amdgcn_s_sleep(1);
        if ((++sp & 255u) == 0u) { if (xb_ld(&bar[XB_TMO])) break; if (sp > XB_SPIN_CAP) { atomicAdd(&bar[XB_TMO], 1u); break; } }
    }
    nloc = mine > 0u ? mine : 1u; nx = cnt > 0u ? cnt : 1u;
}
__device__ __forceinline__ void xcd_barrier(unsigned* bar, volatile LAS unsigned* st, int tid) {
    asm volatile("s_waitcnt vmcnt(0)" ::: "memory");
    __syncthreads();
    if (tid == 0) {
        __builtin_amdgcn_s_waitcnt(0);
        const unsigned x = xb_xcc_id();
        unsigned nloc = st[0], nx = st[1];
        if (nloc == 0u) { xcd_barrier_complete(bar, x, nloc, nx); st[0] = nloc; st[1] = nx;
            const unsigned G8 = (gridDim.x * gridDim.y * gridDim.z) >> 3; bool uni = ((G8 << 3) == gridDim.x * gridDim.y * gridDim.z) && nx == 8u && x < 8u;
#pragma unroll
            for (unsigned j = 0; j < 8; ++j) uni = uni && (xb_ld(&bar[XB_XCNT(j)]) == G8);
            if (uni) st[2] = st[3] * 8u + x;
            st[3] = (uni && gridDim.x == 256u) ? 1u : 0u; }
        const unsigned old = xb_add(&bar[XB_XSUB(x)], 1u);
        const unsigned gen = old / nloc;
        if (old + 1u == (gen + 1u) * nloc) {
            __builtin_amdgcn_fence(__ATOMIC_RELEASE, "agent");
            asm volatile("s_waitcnt vmcnt(0)" ::: "memory");
            const unsigned og = xb_add(&bar[XB_TOP], 1u);
            const unsigned tg = og / nx;
            if (og + 1u == (tg + 1u) * nx) xb_add(&bar[XB_TOPGEN], 1u);
            else XB_SPIN(xb_ld(&bar[XB_TOPGEN]) == tg, bar);
            __builtin_amdgcn_fence(__ATOMIC_ACQUIRE, "agent");
            xb_add(&bar[XB_XGEN(x)], 1u);
            asm volatile("s_waitcnt vmcnt(0)" ::: "memory");
        } else {
            XB_SPIN(xb_ld(&bar[XB_XGEN(x)]) == gen, bar);
            __builtin_amdgcn_fence(__ATOMIC_ACQUIRE, "agent");
            asm volatile("s_waitcnt vmcnt(0)" ::: "memory");
        }
    }
    __syncthreads();
}

constexpr int NPT = 6;
constexpr int P0N = 1 + (int)(REP_MASK & 1u), PPL = NPT + __builtin_popcount((REP_MASK >> 1) & ((1u << NPT) - 1u)), NPHASE = P0N + PPL * NLAYER + 1;

__global__ void __launch_bounds__(512, 2) fwd_kernel(Args args) {
    extern __shared__ __attribute__((aligned(16))) unsigned char lds_raw[];
    (void)args;
    LAS unsigned char* lds = (LAS unsigned char*)lds_raw;
    const int wave0 = __builtin_amdgcn_readfirstlane((int)threadIdx.x >> 6);
    const int hi = get_args()->ph_hi;
    unsigned* bar = (unsigned*)(get_args()->ws + WS_BAR);
    volatile LAS unsigned* bst = (volatile LAS unsigned*)(lds + LDS_BYTES - 16);
    if (threadIdx.x == 0) { bst[0] = 0u; bst[1] = 0u; bst[2] = blockIdx.x; bst[3] = xb_add(&bar[XB_XCNT(xb_xcc_id())], 1u); }
    __syncthreads();
#define MKCTX() Ctx c; { ArgsP ka = get_args(); int t_; asm volatile("v_mbcnt_lo_u32_b32 %0, -1, 0\n\tv_mbcnt_hi_u32_b32 %0, -1, %0" : "=v"(t_)); int wv_ = wave0, bx_ = (int)__builtin_amdgcn_readfirstlane((int)*(volatile LAS unsigned*)(lds + LDS_BYTES - 8)), gx_ = (int)gridDim.x; asm volatile("" : "+s"(wv_), "+s"(bx_), "+s"(gx_)); t_ += wv_ * 64; unsigned char* ws = ka->ws; \
        c.lds = lds; c.tid = t_; c.lane = t_ & 63; c.wave = wv_; c.bx = bx_; c.gx = gx_; c.gw = bx_ * 8 + wv_; c.nW = gx_ * 8; \
        c.H = ka->out; c.SS = (float*)ws; c.NB2 = (bf16_t*)(ws + WS_NB2); c.W = (bf16_t*)(ws + WS_W); c.PB = (bf16_t*)(ws + WS_PB); c.NB = (bf16_t*)(ws + WS_NB); c.BIG = ws + WS_BIG; \
        c.XA = (bf16_t*)(ws + WS_X); c.XB = c.XA + (size_t)M * XW; c.XD = c.XB + (size_t)M * XW; c.XC = c.XD + (size_t)M * XW; } \
        bf16_t* HID = (bf16_t*)c.BIG; bf16_t* ZM = (bf16_t*)c.BIG; bf16_t* ZG = (bf16_t*)c.BIG; float* T = (float*)c.BIG; (void)HID; (void)ZM; (void)ZG; (void)T; \

#define GEMM1(EPI, Aptr, Bptr, Nn, Kk, ...) do { pg8::Gemm g{(Aptr), (Aptr), (Aptr), (Bptr), (Bptr), (Bptr)}; \
        pg8::EPI E{__VA_ARGS__}; pg8::gemm_phase<pg8::EPI, (Nn), (Kk), 1, G_ALIGN, G_SP2>(lds, c.tid, g, E); } while (0)

#pragma unroll 1
    for (int ph = get_args()->ph_lo; ph < hi; ++ph) {
        int L = 0, j = -1, rep = 0;
        if (ph < P0N) rep = ph;
        else if (ph >= P0N + PPL * NLAYER) { L = NLAYER - 1; j = NPT; }
        else { int q = ph - P0N; L = q / PPL; q -= L * PPL;
            for (int jj = 0; jj < NPT; ++jj) { const int cnt = 1 + (int)((REP_MASK >> (jj + 1)) & 1u); if (q < cnt) { j = jj; rep = q; break; } q -= cnt; } }
        const float rsc = rep ? 0.f : 1.f, rsh = rep ? 0.f : 0.5f;
        {
#ifdef PH_ONLY
        switch (PH_ONLY) {
#else
        switch (j) {
#endif
        case -1: { MKCTX(); prep_phase(c, 0, 0, 1648, c.bx, c.gx, true); norm_phase<0>(c, nullptr); } break;
        case 0: case 4: { MKCTX(); const bool f1 = (j == 0);
            pg8::FfnArgs fa{f1 ? c.NB2 : c.NB, c.W + (f1 ? W_GU1 : W_GU2), HID, c.W + (f1 ? W_D1 : W_D2), c.SS + (size_t)(4 * L + (f1 ? 0 : 2)) * M,
                            c.H, c.NB, c.SS + (size_t)(4 * L + (f1 ? 1 : 3)) * M, (unsigned*)(get_args()->ws + WS_BAR) + 8192 + 1152 * (2 * (2 * L + (f1 ? 0 : 1)) + rep),
                            (f1 && L == 0 && !rep) ? get_args()->in[0] : nullptr, (f1 && L == 0 && !rep) ? get_args()->in[1] : nullptr,
                            f1 ? nullptr : c.PB, c.W + W_PE, (float*)c.XA, rsh, rsc};
            pg8::ffn_phase(lds, c.tid, fa); } break;
        case 1: { MKCTX(); GEMM1(EpiWinMix, c.NB, c.W + W_IM, 2560, D, ZM, c.SS + (size_t)(4 * L + 1) * M);
            if (L > 0 && !rep && c.gx > 64) prep_phase(c, L, 1568, 1632, c.bx - 208, c.gx - 208, false);
        } break;
        case 2: { MKCTX(); mix_phase(c, L, 2 * L + rep); } break;
        case 3: { MKCTX();
            unsigned* tc = (unsigned*)(get_args()->ws + WS_BAR) + 17408 + 2304 * (2 * L + rep);
            pg8::TailArgs ta{get_args()->ws, c.H, get_args()->in[12] + L * 3072, get_args()->in[24] + L * 512, c.SS + (size_t)(4 * L + 1) * M, c.SS + (size_t)(4 * L + 2) * M, tc, tc + 1152, rsc};
            pg8::tail_phase(lds, c.tid, ta); } break;
        case 5: {
            { MKCTX(); GEMM1(EpiPE, c.NB, c.W + W_PG, D, D, c.H, (const float*)c.XA, rsc, c.SS + (size_t)(4 * L + 3) * M, c.NB2, c.SS + (size_t)(4 * L + 4) * M); }
            if (L + 1 < NLAYER && !rep) { MKCTX();
                if (c.gx > 64) { prep_phase(c, L + 1, 0, 1568, c.bx - 32, c.gx - 32, false); prep_phase(c, L + 1, 1632, 1648, c.bx - 32, c.gx - 32, true); }
                else prep_phase(c, L + 1, 0, 1648, c.bx, c.gx, true); }
        } break;
        default: { MKCTX(); if (!rep) norm_phase<2>(c, get_args()->in[34]); } break;
        }
        }
        if (ph + 1 < hi) {
            if (hi < 0) cg::this_grid().sync();
            { int t_; asm volatile("v_mbcnt_lo_u32_b32 %0, -1, 0\n\tv_mbcnt_hi_u32_b32 %0, -1, %0" : "=v"(t_)); xcd_barrier(bar, bst, t_ + wave0 * 64); }
        }
    }
#undef GEMM1
#undef MKCTX
}

extern "C" void kernel_launch(void* const* d_in, const int* in_sizes, int n_in, void* d_out, int out_size, void* d_ws, size_t ws_size, hipStream_t stream) {
    static int grid = 0;
    if (grid == 0) {
        if (n_in != 35 || (size_t)out_size != O_END || ws_size < WS_END) { fprintf(stderr, "kernel_launch: unexpected shapes (n_in %d, out %d, ws %zu)\n", n_in, out_size, ws_size); grid = -1; return; }
        int dev = 0, cus = 0, per_cu = 0;
        if (hipGetDevice(&dev) != hipSuccess || hipDeviceGetAttribute(&cus, hipDeviceAttributeMultiprocessorCount, dev) != hipSuccess) { grid = -1; return; }
        if (hipFuncSetAttribute((const void*)fwd_kernel, hipFuncAttributeMaxDynamicSharedMemorySize, LDS_BYTES) != hipSuccess) { fprintf(stderr, "kernel_launch: hipFuncSetAttribute failed\n"); grid = -1; return; }
        if (hipOccupancyMaxActiveBlocksPerMultiprocessor(&per_cu, (const void*)fwd_kernel, 512, LDS_BYTES) != hipSuccess || per_cu < 1) { fprintf(stderr, "kernel_launch: occupancy query says %d\n", per_cu); per_cu = 1; }
        (void)hipGetLastError();
        grid = cus * 1;
    }
    if (grid < 0) return;
    Args a{};
    for (int i = 0; i < 35; ++i) a.in[i] = (const float*)d_in[i];
    a.out = (float*)d_out; a.ws = (unsigned char*)d_ws;
#if MK_N_LAUNCHES == 1
    (void)hipMemsetAsync((char*)d_ws + WS_BAR, 0, 131072, stream);
    a.ph_lo = 0; a.ph_hi = NPHASE;
    void* kargs[] = {&a};
    hipError_t e = hipLaunchCooperativeKernel((const void*)fwd_kernel, dim3(grid), dim3(512), kargs, LDS_BYTES, stream);
    if (e != hipSuccess) fprintf(stderr, "kernel_launch: cooperative launch failed: %s (grid %d)\n", hipGetErrorString(e), grid);
#else
    for (int ph = 0; ph < NPHASE; ++ph) {
        a.ph_lo = ph; a.ph_hi = ph + 1;
        hipLaunchKernelGGL(fwd_kernel, dim3(grid), dim3(512), LDS_BYTES, stream, a);
    }
#endif
}
```

```cpp
#include <hip/hip_runtime.h>
#include <hip/hip_cooperative_groups.h>
#include <cstdio>
#include <cstdint>
namespace cg = cooperative_groups;

#ifndef MK_N_LAUNCHES
#define MK_N_LAUNCHES 1
#endif
#ifndef REP_MASK
#define REP_MASK 0u
#endif
#ifndef G_SP2
#define G_SP2 true
#endif
#ifndef G_ALIGN
#define G_ALIGN true
#endif

#define LAS __attribute__((address_space(3)))
typedef unsigned short bf16_t;
typedef short bf16x8 __attribute__((ext_vector_type(8)));
typedef float f32x4 __attribute__((ext_vector_type(4)));
typedef unsigned u32x4 __attribute__((ext_vector_type(4)));
typedef unsigned u32x2 __attribute__((ext_vector_type(2)));

constexpr int D = 1024, FF = 2816, MP = 16384, MS = 2048, M = MP + MS, SEQ = 8192, DSEQ = 64, DPLE = 256;
constexpr int NLAYER = 2;
constexpr float EPS = 1e-6f;
constexpr int ZMW = 2048, ZGW = 3072, XW = 512;
constexpr size_t O_Y = 0, O_CONVP = (size_t)M * D, O_CONVS = O_CONVP + 2 * 2 * 30 * 512, O_POOLP = O_CONVS + 2 * 32 * 30 * 512,
                 O_POOLS = O_POOLP + 2 * 2 * 15 * 512, O_VP = O_POOLS + 2 * 32 * 15 * 512, O_VS = O_VP + 2 * 2 * 128 * 512, O_END = O_VS + 2 * 32 * 64 * 512;
constexpr size_t MiB = 1u << 20;
constexpr size_t WS_BAR = 768 * 1024, WS_W = 1 * MiB, WS_PB = 54 * MiB, WS_NB = 63 * MiB, WS_BIG = 99 * MiB, WS_X = 207 * MiB, WS_NB2 = 279 * MiB, WS_END = 315 * MiB;
constexpr size_t W_GU1 = 0, W_D1 = W_GU1 + (size_t)5632 * 1024, W_IM = W_D1 + (size_t)1024 * 2816, W_IG = W_IM + (size_t)2560 * 1024,
                 W_CA = W_IG + (size_t)3072 * 1024, W_SB = W_CA + 524288, W_PC = W_SB + 524288, W_PBD = W_PC + 524288, W_O = W_PBD + 262144,
                 W_GU2 = W_O + 1048576, W_D2 = W_GU2 + (size_t)5632 * 1024, W_PG = W_D2 + (size_t)1024 * 2816, W_PE = W_PG + 1048576,
                 W_WS = W_PE + 262144, W_TOTAL = W_WS + 65536;
static_assert(W_TOTAL * 2 <= 53 * MiB, "weight region");
constexpr int LDS_BYTES = 147456;

typedef __bf16 bf16x2_t __attribute__((ext_vector_type(2)));
__device__ __forceinline__ unsigned cvt_pk_bf16(float lo, float hi) { bf16x2_t v; v[0] = (__bf16)lo; v[1] = (__bf16)hi; return __builtin_bit_cast(unsigned, v); }
__device__ __forceinline__ bf16_t f2bf(float f) { return (bf16_t)(cvt_pk_bf16(f, 0.f) & 0xffffu); }
__device__ __forceinline__ float bf2f(bf16_t b) { return __uint_as_float(((unsigned)b) << 16); }
__device__ __forceinline__ float bflo(unsigned w) { return __uint_as_float(w << 16); }
__device__ __forceinline__ float bfhi(unsigned w) { return __uint_as_float(w & 0xffff0000u); }
__device__ __forceinline__ float sigmoidf_(float x) { return __builtin_amdgcn_rcpf(1.0f + __builtin_amdgcn_exp2f(-1.4426950408889634f * x)); }
__device__ __forceinline__ float wave_sum(float v) {
#pragma unroll
    for (int o = 32; o > 0; o >>= 1) v += __shfl_xor(v, o);
    return v;
}
__device__ __forceinline__ void unpack8(const u32x4 w, float (&x)[8]) {
    x[0] = bflo(w.x); x[1] = bfhi(w.x); x[2] = bflo(w.y); x[3] = bfhi(w.y); x[4] = bflo(w.z); x[5] = bfhi(w.z); x[6] = bflo(w.w); x[7] = bfhi(w.w);
}
__device__ __forceinline__ u32x4 pack8(const float (&x)[8]) {
    u32x4 w; w.x = cvt_pk_bf16(x[0], x[1]); w.y = cvt_pk_bf16(x[2], x[3]); w.z = cvt_pk_bf16(x[4], x[5]); w.w = cvt_pk_bf16(x[6], x[7]); return w;
}

#define HANDOFF_STORE(v, rsrc, off, samel2) do { if (samel2) __builtin_amdgcn_raw_buffer_store_b128((v), (rsrc), (off), 0, 0); else __builtin_amdgcn_raw_buffer_store_b128((v), (rsrc), (off), 0, 16); } while (0)
#define SAME_L2(ldsbase) (__builtin_amdgcn_readfirstlane((int)*(volatile LAS unsigned*)((ldsbase) + LDS_BYTES - 4)) != 0)

namespace pg8 {
constexpr int BM = 256, BK = 64, HALF = 128, HTB = HALF * BK * 2, STAGE_BYTES = 8 * HTB, NXCD = 8, WGM = 8;
__device__ __forceinline__ int lds_byte(int r, int c) { const int st = (r >> 4) * 2 + (c >> 5), rr = r & 15, cc = c & 31, ob = rr * 64 + cc * 2; return st * 1024 + (ob ^ (((ob >> 9) & 1) << 5)); }
__device__ __forceinline__ void stage_rc(int b, int& R, int& C) { const int st = b / 1024, sb = b % 1024, swz = sb ^ (((sb >> 9) & 1) << 5); R = (st >> 1) * 16 + swz / 64; C = (st & 1) * 32 + (swz % 64) / 2; }
__device__ __forceinline__ int perm32(int rho) { const int n = rho >> 4, i = rho & 15; return 8 * (i >> 2) + 4 * n + (i & 3); }

struct Unit { int pm, pn, pass; };
struct Gemm { const bf16_t* A0; const bf16_t* A1; const bf16_t* A2; const bf16_t* B0; const bf16_t* B1; const bf16_t* B2; };
template <int N_, int NPASS>
struct Sched {
    static constexpr int nM = 18432 / BM, nN = N_ / BM, nwg = nM * nN;
    __device__ __forceinline__ static bool next(int i, int G, int c, Unit& u) {
        const int ti = i / NPASS; u.pass = i - ti * NPASS;
        const int L = ti * G + c; if (L >= nwg) return false;
        int wgid = L; { constexpr int q = nwg / NXCD, r = nwg % NXCD; const int xcd = wgid % NXCD, off = wgid / NXCD; wgid = (xcd < r ? xcd * (q + 1) : r * (q + 1) + (xcd - r) * q) + off; }
        constexpr int nig = WGM * nN; const int gid = wgid / nig, fm = gid * WGM, gsz = (nM - fm) < WGM ? (nM - fm) : WGM;
        u.pm = fm + ((wgid % nig) % gsz); u.pn = (wgid % nig) / gsz; return true;
    }
};
template <class Epi, int N_, int K, int NPASS, bool ALIGN_EPI, bool SP2, bool ONE = false>
__device__ __forceinline__ void gemm_phase(LAS unsigned char* lds, int tid_in, const Gemm g, const Epi& E, int one_pm = 0, int one_pn = 0) {
    typedef Sched<N_, NPASS> S;
#define PG8_NEXT(i, u) (ONE ? ((i) < NPASS ? ((u).pm = one_pm, (u).pn = one_pn, (u).pass = (i), true) : false) : S::next((i), sG, sC, (u)))
    int tid_ = tid_in; asm volatile("" : "+v"(tid_));
    const int tid = tid_, wid = __builtin_amdgcn_readfirstlane(tid >> 6), lane = tid & 63, wr = wid >> 2, wc = wid & 3, fr = lane & 15, fq = lane >> 4;
    constexpr int nt = K / BK;
    unsigned voffA[2], voffB[2];
#pragma unroll
    for (int i = 0; i < 2; ++i) { int R, C; stage_rc(tid * 16 + i * 8192, R, C); const int Rb = (R & ~31) + perm32(R & 31);
        voffA[i] = (unsigned)(R * K + C) * 2u; voffB[i] = (unsigned)(Rb * K + C) * 2u; }
    constexpr size_t kstep = (size_t)(BK * 2);
    constexpr size_t hstep = (size_t)HALF * K * 2;
    constexpr size_t tstep = 2 * hstep;
    const unsigned ldsw = (unsigned)wid * 1024u;
    const int aoff = lds_byte(wr * 64 + fr, fq * 8), boff = lds_byte(wc * 32 + fr, fq * 8);
#define PG8_SA(b, h) (((b) * 2 + (h)) * HTB)
#define PG8_SB(b, h) ((4 + (b) * 2 + (h)) * HTB)
#define PG8_STAGE(bufoff, gbase, voff) do { _Pragma("unroll") for (int _i = 0; _i < 2; ++_i) \
        __builtin_amdgcn_global_load_lds((const unsigned*)((const char*)(gbase) + (voff)[_i]), (LAS unsigned*)(lds + (bufoff) + ldsw + _i * 8192), 16, 0, 0); } while (0)
#define PG8_LDA(dst, b, h) do { _Pragma("unroll") for (int m = 0; m < 4; ++m) _Pragma("unroll") for (int k = 0; k < 2; ++k) dst[m][k] = *(const LAS bf16x8*)(lds + PG8_SA(b, h) + aoff + m * 2048 + k * 1024); } while (0)
#define PG8_LDB(dst, b, h) do { _Pragma("unroll") for (int n = 0; n < 2; ++n) _Pragma("unroll") for (int k = 0; k < 2; ++k) dst[n][k] = *(const LAS bf16x8*)(lds + PG8_SB(b, h) + boff + n * 2048 + k * 1024); } while (0)
#define PG8_MMA(ai, bj, At, Bt) do { __builtin_amdgcn_s_setprio(1); _Pragma("unroll") for (int m = 0; m < 4; ++m) _Pragma("unroll") for (int n = 0; n < 2; ++n) _Pragma("unroll") for (int k = 0; k < 2; ++k) \
        acc[ai][bj][m][n] = __builtin_amdgcn_mfma_f32_16x16x32_bf16(Bt[n][k], At[m][k], acc[ai][bj][m][n], 0, 0, 0); __builtin_amdgcn_s_setprio(0); } while (0)
#define PG8_WAIT_V(n) asm volatile("s_waitcnt vmcnt(" #n ")" ::: "memory")
#define PG8_WAIT_L(n) asm volatile("s_waitcnt lgkmcnt(" #n ")" ::: "memory")
#define PG8_BAR __builtin_amdgcn_s_barrier()
#define PG8_SCHED __builtin_amdgcn_sched_barrier(0)
#define PG8_ABASE(u) ((const char*)((u).pass == 0 ? g.A0 : ((u).pass == 1 ? g.A1 : g.A2)))
#define PG8_BBASE(u) ((const char*)((u).pass == 0 ? g.B0 : ((u).pass == 1 ? g.B1 : g.B2)))
    Unit cur, nxt; int ui = 0;
    int sG = (int)gridDim.x, sC = (int)__builtin_amdgcn_readfirstlane((int)*(volatile LAS unsigned*)(lds + LDS_BYTES - 8)); asm volatile("" : "+s"(sG), "+s"(sC));
    if (!PG8_NEXT(0, cur)) return;
    f32x4 acc[2][2][4][2];
#pragma unroll
    for (int a = 0; a < 2; ++a)
#pragma unroll
        for (int b = 0; b < 2; ++b)
#pragma unroll
            for (int m = 0; m < 4; ++m)
#pragma unroll
                for (int n = 0; n < 2; ++n) acc[a][b][m][n] = (f32x4){0.f, 0.f, 0.f, 0.f};
    bf16x8 At[4][2], B0[2][2], B1[2][2];
    const char* cA = PG8_ABASE(cur) + (size_t)cur.pm * tstep; const char* cB = PG8_BBASE(cur) + (size_t)cur.pn * tstep;
    if constexpr (SP2) {
        PG8_STAGE(PG8_SB(0, 0), cB, voffB); PG8_STAGE(PG8_SB(0, 1), cB + hstep, voffB); PG8_STAGE(PG8_SA(0, 0), cA, voffA); PG8_STAGE(PG8_SA(0, 1), cA + hstep, voffA);
        if (wr == 1) PG8_BAR;
        PG8_WAIT_V(2); PG8_BAR;
        PG8_STAGE(PG8_SB(1, 0), cB + kstep, voffB); PG8_STAGE(PG8_SA(1, 0), cA + kstep, voffA); PG8_STAGE(PG8_SB(1, 1), cB + hstep + kstep, voffB);
        PG8_WAIT_V(6); PG8_BAR;
    } else {
        PG8_STAGE(PG8_SB(0, 0), cB, voffB); PG8_STAGE(PG8_SA(0, 0), cA, voffA); PG8_STAGE(PG8_SB(0, 1), cB + hstep, voffB); PG8_STAGE(PG8_SA(0, 1), cA + hstep, voffA);
        if (wr == 1) PG8_BAR;
        PG8_WAIT_V(4); PG8_BAR;
        PG8_STAGE(PG8_SB(1, 0), cB + kstep, voffB); PG8_STAGE(PG8_SA(1, 0), cA + kstep, voffA); PG8_STAGE(PG8_SB(1, 1), cB + hstep + kstep, voffB);
        PG8_WAIT_V(6); PG8_BAR;
    }
    for (;;) {
        const bool has_next = PG8_NEXT(ui + 1, nxt);
        const char* nA = has_next ? PG8_ABASE(nxt) + (size_t)nxt.pm * tstep : cA; const char* nB = has_next ? PG8_BBASE(nxt) + (size_t)nxt.pn * tstep : cB;
#pragma unroll 1
        for (int t = 0; t < nt; t += 2) {
            const bool last = (t == nt - 2);
            const char* a1 = cA + (size_t)(t + 1) * kstep;
            const char* a2 = last ? nA : cA + (size_t)(t + 2) * kstep; const char* b2 = last ? nB : cB + (size_t)(t + 2) * kstep;
            const char* a3 = a2 + kstep; const char* b3 = b2 + kstep;
            if constexpr (SP2) {
            PG8_LDB(B0, 0, 0); PG8_LDB(B1, 0, 1); PG8_SCHED; PG8_LDA(At, 0, 0); PG8_STAGE(PG8_SA(1, 1), a1 + hstep, voffA);
            PG8_WAIT_V(8); PG8_WAIT_L(0); PG8_BAR; PG8_MMA(0, 0, At, B0); PG8_MMA(0, 1, At, B1); PG8_BAR; PG8_SCHED;
            PG8_LDA(At, 0, 1); PG8_STAGE(PG8_SB(0, 0), b2, voffB); PG8_STAGE(PG8_SB(0, 1), b2 + hstep, voffB); PG8_STAGE(PG8_SA(0, 0), a2, voffA);
            PG8_WAIT_V(8); PG8_WAIT_L(0); PG8_BAR; PG8_MMA(1, 0, At, B0); PG8_MMA(1, 1, At, B1); PG8_BAR; PG8_SCHED;
            PG8_LDB(B0, 1, 0); PG8_LDB(B1, 1, 1); PG8_SCHED; PG8_LDA(At, 1, 0); PG8_STAGE(PG8_SA(0, 1), a2 + hstep, voffA);
            PG8_WAIT_V(8); PG8_WAIT_L(0); PG8_BAR; PG8_MMA(0, 0, At, B0); PG8_MMA(0, 1, At, B1); PG8_BAR; PG8_SCHED;
            PG8_LDA(At, 1, 1); PG8_STAGE(PG8_SB(1, 0), b3, voffB); PG8_STAGE(PG8_SB(1, 1), b3 + hstep, voffB); PG8_STAGE(PG8_SA(1, 0), a3, voffA);
            PG8_WAIT_V(8); PG8_WAIT_L(0); PG8_BAR; PG8_MMA(1, 0, At, B0); PG8_MMA(1, 1, At, B1); PG8_BAR; PG8_SCHED;
            } else {
            PG8_LDB(B0, 0, 0); PG8_SCHED; PG8_LDA(At, 0, 0); PG8_STAGE(PG8_SA(1, 1), a1 + hstep, voffA);
            PG8_WAIT_L(8); PG8_BAR; PG8_WAIT_L(0); PG8_MMA(0, 0, At, B0); PG8_BAR; PG8_SCHED;
            PG8_LDB(B1, 0, 1); PG8_STAGE(PG8_SB(0, 0), b2, voffB);
            PG8_BAR; PG8_WAIT_L(0); PG8_MMA(0, 1, At, B1); PG8_BAR;
            PG8_LDA(At, 0, 1); PG8_STAGE(PG8_SA(0, 0), a2, voffA);
            PG8_BAR; PG8_WAIT_L(0); PG8_MMA(1, 0, At, B0); PG8_BAR; PG8_SCHED;
            PG8_STAGE(PG8_SB(0, 1), b2 + hstep, voffB);
            PG8_WAIT_V(6); PG8_BAR; PG8_MMA(1, 1, At, B1); PG8_BAR;
            PG8_LDB(B0, 1, 0); PG8_SCHED; PG8_LDA(At, 1, 0); PG8_STAGE(PG8_SA(0, 1), a2 + hstep, voffA);
            PG8_WAIT_L(8); PG8_BAR; PG8_WAIT_L(0); PG8_MMA(0, 0, At, B0); PG8_BAR; PG8_SCHED;
            PG8_LDB(B1, 1, 1); PG8_STAGE(PG8_SB(1, 0), b3, voffB);
            PG8_BAR; PG8_WAIT_L(0); PG8_MMA(0, 1, At, B1); PG8_BAR;
            PG8_LDA(At, 1, 1); PG8_STAGE(PG8_SA(1, 0), a3, voffA);
            PG8_BAR; PG8_WAIT_L(0); PG8_MMA(1, 0, At, B0); PG8_BAR; PG8_SCHED;
            PG8_STAGE(PG8_SB(1, 1), b3 + hstep, voffB);
            PG8_WAIT_V(6); PG8_BAR; PG8_MMA(1, 1, At, B1); PG8_BAR;
            }
        }
        if constexpr (ALIGN_EPI) { if (wr == 0) PG8_BAR; }
        E(acc, cur, wr, wc, fr, fq);
        if (!has_next) break;
        if (nxt.pass == 0) {
#pragma unroll
        for (int a = 0; a < 2; ++a)
#pragma unroll
            for (int b = 0; b < 2; ++b)
#pragma unroll
                for (int m = 0; m < 4; ++m)
#pragma unroll
                    for (int n = 0; n < 2; ++n) acc[a][b][m][n] = (f32x4){0.f, 0.f, 0.f, 0.f};
        }
        cur = nxt; cA = nA; cB = nB; ++ui;
        if constexpr (ALIGN_EPI) { if (wr == 1) PG8_BAR; }
    }
    PG8_WAIT_V(0);
    if constexpr (!ALIGN_EPI) { if (wr == 0) PG8_BAR; }
    PG8_BAR;
#undef PG8_SA
#undef PG8_SB
#undef PG8_STAGE
#undef PG8_LDA
#undef PG8_LDB
#undef PG8_MMA
#undef PG8_WAIT_V
#undef PG8_WAIT_L
#undef PG8_BAR
#undef PG8_SCHED
#undef PG8_ABASE
#undef PG8_BBASE
#undef PG8_NEXT
}

typedef f32x4 (&AccRef)[2][2][4][2];
#define EPI_ROW(u, ai, m) ((u).pm * BM + (ai) * HALF + wr * 64 + (m) * 16 + fr)
#define EPI_COLW (wc * 32 + fq * 8)

#define EPI_RS(ss, row) __builtin_amdgcn_rsqf((ss)[row] * (1.0f / 1024.0f) + 1e-6f)
struct EpiGU {
    bf16_t* O; int ldo; const float* ss;
    __device__ __forceinline__ void operator()(AccRef acc, const Unit& u, int wr, int wc, int fr, int fq) const {
#pragma unroll
        for (int ai = 0; ai < 2; ++ai)
#pragma unroll
            for (int m = 0; m < 4; ++m) {
                const int row = EPI_ROW(u, ai, m); const float rs = EPI_RS(ss, row);
                bf16_t* p = O + (size_t)row * ldo + u.pn * 128 + EPI_COLW;
                float h[8];
#pragma unroll
                for (int n = 0; n < 2; ++n)
#pragma unroll
                    for (int j = 0; j < 4; ++j) { const float gt = rs * acc[ai][0][m][n][j], up = rs * acc[ai][1][m][n][j]; h[n * 4 + j] = gt * sigmoidf_(gt) * up; }
                *(u32x4*)p = pack8(h);
            }
    }
};
struct EpiWinMix {
    bf16_t* Z; const float* ss;
    __device__ __forceinline__ void operator()(AccRef acc, const Unit& u, int wr, int wc, int fr, int fq) const {
        if (u.pn < 4) {
#pragma unroll
            for (int ai = 0; ai < 2; ++ai)
#pragma unroll
                for (int m = 0; m < 4; ++m) {
                    const int row = EPI_ROW(u, ai, m); const float rs = EPI_RS(ss, row);
                    bf16_t* p = Z + (size_t)row * ZMW + u.pn * 128 + EPI_COLW;
                    float h[8];
#pragma unroll
                    for (int n = 0; n < 2; ++n)
#pragma unroll
                        for (int j = 0; j < 4; ++j) h[n * 4 + j] = rs * acc[ai][0][m][n][j] * sigmoidf_(rs * acc[ai][1][m][n][j]);
                    *(u32x4*)p = pack8(h);
                }
        } else {
#pragma unroll
            for (int ai = 0; ai < 2; ++ai)
#pragma unroll
                for (int m = 0; m < 4; ++m) {
                    const int row = EPI_ROW(u, ai, m); const float rs = EPI_RS(ss, row);
                    bf16_t* p = Z + (size_t)row * ZMW + 512 + (u.pn - 4) * 256 + EPI_COLW;
#pragma unroll
                    for (int bj = 0; bj < 2; ++bj) {
                        float h[8];
#pragma unroll
                        for (int n = 0; n < 2; ++n)
#pragma unroll
                            for (int j = 0; j < 4; ++j) h[n * 4 + j] = rs * acc[ai][bj][m][n][j];
                        *(u32x4*)(p + bj * HALF) = pack8(h);
                    }
                }
        }
    }
};
struct EpiGates {
    bf16_t* Z; const float* bias; const float* ss;
    __device__ __forceinline__ void operator()(AccRef acc, const Unit& u, int wr, int wc, int fr, int fq) const {
        const int col0 = u.pn * 256 + EPI_COLW;
        f32x4 bv[2][2];
#pragma unroll
        for (int bj = 0; bj < 2; ++bj)
#pragma unroll
            for (int n = 0; n < 2; ++n) bv[bj][n] = *(const f32x4*)(bias + col0 + bj * HALF + n * 4);
#pragma unroll
        for (int ai = 0; ai < 2; ++ai)
#pragma unroll
            for (int m = 0; m < 4; ++m) {
                const int row = EPI_ROW(u, ai, m); const float rs = EPI_RS(ss, row);
                bf16_t* p = Z + (size_t)row * ZGW + col0;
#pragma unroll
                for (int bj = 0; bj < 2; ++bj) {
                    float h[8];
#pragma unroll
                    for (int n = 0; n < 2; ++n)
#pragma unroll
                        for (int j = 0; j < 4; ++j) h[n * 4 + j] = sigmoidf_(rs * acc[ai][bj][m][n][j] + bv[bj][n][j]);
                    *(u32x4*)(p + bj * HALF) = pack8(h);
                }
            }
    }
};
struct EpiScale {
    bf16_t* O; int ldo; const float* scale;
    __device__ __forceinline__ void operator()(AccRef acc, const Unit& u, int wr, int wc, int fr, int fq) const {
        const int col0 = u.pn * 256 + EPI_COLW;
        f32x4 bv[2][2];
#pragma unroll
        for (int bj = 0; bj < 2; ++bj)
#pragma unroll
            for (int n = 0; n < 2; ++n) bv[bj][n] = *(const f32x4*)(scale + col0 + bj * HALF + n * 4);
#pragma unroll
        for (int ai = 0; ai < 2; ++ai)
#pragma unroll
            for (int m = 0; m < 4; ++m) {
                bf16_t* p = O + (size_t)EPI_ROW(u, ai, m) * ldo + col0;
#pragma unroll
                for (int bj = 0; bj < 2; ++bj) {
                    float h[8];
#pragma unroll
                    for (int n = 0; n < 2; ++n)
#pragma unroll
                        for (int j = 0; j < 4; ++j) h[n * 4 + j] = acc[ai][bj][m][n][j] * bv[bj][n][j];
                    *(u32x4*)(p + bj * HALF) = pack8(h);
                }
            }
    }
};
struct EpiRes {
    float* H; bf16_t* NBo; float* sso; float s, sw;
    __device__ __forceinline__ void operator()(AccRef acc, const Unit& u, int wr, int wc, int fr, int fq) const {
        const int col0 = u.pn * 256 + EPI_COLW;
#pragma unroll
        for (int ai = 0; ai < 2; ++ai)
#pragma unroll
            for (int m = 0; m < 4; ++m) {
                const int row = EPI_ROW(u, ai, m);
                float* p = H + (size_t)row * D + col0;
                float q = 0.f;
#pragma unroll
                for (int bj = 0; bj < 2; ++bj) {
                    float h[8];
#pragma unroll
                    for (int n = 0; n < 2; ++n) { f32x4* qp = (f32x4*)(p + bj * HALF + n * 4); f32x4 v = *qp; v += acc[ai][bj][m][n] * s; *qp = v;
#pragma unroll
                        for (int j = 0; j < 4; ++j) { h[n * 4 + j] = v[j]; q += v[j] * v[j]; } }
                    *(u32x4*)(NBo + (size_t)row * D + col0 + bj * HALF) = pack8(h);
                }
                q += __shfl_xor(q, 16); q += __shfl_xor(q, 32);
                if (fq == 0) atomicAdd(sso + row, q * sw);
            }
    }
};
struct EpiT {
    float* T;
    __device__ __forceinline__ void operator()(AccRef acc, const Unit& u, int wr, int wc, int fr, int fq) const {
        const int col0 = u.pn * 256 + EPI_COLW;
#pragma unroll
        for (int ai = 0; ai < 2; ++ai)
#pragma unroll
            for (int m = 0; m < 4; ++m) {
                float* p = T + (size_t)EPI_ROW(u, ai, m) * D + col0;
#pragma unroll
                for (int bj = 0; bj < 2; ++bj)
#pragma unroll
                    for (int n = 0; n < 2; ++n) *(f32x4*)(p + bj * HALF + n * 4) = acc[ai][bj][m][n];
            }
    }
};
struct EpiPE {
    float* H; const float* T; float s; const float* ss; bf16_t* NBo; float* sso;
    __device__ __forceinline__ void operator()(AccRef acc, const Unit& u, int wr, int wc, int fr, int fq) const {
        const int col0 = u.pn * 256 + EPI_COLW;
#pragma unroll
        for (int ai = 0; ai < 2; ++ai)
#pragma unroll
            for (int m = 0; m < 4; ++m) {
                const int row = EPI_ROW(u, ai, m); const float rs = EPI_RS(ss, row);
                const size_t off = (size_t)row * D + col0;
                float q = 0.f;
#pragma unroll
                for (int bj = 0; bj < 2; ++bj) {
                    float h[8], t8[8];
                    unpack8(*(const u32x4*)((const bf16_t*)T + off + bj * HALF), t8);
#pragma unroll
                    for (int n = 0; n < 2; ++n) {
                        f32x4* qp = (f32x4*)(H + off + bj * HALF + n * 4); f32x4 v = *qp;
#pragma unroll
                        for (int j = 0; j < 4; ++j) { v[j] += s * sigmoidf_(rs * acc[ai][bj][m][n][j]) * t8[n * 4 + j]; h[n * 4 + j] = v[j]; q += v[j] * v[j]; }
                        *qp = v;
                    }
                    if (NBo) *(u32x4*)(NBo + off + bj * HALF) = pack8(h);
                }
                q += __shfl_xor(q, 16); q += __shfl_xor(q, 32);
                if (fq == 0) atomicAdd(sso + row, q * s);
            }
    }
};
struct EpiMerge {
    const bf16_t* ZG; bf16_t* O;
    __device__ __forceinline__ void operator()(AccRef acc, const Unit& u, int wr, int wc, int fr, int fq) const {
        const int col0 = u.pn * 256 + EPI_COLW;
#pragma unroll
        for (int ai = 0; ai < 2; ++ai)
#pragma unroll
            for (int m = 0; m < 4; ++m) {
                const size_t row = (size_t)EPI_ROW(u, ai, m);
                const bf16_t* gp = ZG + row * ZGW + u.pass * 1024 + col0;
#pragma unroll
                for (int bj = 0; bj < 2; ++bj) {
                    float g0[8], f[8];
                    unpack8(*(const u32x4*)(gp + bj * HALF), g0);
                    if (u.pass < 2) {
                        float g1[8]; unpack8(*(const u32x4*)(gp + 1024 + bj * HALF), g1);
#pragma unroll
                        for (int e = 0; e < 8; ++e) f[e] = fmaxf(g0[e], 1e-30f) * __builtin_amdgcn_rcpf(fmaxf(g1[e], 1e-30f));
                    } else {
#pragma unroll
                        for (int e = 0; e < 8; ++e) f[e] = fmaxf(g0[e], 1e-30f);
                    }
#pragma unroll
                    for (int n = 0; n < 2; ++n)
#pragma unroll
                        for (int j = 0; j < 4; ++j) acc[ai][bj][m][n][j] *= f[n * 4 + j];
                    if (u.pass == 2) {
                        float h[8];
#pragma unroll
                        for (int n = 0; n < 2; ++n)
#pragma unroll
                            for (int j = 0; j < 4; ++j) h[n * 4 + j] = acc[ai][bj][m][n][j];
                        *(u32x4*)(O + row * D + col0 + bj * HALF) = pack8(h);
                    }
                }
            }
    }
};

struct EpiMergeWT {
    const bf16_t* ZG; bf16_t* O; unsigned* cntM; int samel2;
    __device__ __forceinline__ void operator()(AccRef acc, const Unit& u, int wr, int wc, int fr, int fq) const {
        const int col0 = u.pn * 256 + EPI_COLW;
        const __amdgpu_buffer_rsrc_t rm = __builtin_amdgcn_make_buffer_rsrc((void*)O, 0, (int)((size_t)18432 * D * 2), 0x00020000);
#pragma unroll
        for (int ai = 0; ai < 2; ++ai)
#pragma unroll
            for (int m = 0; m < 4; ++m) {
                const size_t row = (size_t)EPI_ROW(u, ai, m);
                const bf16_t* gp = ZG + row * ZGW + u.pass * 1024 + col0;
#pragma unroll
                for (int bj = 0; bj < 2; ++bj) {
                    float g0[8], f[8];
                    unpack8(*(const u32x4*)(gp + bj * HALF), g0);
                    if (u.pass < 2) {
                        float g1[8]; unpack8(*(const u32x4*)(gp + 1024 + bj * HALF), g1);
#pragma unroll
                        for (int e = 0; e < 8; ++e) f[e] = fmaxf(g0[e], 1e-30f) * __builtin_amdgcn_rcpf(fmaxf(g1[e], 1e-30f));
                    } else {
#pragma unroll
                        for (int e = 0; e < 8; ++e) f[e] = fmaxf(g0[e], 1e-30f);
                    }
#pragma unroll
                    for (int n = 0; n < 2; ++n)
#pragma unroll
                        for (int j = 0; j < 4; ++j) acc[ai][bj][m][n][j] *= f[n * 4 + j];
                    if (u.pass == 2) {
                        float h[8];
#pragma unroll
                        for (int n = 0; n < 2; ++n)
#pragma unroll
                            for (int j = 0; j < 4; ++j) h[n * 4 + j] = acc[ai][bj][m][n][j];
                        HANDOFF_STORE(pack8(h), rm, (unsigned)((row * D + col0 + bj * HALF) * 2), samel2);
                    }
                }
            }
        if (u.pass == 2) {
            asm volatile("s_waitcnt vmcnt(0)" ::: "memory");
            if ((threadIdx.x & 63) == 0) (void)__hip_atomic_fetch_add(cntM + 16 * u.pm, 1u, __ATOMIC_RELAXED, __HIP_MEMORY_SCOPE_AGENT);
        }
    }
};

struct FfnUnit { int kind, pm, pn; };
__device__ __forceinline__ bool ffn_next(int i, int G, int c, bool pe, FfnUnit& u) {
    if (G == 256) {
        const int x = c & 7, vc = c >> 3;
        const int ngu = vc < 4 ? 4 : (vc < 18 ? 7 : 6), ndn = vc < 4 ? 2 : 1;
        if (i < ngu) {
            const int t = i < 4 ? 32 * i + vc : (i < 6 ? 128 + 28 * (i - 4) + (vc - 4) : 184 + (vc - 4));
            u.kind = 0;
            if (t < 88) { u.pm = 9 * x + (t & 3); u.pn = t >> 2; }
            else if (t < 176) { u.pm = 9 * x + 4 + ((t - 88) & 3); u.pn = (t - 88) >> 2; }
            else { u.pm = 9 * x + 8; u.pn = t - 176; }
            return true;
        }
        const int k = i - ngu;
        if (k < ndn) { const int d = vc < 4 ? 4 * k + vc : (vc < 18 ? 22 + (vc - 4) : 8 + (vc - 18));
            u.kind = 1; u.pm = 9 * x + (d >> 2); u.pn = d & 3; return true; }
        if (!pe || vc < 18) return false;
        const int e = (vc - 18) + 14 * (k - ndn); if (k - ndn >= 3 || e >= 36) return false;
        u.kind = 2; u.pm = 9 * x + (e >> 2); u.pn = e & 3; return true;
    }
    const int ngu = (1584 - c + G - 1) / G;
    if (i < ngu) { const int t = i * G + c; u.kind = 0; u.pm = t / 22; u.pn = t - 22 * u.pm; return true; }
    const int ndn = (288 - c + G - 1) / G, i1 = i - ngu;
    if (i1 < ndn) { const int t = i1 * G + c; u.kind = 1; u.pm = t >> 2; u.pn = t & 3; return true; }
    if (!pe) return false;
    const int t = (i1 - ndn) * G + c; if (t >= 288) return false;
    u.kind = 2; u.pm = t >> 2; u.pn = t & 3; return true;
}
struct FfnArgs { const bf16_t* Agu; const bf16_t* Bgu; bf16_t* HID; const bf16_t* Bdn; const float* ss_in; float* H; bf16_t* NBo; float* sso; unsigned* cnt; const float* x0; const float* x1; const bf16_t* Ape; const bf16_t* Bpe; float* T; float s, sw; };

__device__ __forceinline__ void ffn_phase(LAS unsigned char* lds, int tid_in, const FfnArgs& fa) {
    int tid_ = tid_in; asm volatile("" : "+v"(tid_));
    const int tid = tid_, wid = __builtin_amdgcn_readfirstlane(tid >> 6), lane = tid & 63, wr = wid >> 2, wc = wid & 3, fr = lane & 15, fq = lane >> 4;
    constexpr int K0 = 1024, K1 = 2816, K2 = 256;
    const bool pe = fa.Ape != nullptr;
    unsigned vA[3][2], vB[3][2];
#pragma unroll
    for (int i = 0; i < 2; ++i) { int R, C; stage_rc(tid * 16 + i * 8192, R, C); const int Rb = (R & ~31) + perm32(R & 31);
        vA[0][i] = (unsigned)(R * K0 + C) * 2u; vB[0][i] = (unsigned)(Rb * K0 + C) * 2u; vA[1][i] = (unsigned)(R * K1 + C) * 2u; vB[1][i] = (unsigned)(Rb * K1 + C) * 2u; vA[2][i] = (unsigned)(R * K2 + C) * 2u; vB[2][i] = (unsigned)(Rb * K2 + C) * 2u; }
    constexpr size_t kstep = (size_t)(BK * 2);
    const unsigned ldsw = (unsigned)wid * 1024u;
    const int aoff = lds_byte(wr * 64 + fr, fq * 8), boff = lds_byte(wc * 32 + fr, fq * 8);
#define PG8_SA(b, h) (((b) * 2 + (h)) * HTB)
#define PG8_SB(b, h) ((4 + (b) * 2 + (h)) * HTB)
#define PG8_STAGE(bufoff, gbase, v0, v1) do { \
        __builtin_amdgcn_global_load_lds((const unsigned*)((const char*)(gbase) + (v0)), (LAS unsigned*)(lds + (bufoff) + ldsw), 16, 0, 0); \
        __builtin_amdgcn_global_load_lds((const unsigned*)((const char*)(gbase) + (v1)), (LAS unsigned*)(lds + (bufoff) + ldsw + 8192), 16, 0, 0); } while (0)
#define PG8_LDA(dst, b, h) do { _Pragma("unroll") for (int m = 0; m < 4; ++m) _Pragma("unroll") for (int k = 0; k < 2; ++k) dst[m][k] = *(const LAS bf16x8*)(lds + PG8_SA(b, h) + aoff + m * 2048 + k * 1024); } while (0)
#define PG8_LDB(dst, b, h) do { _Pragma("unroll") for (int n = 0; n < 2; ++n) _Pragma("unroll") for (int k = 0; k < 2; ++k) dst[n][k] = *(const LAS bf16x8*)(lds + PG8_SB(b, h) + boff + n * 2048 + k * 1024); } while (0)
#define PG8_MMA(ai, bj, At, Bt) do { __builtin_amdgcn_s_setprio(1); _Pragma("unroll") for (int m = 0; m < 4; ++m) _Pragma("unroll") for (int n = 0; n < 2; ++n) _Pragma("unroll") for (int k = 0; k < 2; ++k) \
        acc[ai][bj][m][n] = __builtin_amdgcn_mfma_f32_16x16x32_bf16(Bt[n][k], At[m][k], acc[ai][bj][m][n], 0, 0, 0); __builtin_amdgcn_s_setprio(0); } while (0)
#define PG8_WAIT_V(n) asm volatile("s_waitcnt vmcnt(" #n ")" ::: "memory")
#define PG8_WAIT_L(n) asm volatile("s_waitcnt lgkmcnt(" #n ")" ::: "memory")
#define PG8_BAR __builtin_amdgcn_s_barrier()
#define PG8_SCHED __builtin_amdgcn_sched_barrier(0)
#define FFN_READY(u) do { if ((u).kind == 1) { \
        if (wid == 0) { unsigned* w_ = fa.cnt + 16 * (u).pm; unsigned sp_ = 0; \
            while ((unsigned)__builtin_amdgcn_readfirstlane(__hip_atomic_load(w_, __ATOMIC_RELAXED, __HIP_MEMORY_SCOPE_AGENT)) < 176u) { __builtin_amdgcn_s_sleep(2); if (++sp_ > (1u << 24)) break; } \
            __builtin_amdgcn_fence(__ATOMIC_ACQUIRE, "agent"); asm volatile("s_waitcnt vmcnt(0)" ::: "memory"); } \
        asm volatile("" ::: "memory"); __builtin_amdgcn_s_barrier(); asm volatile("" ::: "memory"); } } while (0)
    int sG = (int)gridDim.x, sC = (int)__builtin_amdgcn_readfirstlane((int)*(volatile LAS unsigned*)(lds + LDS_BYTES - 8)); asm volatile("" : "+s"(sG), "+s"(sC));
    FfnUnit cur, nxt; int ui = 0;
    if (!ffn_next(0, sG, sC, pe, cur)) return;
    f32x4 acc[2][2][4][2];
    bf16x8 At[4][2], B0[2][2], B1[2][2];
#define FFN_K(u) ((u).kind == 0 ? K0 : ((u).kind == 1 ? K1 : K2))
#define FFN_UA(u) ((const char*)((u).kind == 0 ? fa.Agu : ((u).kind == 1 ? (const bf16_t*)fa.HID : fa.Ape)) + (size_t)(u).pm * (size_t)(256 * 2) * FFN_K(u))
#define FFN_UB(u) ((const char*)((u).kind == 0 ? fa.Bgu : ((u).kind == 1 ? fa.Bdn : fa.Bpe)) + (size_t)(u).pn * (size_t)(256 * 2) * FFN_K(u))
#define FFN_V(arr, u, i) ((u).kind == 0 ? arr[0][i] : ((u).kind == 1 ? arr[1][i] : arr[2][i]))
    for (;;) {
#pragma unroll
    for (int a = 0; a < 2; ++a)
#pragma unroll
        for (int b = 0; b < 2; ++b)
#pragma unroll
            for (int m = 0; m < 4; ++m)
#pragma unroll
                for (int n = 0; n < 2; ++n) acc[a][b][m][n] = (f32x4){0.f, 0.f, 0.f, 0.f};
    const char* cA = FFN_UA(cur); const char* cB = FFN_UB(cur);
    size_t chs = (size_t)HALF * 2 * FFN_K(cur);
    unsigned cvA0 = FFN_V(vA, cur, 0), cvA1 = FFN_V(vA, cur, 1), cvB0 = FFN_V(vB, cur, 0), cvB1 = FFN_V(vB, cur, 1);
    int nt = FFN_K(cur) / BK;
    FFN_READY(cur);
    PG8_STAGE(PG8_SB(0, 0), cB, cvB0, cvB1); PG8_STAGE(PG8_SB(0, 1), cB + chs, cvB0, cvB1); PG8_STAGE(PG8_SA(0, 0), cA, cvA0, cvA1); PG8_STAGE(PG8_SA(0, 1), cA + chs, cvA0, cvA1);
    if (wr == 1) PG8_BAR;
    PG8_WAIT_V(2); PG8_BAR;
    PG8_STAGE(PG8_SB(1, 0), cB + kstep, cvB0, cvB1); PG8_STAGE(PG8_SA(1, 0), cA + kstep, cvA0, cvA1); PG8_STAGE(PG8_SB(1, 1), cB + chs + kstep, cvB0, cvB1);
    PG8_WAIT_V(6); PG8_BAR;
    for (;;) {
        bool has_next = ffn_next(ui + 1, sG, sC, pe, nxt);
        if (has_next && nxt.kind != cur.kind) has_next = false;
        if (!has_next) nxt = cur;
        const char* nA = FFN_UA(nxt); const char* nB = FFN_UB(nxt);
        const size_t nhs = (size_t)HALF * 2 * FFN_K(nxt);
        const unsigned nvA0 = FFN_V(vA, nxt, 0), nvA1 = FFN_V(vA, nxt, 1), nvB0 = FFN_V(vB, nxt, 0), nvB1 = FFN_V(vB, nxt, 1);
#pragma unroll 1
        for (int t = 0; t < nt; t += 2) {
            const bool last = (t == nt - 2);
            const char* a1 = cA + (size_t)(t + 1) * kstep;
            const char* a2 = last ? nA : cA + (size_t)(t + 2) * kstep; const char* b2 = last ? nB : cB + (size_t)(t + 2) * kstep;
            const char* a3 = a2 + kstep; const char* b3 = b2 + kstep;
            const size_t hs2 = last ? nhs : chs;
            const unsigned sA0 = last ? nvA0 : cvA0, sA1 = last ? nvA1 : cvA1, sB0 = last ? nvB0 : cvB0, sB1 = last ? nvB1 : cvB1;
            if (last && has_next) FFN_READY(nxt);
            PG8_LDB(B0, 0, 0); PG8_LDB(B1, 0, 1); PG8_SCHED; PG8_LDA(At, 0, 0); PG8_STAGE(PG8_SA(1, 1), a1 + chs, cvA0, cvA1);
            PG8_WAIT_V(8); PG8_WAIT_L(0); PG8_BAR; PG8_MMA(0, 0, At, B0); PG8_MMA(0, 1, At, B1); PG8_BAR; PG8_SCHED;
            PG8_LDA(At, 0, 1); PG8_STAGE(PG8_SB(0, 0), b2, sB0, sB1); PG8_STAGE(PG8_SB(0, 1), b2 + hs2, sB0, sB1); PG8_STAGE(PG8_SA(0, 0), a2, sA0, sA1);
            PG8_WAIT_V(8); PG8_WAIT_L(0); PG8_BAR; PG8_MMA(1, 0, At, B0); PG8_MMA(1, 1, At, B1); PG8_BAR; PG8_SCHED;
            PG8_LDB(B0, 1, 0); PG8_LDB(B1, 1, 1); PG8_SCHED; PG8_LDA(At, 1, 0); PG8_STAGE(PG8_SA(0, 1), a2 + hs2, sA0, sA1);
            PG8_WAIT_V(8); PG8_WAIT_L(0); PG8_BAR; PG8_MMA(0, 0, At, B0); PG8_MMA(0, 1, At, B1); PG8_BAR; PG8_SCHED;
            PG8_LDA(At, 1, 1); PG8_STAGE(PG8_SB(1, 0), b3, sB0, sB1); PG8_STAGE(PG8_SB(1, 1), b3 + hs2, sB0, sB1); PG8_STAGE(PG8_SA(1, 0), a3, sA0, sA1);
            PG8_WAIT_V(8); PG8_WAIT_L(0); PG8_BAR; PG8_MMA(1, 0, At, B0); PG8_MMA(1, 1, At, B1); PG8_BAR; PG8_SCHED;
        }
        if (wr == 0) PG8_BAR;
        if (cur.kind == 0) {
            const bool samel2 = SAME_L2(lds);
            const __amdgpu_buffer_rsrc_t hrs = __builtin_amdgcn_make_buffer_rsrc((void*)fa.HID, 0, (int)((size_t)18432 * 2816 * 2), 0x00020000);
#pragma unroll
            for (int ai = 0; ai < 2; ++ai)
#pragma unroll
                for (int m = 0; m < 4; ++m) {
                    const int row = cur.pm * BM + ai * HALF + wr * 64 + m * 16 + fr; const float rs = EPI_RS(fa.ss_in, row);
                    typedef float f32x2 __attribute__((ext_vector_type(2)));
                    u32x4 hw;
#pragma unroll
                    for (int n = 0; n < 2; ++n)
#pragma unroll
                        for (int jp = 0; jp < 2; ++jp) {
                            f32x2 gv = {acc[ai][0][m][n][2 * jp], acc[ai][0][m][n][2 * jp + 1]}, uv = {acc[ai][1][m][n][2 * jp], acc[ai][1][m][n][2 * jp + 1]};
                            gv *= rs; uv *= rs;
                            const f32x2 ar = gv * (-1.4426950408889634f);
                            f32x2 ev; ev.x = __builtin_amdgcn_exp2f(ar.x); ev.y = __builtin_amdgcn_exp2f(ar.y);
                            const f32x2 dv = ev + 1.0f;
                            f32x2 rv; rv.x = __builtin_amdgcn_rcpf(dv.x); rv.y = __builtin_amdgcn_rcpf(dv.y);
                            const f32x2 hv = (gv * uv) * rv;
                            hw[n * 2 + jp] = cvt_pk_bf16(hv.x, hv.y);
                        }
                    HANDOFF_STORE(hw, hrs, (unsigned)(((size_t)row * 2816 + cur.pn * 128 + wc * 32 + fq * 8) * 2), samel2);
                }
            asm volatile("s_waitcnt vmcnt(0)" ::: "memory");
            if (lane == 0) (void)__hip_atomic_fetch_add(fa.cnt + 16 * cur.pm, 1u, __ATOMIC_RELAXED, __HIP_MEMORY_SCOPE_AGENT);
        } else if (cur.kind == 2) {
            const int col0 = cur.pn * 256 + wc * 32 + fq * 8;
#pragma unroll
            for (int ai = 0; ai < 2; ++ai)
#pragma unroll
                for (int m = 0; m < 4; ++m) {
                    bf16_t* p = (bf16_t*)fa.T + (size_t)(cur.pm * BM + ai * HALF + wr * 64 + m * 16 + fr) * D + col0;
#pragma unroll
                    for (int bj = 0; bj < 2; ++bj) {
                        float h[8];
#pragma unroll
                        for (int n = 0; n < 2; ++n)
#pragma unroll
                            for (int j = 0; j < 4; ++j) h[n * 4 + j] = acc[ai][bj][m][n][j];
                        *(u32x4*)(p + bj * HALF) = pack8(h);
                    }
                }
        } else {
            const int col0 = cur.pn * 256 + wc * 32 + fq * 8;
#pragma unroll
            for (int ai = 0; ai < 2; ++ai)
#pragma unroll
                for (int m = 0; m < 4; ++m) {
                    const int row = cur.pm * BM + ai * HALF + wr * 64 + m * 16 + fr;
                    float* p = fa.H + (size_t)row * D + col0;
                    const float* rp = fa.x0 ? (row < MP ? fa.x0 + (size_t)row * D : fa.x1 + (size_t)(row - MP) * D) + col0 : p;
                    float q = 0.f;
#pragma unroll
                    for (int bj = 0; bj < 2; ++bj) {
                        float h[8];
#pragma unroll
                        for (int n = 0; n < 2; ++n) { f32x4* qp = (f32x4*)(p + bj * HALF + n * 4); f32x4 v = *(const f32x4*)(rp + bj * HALF + n * 4); v += acc[ai][bj][m][n] * fa.s; *qp = v;
#pragma unroll
                            for (int j = 0; j < 4; ++j) { h[n * 4 + j] = v[j]; q += v[j] * v[j]; } }
                        *(u32x4*)(fa.NBo + (size_t)row * D + col0 + bj * HALF) = pack8(h);
                    }
                    q += __shfl_xor(q, 16); q += __shfl_xor(q, 32);
                    if (fq == 0) atomicAdd(fa.sso + row, q * fa.sw);
                }
        }
        if (!has_next) break;
#pragma unroll
        for (int a = 0; a < 2; ++a)
#pragma unroll
            for (int b = 0; b < 2; ++b)
#pragma unroll
                for (int m = 0; m < 4; ++m)
#pragma unroll
                    for (int n = 0; n < 2; ++n) acc[a][b][m][n] = (f32x4){0.f, 0.f, 0.f, 0.f};
        cur = nxt; cA = nA; cB = nB; chs = nhs; cvA0 = nvA0; cvA1 = nvA1; cvB0 = nvB0; cvB1 = nvB1; nt = FFN_K(cur) / BK; ++ui;
        if (wr == 1) PG8_BAR;
    }
    PG8_WAIT_V(0);
    PG8_BAR;
    ++ui; if (!ffn_next(ui, sG, sC, pe, cur)) break;
    }
#undef PG8_SA
#undef PG8_SB
#undef PG8_STAGE
#undef PG8_LDA
#undef PG8_LDB
#undef PG8_MMA
#undef PG8_WAIT_V
#undef PG8_WAIT_L
#undef PG8_BAR
#undef PG8_SCHED
#undef FFN_READY
#undef FFN_UA
#undef FFN_UB
#undef FFN_K
#undef FFN_V
}

constexpr int TAIL_MAXU = 8;
__device__ const unsigned short TAIL_SCHED[32][TAIL_MAXU] = {
    {0x100,0x20,0x44,0x62,0x7a,0x262,0x360,0xffff},
    {0x101,0x21,0x45,0x63,0x7b,0x263,0x361,0xffff},
    {0x110,0x22,0x46,0x64,0x230,0x320,0xffff,0xffff},
    {0x111,0x23,0x47,0x65,0x231,0x321,0xffff,0xffff},
    {0x0,0x28,0x202,0x86,0x280,0x380,0xffff,0xffff},
    {0x1,0x29,0x203,0x87,0x281,0x381,0xffff,0xffff},
    {0x2,0x2a,0x50,0x180,0x232,0x322,0xffff,0xffff},
    {0x3,0x2b,0x51,0x181,0x233,0x323,0xffff,0xffff},
    {0x4,0x140,0x48,0x66,0x80,0x270,0x362,0xffff},
    {0x5,0x141,0x49,0x67,0x81,0x271,0x363,0xffff},
    {0x6,0x30,0x52,0x220,0x282,0x382,0xffff,0xffff},
    {0x7,0x31,0x53,0x221,0x283,0x383,0xffff,0xffff},
    {0x8,0x32,0x54,0x222,0x302,0x370,0xffff,0xffff},
    {0x9,0x33,0x55,0x223,0x303,0x371,0xffff,0xffff},
    {0xa,0x34,0x56,0x70,0x240,0x330,0xffff,0xffff},
    {0xb,0x35,0x57,0x71,0x241,0x331,0xffff,0xffff},
    {0x120,0x24,0x4a,0x68,0x82,0x272,0x372,0xffff},
    {0x121,0x25,0x4b,0x69,0x83,0x273,0x373,0xffff},
    {0x10,0x36,0x58,0x72,0x242,0x332,0xffff,0xffff},
    {0x11,0x37,0x59,0x73,0x243,0x333,0xffff,0xffff},
    {0x12,0x38,0x5a,0x74,0x250,0x340,0xffff,0xffff},
    {0x13,0x39,0x5b,0x75,0x251,0x341,0xffff,0xffff},
    {0x14,0x3a,0x170,0x6a,0x84,0x300,0x350,0xffff},
    {0x15,0x3b,0x171,0x6b,0x85,0x301,0x351,0xffff},
    {0x16,0x150,0x160,0x60,0x76,0x252,0x342,0xffff},
    {0x17,0x151,0x161,0x61,0x77,0x253,0x343,0xffff},
    {0x18,0x40,0x210,0x88,0x310,0xffff,0xffff,0xffff},
    {0x19,0x41,0x211,0x89,0x311,0xffff,0xffff,0xffff},
    {0x1a,0x42,0x212,0x8a,0x312,0xffff,0xffff,0xffff},
    {0x1b,0x43,0x213,0x8b,0x313,0xffff,0xffff,0xffff},
    {0x130,0x26,0x200,0x78,0x260,0x352,0xffff,0xffff},
    {0x131,0x27,0x201,0x79,0x261,0x353,0xffff,0xffff}
};

struct TU { int kind, pass, pm, pn; };
__device__ __forceinline__ bool tail_unit(int i, int G, int c, TU& u) {
    u.pass = 0;
    if (G == 256) {
        if (i >= TAIL_MAXU) return false;
        const unsigned e = TAIL_SCHED[c >> 3][i]; if (e == 0xffffu) return false;
        u.kind = (int)(e >> 8); u.pm = 9 * (c & 7) + (int)((e >> 4) & 15u); u.pn = (int)(e & 15u); return true;
    }
    const int n0 = (1008 - c + G - 1) / G;
    if (i < n0) { const int t = i * G + c; if (t < 864) { u.kind = 0; u.pm = t / 12; u.pn = t - 12 * u.pm; } else { u.kind = 1; u.pm = (t - 864) >> 1; u.pn = (t - 864) & 1; } return true; }
    const int n1 = (288 - c + G - 1) / G; const int i1 = i - n0;
    if (i1 < n1) { const int t = i1 * G + c; u.kind = 2; u.pm = t >> 2; u.pn = t & 3; return true; }
    const int t = (i1 - n1) * G + c; if (t >= 288) return false;
    u.kind = 3; u.pm = t >> 2; u.pn = t & 3; return true;
}
struct TailArgs { unsigned char* ws; float* H; const float* gbias; const float* pscale; const float* ss_in; float* sso; unsigned* cntA; unsigned* cntM; float s; };

__device__ __forceinline__ void tail_phase(LAS unsigned char* lds, int tid_in, const TailArgs& ta) {
    int tid_ = tid_in; asm volatile("" : "+v"(tid_));
    const int tid = tid_, wid = __builtin_amdgcn_readfirstlane(tid >> 6), lane = tid & 63, wr = wid >> 2, wc = wid & 3, fr = lane & 15, fq = lane >> 4;
    constexpr int K0 = 1024, K1 = 512;
    constexpr size_t kstep = (size_t)(BK * 2);
    const unsigned ldsw = (unsigned)wid * 1024u;
#define PG8_SA(b, h) (((b) * 2 + (h)) * HTB)
#define PG8_SB(b, h) ((4 + (b) * 2 + (h)) * HTB)
#define PG8_STAGE(bufoff, gbase, v0, v1) do { \
        __builtin_amdgcn_global_load_lds((const unsigned*)((const char*)(gbase) + (v0)), (LAS unsigned*)(lds + (bufoff) + ldsw), 16, 0, 0); \
        __builtin_amdgcn_global_load_lds((const unsigned*)((const char*)(gbase) + (v1)), (LAS unsigned*)(lds + (bufoff) + ldsw + 8192), 16, 0, 0); } while (0)
#define PG8_LDA(dst, b, h) do { _Pragma("unroll") for (int m = 0; m < 4; ++m) _Pragma("unroll") for (int k = 0; k < 2; ++k) dst[m][k] = *(const LAS bf16x8*)(lds + PG8_SA(b, h) + aoff + m * 2048 + k * 1024); } while (0)
#define PG8_LDB(dst, b, h) do { _Pragma("unroll") for (int n = 0; n < 2; ++n) _Pragma("unroll") for (int k = 0; k < 2; ++k) dst[n][k] = *(const LAS bf16x8*)(lds + PG8_SB(b, h) + boff + n * 2048 + k * 1024); } while (0)
#define PG8_MMA(ai, bj, At, Bt) do { __builtin_amdgcn_s_setprio(1); _Pragma("unroll") for (int m = 0; m < 4; ++m) _Pragma("unroll") for (int n = 0; n < 2; ++n) _Pragma("unroll") for (int k = 0; k < 2; ++k) \
        acc[ai][bj][m][n] = __builtin_amdgcn_mfma_f32_16x16x32_bf16(Bt[n][k], At[m][k], acc[ai][bj][m][n], 0, 0, 0); __builtin_amdgcn_s_setprio(0); } while (0)
#define PG8_WAIT_V(n) asm volatile("s_waitcnt vmcnt(" #n ")" ::: "memory")
#define PG8_WAIT_L(n) asm volatile("s_waitcnt lgkmcnt(" #n ")" ::: "memory")
#define PG8_BAR __builtin_amdgcn_s_barrier()
#define PG8_SCHED __builtin_amdgcn_sched_barrier(0)
#define TL_DEP(u) (((u).kind == 2 && (u).pass == 0) || (u).kind == 3)
#define TL_READY(u) do { if (TL_DEP(u)) { \
        if (wid == 0) { unsigned* w_ = ((u).kind == 2 ? ta.cntA : ta.cntM) + 16 * (u).pm; const unsigned need_ = (u).kind == 2 ? 112u : 32u; unsigned sp_ = 0; \
            while ((unsigned)__builtin_amdgcn_readfirstlane(__hip_atomic_load(w_, __ATOMIC_RELAXED, __HIP_MEMORY_SCOPE_AGENT)) < need_) { __builtin_amdgcn_s_sleep(2); if (++sp_ > (1u << 24)) break; } \
            __builtin_amdgcn_fence(__ATOMIC_ACQUIRE, "agent"); asm volatile("s_waitcnt vmcnt(0)" ::: "memory"); } \
        asm volatile("" ::: "memory"); __builtin_amdgcn_s_barrier(); asm volatile("" ::: "memory"); } } while (0)
#define TL_K(u) (((u).kind == 0 || (u).kind == 3) ? K0 : K1)
#define TL_ABASE(u) ((const char*)ta.ws + ((u).kind == 0 ? WS_NB : (u).kind == 1 ? WS_X + 2 * XSZ : (u).kind == 3 ? WS_NB2 : ((u).pass == 0 ? WS_X : (u).pass == 1 ? WS_X + XSZ : WS_X + 3 * XSZ)))
#define TL_BBASE(u) ((const char*)ta.ws + WS_W + 2 * ((u).kind == 0 ? W_IG : (u).kind == 1 ? W_PBD : (u).kind == 3 ? W_O : ((u).pass == 0 ? W_CA : (u).pass == 1 ? W_SB : W_PC)))
#define TL_UA(u) (TL_ABASE(u) + (size_t)(u).pm * (size_t)(256 * 2) * TL_K(u))
#define TL_UB(u) (TL_BBASE(u) + (size_t)(u).pn * (size_t)(256 * 2) * TL_K(u))
    constexpr size_t XSZ = (size_t)18432 * 512 * 2;
    int sG = (int)gridDim.x, sC = (int)__builtin_amdgcn_readfirstlane((int)*(volatile LAS unsigned*)(lds + LDS_BYTES - 8)); asm volatile("" : "+s"(sG), "+s"(sC));
    TU cur, nxt; int ui = 0;
    if (!tail_unit(0, sG, sC, cur)) return;
    f32x4 acc[2][2][4][2];
    bf16x8 At[4][2], B0[2][2], B1[2][2];
    for (;;) {
    if (cur.kind == 2) {
        TL_READY(cur);
        { const Gemm g{(const bf16_t*)(ta.ws + WS_X), (const bf16_t*)(ta.ws + WS_X + XSZ), (const bf16_t*)(ta.ws + WS_X + 3 * XSZ),
                       (const bf16_t*)(ta.ws + WS_W) + W_CA, (const bf16_t*)(ta.ws + WS_W) + W_SB, (const bf16_t*)(ta.ws + WS_W) + W_PC};
          const EpiMergeWT E{(const bf16_t*)(ta.ws + WS_BIG), (bf16_t*)(ta.ws + WS_NB2), ta.cntM, (int)SAME_L2(lds)};
          int tm_; asm volatile("v_mbcnt_lo_u32_b32 %0, -1, 0\n\tv_mbcnt_hi_u32_b32 %0, -1, %0" : "=v"(tm_));
          gemm_phase<EpiMergeWT, D, 512, 3, true, true, true>(lds, tm_ + wid * 64, g, E, cur.pm, cur.pn); }
        ++ui; if (!tail_unit(ui, sG, sC, cur)) break;
        continue;
    }
    int tl_; asm volatile("v_mbcnt_lo_u32_b32 %0, -1, 0\n\tv_mbcnt_hi_u32_b32 %0, -1, %0" : "=v"(tl_)); tl_ += wid * 64;
    unsigned vA[2][2], vB[2][2];
#pragma unroll
    for (int i = 0; i < 2; ++i) { int R, C; stage_rc(tl_ * 16 + i * 8192, R, C); const int Rb = (R & ~31) + perm32(R & 31);
        vA[0][i] = (unsigned)(R * K0 + C) * 2u; vB[0][i] = (unsigned)(Rb * K0 + C) * 2u; vA[1][i] = (unsigned)(R * K1 + C) * 2u; vB[1][i] = (unsigned)(Rb * K1 + C) * 2u; }
    const int aoff = lds_byte(wr * 64 + (tl_ & 15), ((tl_ & 63) >> 4) * 8), boff = lds_byte(wc * 32 + (tl_ & 15), ((tl_ & 63) >> 4) * 8);
#pragma unroll
    for (int a = 0; a < 2; ++a)
#pragma unroll
        for (int b = 0; b < 2; ++b)
#pragma unroll
            for (int m = 0; m < 4; ++m)
#pragma unroll
                for (int n = 0; n < 2; ++n) acc[a][b][m][n] = (f32x4){0.f, 0.f, 0.f, 0.f};
    const char* cA = TL_UA(cur); const char* cB = TL_UB(cur);
    size_t chs = (size_t)HALF * 2 * TL_K(cur);
    bool ck = TL_K(cur) == K1;
    unsigned cvA0 = ck ? vA[1][0] : vA[0][0], cvA1 = ck ? vA[1][1] : vA[0][1], cvB0 = ck ? vB[1][0] : vB[0][0], cvB1 = ck ? vB[1][1] : vB[0][1];
    int nt = TL_K(cur) / BK;
    TL_READY(cur);
    PG8_STAGE(PG8_SB(0, 0), cB, cvB0, cvB1); PG8_STAGE(PG8_SB(0, 1), cB + chs, cvB0, cvB1); PG8_STAGE(PG8_SA(0, 0), cA, cvA0, cvA1); PG8_STAGE(PG8_SA(0, 1), cA + chs, cvA0, cvA1);
    if (wr == 1) PG8_BAR;
    PG8_WAIT_V(2); PG8_BAR;
    PG8_STAGE(PG8_SB(1, 0), cB + kstep, cvB0, cvB1); PG8_STAGE(PG8_SA(1, 0), cA + kstep, cvA0, cvA1); PG8_STAGE(PG8_SB(1, 1), cB + chs + kstep, cvB0, cvB1);
    PG8_WAIT_V(6); PG8_BAR;
    bool more;
    for (;;) {
        more = tail_unit(ui + 1, sG, sC, nxt);
        const bool has_next = more && !TL_DEP(nxt);
        if (!has_next) nxt = cur;
        const char* nA = TL_UA(nxt); const char* nB = TL_UB(nxt);
        const size_t nhs = (size_t)HALF * 2 * TL_K(nxt);
        const bool nk = TL_K(nxt) == K1;
        const unsigned nvA0 = nk ? vA[1][0] : vA[0][0], nvA1 = nk ? vA[1][1] : vA[0][1], nvB0 = nk ? vB[1][0] : vB[0][0], nvB1 = nk ? vB[1][1] : vB[0][1];
#pragma unroll 1
        for (int t = 0; t < nt; t += 2) {
            const bool last = (t == nt - 2);
            const char* a1 = cA + (size_t)(t + 1) * kstep;
            const char* a2 = last ? nA : cA + (size_t)(t + 2) * kstep; const char* b2 = last ? nB : cB + (size_t)(t + 2) * kstep;
            const char* a3 = a2 + kstep; const char* b3 = b2 + kstep;
            const size_t hs2 = last ? nhs : chs;
            const unsigned sA0 = last ? nvA0 : cvA0, sA1 = last ? nvA1 : cvA1, sB0 = last ? nvB0 : cvB0, sB1 = last ? nvB1 : cvB1;
            PG8_LDB(B0, 0, 0); PG8_LDB(B1, 0, 1); PG8_SCHED; PG8_LDA(At, 0, 0); PG8_STAGE(PG8_SA(1, 1), a1 + chs, cvA0, cvA1);
            PG8_WAIT_V(8); PG8_WAIT_L(0); PG8_BAR; PG8_MMA(0, 0, At, B0); PG8_MMA(0, 1, At, B1); PG8_BAR; PG8_SCHED;
            PG8_LDA(At, 0, 1); PG8_STAGE(PG8_SB(0, 0), b2, sB0, sB1); PG8_STAGE(PG8_SB(0, 1), b2 + hs2, sB0, sB1); PG8_STAGE(PG8_SA(0, 0), a2, sA0, sA1);
            PG8_WAIT_V(8); PG8_WAIT_L(0); PG8_BAR; PG8_MMA(1, 0, At, B0); PG8_MMA(1, 1, At, B1); PG8_BAR; PG8_SCHED;
            PG8_LDB(B0, 1, 0); PG8_LDB(B1, 1, 1); PG8_SCHED; PG8_LDA(At, 1, 0); PG8_STAGE(PG8_SA(0, 1), a2 + hs2, sA0, sA1);
            PG8_WAIT_V(8); PG8_WAIT_L(0); PG8_BAR; PG8_MMA(0, 0, At, B0); PG8_MMA(0, 1, At, B1); PG8_BAR; PG8_SCHED;
            PG8_LDA(At, 1, 1); PG8_STAGE(PG8_SB(1, 0), b3, sB0, sB1); PG8_STAGE(PG8_SB(1, 1), b3 + hs2, sB0, sB1); PG8_STAGE(PG8_SA(1, 0), a3, sA0, sA1);
            PG8_WAIT_V(8); PG8_WAIT_L(0); PG8_BAR; PG8_MMA(1, 0, At, B0); PG8_MMA(1, 1, At, B1); PG8_BAR; PG8_SCHED;
        }
        if (wr == 0) PG8_BAR;
        const int colw = wc * 32 + fq * 8;
        if (cur.kind == 0) {
            const bool samel2 = SAME_L2(lds);
            const __amdgpu_buffer_rsrc_t rz = __builtin_amdgcn_make_buffer_rsrc((void*)(ta.ws + WS_BIG), 0, (int)((size_t)18432 * ZGW * 2), 0x00020000);
            const int col0 = cur.pn * 256 + colw;
#pragma unroll
            for (int ai = 0; ai < 2; ++ai)
#pragma unroll
                for (int m = 0; m < 4; ++m) {
                    const int row = cur.pm * BM + ai * HALF + wr * 64 + m * 16 + fr; const float rs = EPI_RS(ta.ss_in, row);
#pragma unroll
                    for (int bj = 0; bj < 2; ++bj) {
                        float h[8];
#pragma unroll
                        for (int n = 0; n < 2; ++n)
#pragma unroll
                            for (int j = 0; j < 4; ++j) h[n * 4 + j] = sigmoidf_(rs * acc[ai][bj][m][n][j] + ta.gbias[col0 + bj * HALF + n * 4 + j]);
                        HANDOFF_STORE(pack8(h), rz, (unsigned)(((size_t)row * ZGW + col0 + bj * HALF) * 2), samel2);
                    }
                    asm volatile("" ::: "memory");
                }
            asm volatile("s_waitcnt vmcnt(0)" ::: "memory");
            if (lane == 0) (void)__hip_atomic_fetch_add(ta.cntA + 16 * cur.pm, 1u, __ATOMIC_RELAXED, __HIP_MEMORY_SCOPE_AGENT);
        } else if (cur.kind == 1) {
            const bool samel2 = SAME_L2(lds);
            const __amdgpu_buffer_rsrc_t rx = __builtin_amdgcn_make_buffer_rsrc((void*)(ta.ws + WS_X + 3 * XSZ), 0, (int)XSZ, 0x00020000);
            const int col0 = cur.pn * 256 + colw;
#pragma unroll
            for (int ai = 0; ai < 2; ++ai)
#pragma unroll
                for (int m = 0; m < 4; ++m) {
                    const int row = cur.pm * BM + ai * HALF + wr * 64 + m * 16 + fr;
#pragma unroll
                    for (int bj = 0; bj < 2; ++bj) {
                        float h[8];
#pragma unroll
                        for (int n = 0; n < 2; ++n)
#pragma unroll
                            for (int j = 0; j < 4; ++j) h[n * 4 + j] = acc[ai][bj][m][n][j] * ta.pscale[col0 + bj * HALF + n * 4 + j];
                        HANDOFF_STORE(pack8(h), rx, (unsigned)(((size_t)row * XW + col0 + bj * HALF) * 2), samel2);
                    }
                    asm volatile("" ::: "memory");
                }
            asm volatile("s_waitcnt vmcnt(0)" ::: "memory");
            if (lane == 0) (void)__hip_atomic_fetch_add(ta.cntA + 16 * cur.pm, 1u, __ATOMIC_RELAXED, __HIP_MEMORY_SCOPE_AGENT);
        } else {
            const int col0 = cur.pn * 256 + colw;
            bf16_t* NBo = (bf16_t*)(ta.ws + WS_NB);
#pragma unroll
            for (int ai = 0; ai < 2; ++ai)
#pragma unroll
                for (int m = 0; m < 4; ++m) {
                    const int row = cur.pm * BM + ai * HALF + wr * 64 + m * 16 + fr;
                    float* p = ta.H + (size_t)row * D + col0;
                    float q = 0.f;
#pragma unroll
                    for (int bj = 0; bj < 2; ++bj) {
                        float h[8];
#pragma unroll
                        for (int n = 0; n < 2; ++n) { f32x4* qp = (f32x4*)(p + bj * HALF + n * 4); f32x4 v = *qp; v += acc[ai][bj][m][n] * ta.s; *qp = v;
#pragma unroll
                            for (int j = 0; j < 4; ++j) { h[n * 4 + j] = v[j]; q += v[j] * v[j]; } }
                        *(u32x4*)(NBo + (size_t)row * D + col0 + bj * HALF) = pack8(h);
                    }
                    q += __shfl_xor(q, 16); q += __shfl_xor(q, 32);
                    if (fq == 0) atomicAdd(ta.sso + row, q * ta.s);
                    asm volatile("" ::: "memory");
                }
        }
        if (!has_next) break;
        {
#pragma unroll
        for (int a = 0; a < 2; ++a)
#pragma unroll
            for (int b = 0; b < 2; ++b)
#pragma unroll
                for (int m = 0; m < 4; ++m)
#pragma unroll
                    for (int n = 0; n < 2; ++n) acc[a][b][m][n] = (f32x4){0.f, 0.f, 0.f, 0.f};
        }
        ++ui;
        cur = nxt; cA = nA; cB = nB; chs = nhs; cvA0 = nvA0; cvA1 = nvA1; cvB0 = nvB0; cvB1 = nvB1; nt = TL_K(cur) / BK;
        if (wr == 1) PG8_BAR;
    }
    PG8_WAIT_V(0);
    PG8_BAR;
    if (!more) break;
    ++ui; tail_unit(ui, sG, sC, cur);
    }
#undef PG8_SA
#undef PG8_SB
#undef PG8_STAGE
#undef PG8_LDA
#undef PG8_LDB
#undef PG8_MMA
#undef PG8_WAIT_V
#undef PG8_WAIT_L
#undef PG8_BAR
#undef PG8_SCHED
#undef TL_DEP
#undef TL_READY
#undef TL_K
#undef TL_ABASE
#undef TL_BBASE
#undef TL_UA
#undef TL_UB
}
}

struct Args { const float* in[35]; float* out; unsigned char* ws; int ph_lo, ph_hi; };
static_assert(sizeof(Args) == 35 * 8 + 8 + 8 + 8, "Args has no padding");

typedef const Args __attribute__((address_space(4)))* ArgsP;
__device__ __forceinline__ ArgsP get_args() { ArgsP p = (ArgsP)__builtin_amdgcn_kernarg_segment_ptr(); asm volatile("" : "+s"(p)); return p; }
struct Ctx {
    LAS unsigned char* lds;
    int tid, lane, wave, gw, nW, bx, gx;
    float* H; float* SS; bf16_t* W; bf16_t* PB; bf16_t* NB; bf16_t* NB2; unsigned char* BIG; bf16_t* XA; bf16_t* XB; bf16_t* XD; bf16_t* XC;
};

__device__ __forceinline__ const float* x_row(ArgsP a, int r) { return r < MP ? a->in[0] + (size_t)r * D : a->in[1] + (size_t)(r - MP) * D; }
__device__ __forceinline__ const float* p_row(const float* pp, const float* ps, int L, int r) { return r < MP ? pp + ((size_t)L * MP + r) * DPLE : ps + ((size_t)L * MS + (r - MP)) * DPLE; }

template <int MODE>
__device__ __forceinline__ void norm_phase(const Ctx& c, const float* gain) {
    const int lane = c.lane;
    ArgsP ap = get_args();
    if (MODE == 0) { for (size_t i = (size_t)c.bx * 512 + c.tid; i < (size_t)8 * M; i += (size_t)c.gx * 512) c.SS[M + i] = 0.f; }
    f32x4 gv[4];
#pragma unroll
    for (int i = 0; i < 4; ++i) gv[i] = (MODE == 2) ? *(const f32x4*)(gain + i * 256 + lane * 4) : (f32x4){1.f, 1.f, 1.f, 1.f};
    for (int r = c.gw; r < M; r += c.nW) {
        const float* src = (MODE == 0) ? x_row(ap, r) : c.H + (size_t)r * D;
        f32x4 v[4]; float ss = 0.f;
#pragma unroll
        for (int i = 0; i < 4; ++i) { v[i] = *(const f32x4*)(src + i * 256 + lane * 4); ss += v[i][0] * v[i][0] + v[i][1] * v[i][1] + v[i][2] * v[i][2] + v[i][3] * v[i][3]; }
        if (MODE == 0) {
            ss = wave_sum(ss);
            if (lane == 0) c.SS[r] = ss;
#pragma unroll
            for (int i = 0; i < 4; ++i) {
                u32x2 w; w.x = cvt_pk_bf16(v[i][0], v[i][1]); w.y = cvt_pk_bf16(v[i][2], v[i][3]); *(u32x2*)(c.NB2 + (size_t)r * D + i * 256 + lane * 4) = w;
            }
        } else {
            const float rs = __builtin_amdgcn_rsqf(c.SS[(size_t)8 * M + r] * (1.0f / D) + EPS);
#pragma unroll
            for (int i = 0; i < 4; ++i) *(f32x4*)(c.H + (size_t)r * D + i * 256 + lane * 4) = v[i] * rs * gv[i];
        }
    }
}

__device__ __forceinline__ void prep_phase(const Ctx& c, int L, int it_lo, int it_hi, int b0, int bstride, bool do_tables) {
    ArgsP a = get_args();
    LAS unsigned* Tw = (LAS unsigned*)c.lds;
    const int tid = c.tid, lane = c.lane, wave = c.wave;
    if (b0 >= 0) for (int it = it_lo + b0; it < it_hi; it += bstride) {
        int r = it; const float* s0; const float* s1; const float* gain = nullptr; int ld, K, c0, c1, t, kc; size_t dsto;
        if (r < 352) { t = r >> 4; kc = r & 15; s0 = a->in[7] + (size_t)L * D * FF; s1 = a->in[8] + (size_t)L * D * FF; gain = a->in[6] + L * D; ld = FF; K = D; c0 = c1 = t * 128; dsto = W_GU1; }
        else if ((r -= 352) < 176) { t = r / 44; kc = r - t * 44; s0 = s1 = a->in[9] + (size_t)L * FF * D; ld = D; K = FF; c0 = t * 256; c1 = c0 + 128; dsto = W_D1; }
        else if ((r -= 176) < 160) { t = r >> 4; kc = r & 15; s0 = s1 = a->in[11] + (size_t)L * D * 5632; gain = a->in[10] + L * D; ld = 5632; K = D;
            if (t < 4) { c0 = t * 128; c1 = 512 + t * 128; } else { c0 = t * 256; c1 = c0 + 128; } dsto = W_IM; }
        else if ((r -= 160) < 192) { t = r >> 4; kc = r & 15; s0 = s1 = a->in[11] + (size_t)L * D * 5632; gain = a->in[10] + L * D; ld = 5632; K = D; c0 = 2560 + t * 256; c1 = c0 + 128; dsto = W_IG; }
        else if ((r -= 192) < 32) { t = r >> 3; kc = r & 7; s0 = s1 = a->in[17] + (size_t)L * 512 * D; ld = D; K = 512; c0 = t * 256; c1 = c0 + 128; dsto = W_CA; }
        else if ((r -= 32) < 32) { t = r >> 3; kc = r & 7; s0 = s1 = a->in[22] + (size_t)L * 512 * D; ld = D; K = 512; c0 = t * 256; c1 = c0 + 128; dsto = W_SB; }
        else if ((r -= 32) < 32) { t = r >> 3; kc = r & 7; s0 = s1 = a->in[25] + (size_t)L * 512 * D; ld = D; K = 512; c0 = t * 256; c1 = c0 + 128; dsto = W_PC; }
        else if ((r -= 32) < 64) { t = r >> 4; kc = r & 15; s0 = s1 = a->in[26] + (size_t)L * D * D; ld = D; K = D; c0 = t * 256; c1 = c0 + 128; dsto = W_O; }
        else if ((r -= 64) < 352) { t = r >> 4; kc = r & 15; s0 = a->in[28] + (size_t)L * D * FF; s1 = a->in[29] + (size_t)L * D * FF; gain = a->in[27] + L * D; ld = FF; K = D; c0 = c1 = t * 128; dsto = W_GU2; }
        else if ((r -= 352) < 176) { t = r / 44; kc = r - t * 44; s0 = s1 = a->in[30] + (size_t)L * FF * D; ld = D; K = FF; c0 = t * 256; c1 = c0 + 128; dsto = W_D2; }
        else if ((r -= 176) < 64) { t = r >> 4; kc = r & 15; s0 = s1 = a->in[32] + (size_t)L * D * D; gain = a->in[31] + L * D; ld = D; K = D; c0 = t * 256; c1 = c0 + 128; dsto = W_PG; }
        else { r -= 64; t = r >> 2; kc = r & 3; s0 = s1 = a->in[33] + (size_t)L * DPLE * D; ld = D; K = DPLE; c0 = t * 256; c1 = c0 + 128; dsto = W_PE; }
        const int k0 = kc * 64, d0 = t * 256;
        {
            const int hf = lane >> 5, c4 = (lane & 31) * 4;
            const float* sp = (hf ? s1 + c1 : s0 + c0) + (size_t)(k0 + wave * 8) * ld + c4;
            f32x4 v[8];
#pragma unroll
            for (int rr = 0; rr < 8; ++rr) v[rr] = *(const f32x4*)(sp + (size_t)rr * ld);
            if (gain) {
#pragma unroll
                for (int rr = 0; rr < 8; ++rr) v[rr] *= gain[k0 + wave * 8 + rr];
            }
            const int nb = hf * 128 + c4;
#pragma unroll
            for (int p = 0; p < 4; ++p)
#pragma unroll
                for (int i = 0; i < 4; ++i) Tw[(nb + i) * 33 + wave * 4 + p] = cvt_pk_bf16(v[2 * p][i], v[2 * p + 1][i]);
        }
        __syncthreads();
        bf16_t* dst = c.W + dsto;
        {
            const int n = tid >> 1, hk = tid & 1;
            bf16_t* dp = dst + (size_t)(d0 + n) * K + k0 + 32 * hk;
#pragma unroll
            for (int jq = 0; jq < 4; ++jq) {
                u32x4 w; w.x = Tw[n * 33 + 16 * hk + 4 * jq]; w.y = Tw[n * 33 + 16 * hk + 4 * jq + 1]; w.z = Tw[n * 33 + 16 * hk + 4 * jq + 2]; w.w = Tw[n * 33 + 16 * hk + 4 * jq + 3];
                *(u32x4*)(dp + 8 * jq) = w;
            }
        }
        __syncthreads();
    }
    if (!do_tables) return;
    if (b0 < 0) return;
    const size_t gtid = (size_t)b0 * 512 + tid, gstride = (size_t)bstride * 512;
    const float* pw = a->in[23] + (size_t)L * 4 * 128 * 128;
    for (size_t i = gtid; i < 512 * 512; i += gstride) { const int n = (int)(i >> 9), k = (int)(i & 511);
        c.W[W_PBD + i] = ((n >> 7) == (k >> 7)) ? f2bf(pw[((size_t)(n >> 7) * 128 + (k & 127)) * 128 + (n & 127)]) : (bf16_t)0; }
    const float* wsrc = a->in[20] + (size_t)L * 4 * 128 * 128;
    for (size_t i = gtid; i < 65536; i += gstride) { const int ii = (int)((i >> 7) & 127), jj = (int)(i & 127); c.W[W_WS + i] = (jj <= ii) ? f2bf(wsrc[i]) : (bf16_t)0; }
    const float* pp = a->in[2]; const float* ps = a->in[3];
    for (size_t i = gtid; i < (size_t)M * 64; i += gstride) { const int r = (int)(i >> 6), c4 = (int)(i & 63);
        const f32x4 v = *(const f32x4*)(p_row(pp, ps, L, r) + c4 * 4); u32x2 w; w.x = cvt_pk_bf16(v[0], v[1]); w.y = cvt_pk_bf16(v[2], v[3]); *(u32x2*)(c.PB + (size_t)r * DPLE + c4 * 4) = w; }
}

__device__ __forceinline__ void load_bf8(const bf16_t* p, float (&x)[8]) { unpack8(*(const u32x4*)p, x); }

#ifndef MIX_REP_SKIP
#define MIX_REP_SKIP 0
#endif
__device__ __forceinline__ void mix_phase(const Ctx& c, int L, int qsel) {
    const int skip = (qsel & 1) ? MIX_REP_SKIP : 0;
    ArgsP a = get_args();
    const bf16_t* ZM = (const bf16_t*)c.BIG;
    const int tid = c.tid, lane = c.lane, wave = c.wave, fr = lane & 15, fq = lane >> 4;
    float* out = a->out;
    unsigned* qctr = (unsigned*)(a->ws + WS_BAR) + 4096 + 128 * qsel;
    volatile LAS unsigned* qslot = (volatile LAS unsigned*)(c.lds + 65536);
    if (!(skip & 1)) for (int b = c.bx; b < 160; b += c.gx) {
        const int row0 = b < 128 ? b * 128 : MP + (b - 128) * 64, R = b < 128 ? 128 : 64;
        LAS unsigned char* vnT = c.lds;
        const float* lg = a->in[18] + L * 512; const float* lb = a->in[19] + L * 512;
        float gch[8], bch[8];
#pragma unroll
        for (int e = 0; e < 8; ++e) { gch[e] = lg[lane + 64 * e]; bch[e] = lb[lane + 64 * e]; }
        float* vout = nullptr;
        if (b < 128) { if ((b & 63) == 63) vout = out + O_VP + ((size_t)(L * 2 + (b >> 6)) * 128) * 512; }
        else vout = out + O_VS + ((size_t)(L * 32 + (b - 128)) * 64) * 512;
        for (int grp = wave; grp < 16; grp += 8) {
            const int j0 = grp * 8;
            if (j0 >= R) {
#pragma unroll
                for (int e = 0; e < 8; ++e) *(LAS u32x4*)(vnT + (lane + 64 * e) * 272 + j0 * 2) = (u32x4){0u, 0u, 0u, 0u};
                continue;
            }
            float y[8][8];
#pragma unroll
            for (int rr = 0; rr < 8; ++rr) {
                const bf16_t* vp = ZM + (size_t)(row0 + j0 + rr) * ZMW + 1024 + lane;
                float s = 0.f;
#pragma unroll
                for (int e = 0; e < 8; ++e) { y[rr][e] = bf2f(vp[64 * e]); s += y[rr][e]; }
                const float mu = wave_sum(s) * (1.0f / 512);
                float q = 0.f;
#pragma unroll
                for (int e = 0; e < 8; ++e) { y[rr][e] -= mu; q += y[rr][e] * y[rr][e]; }
                const float rstd = __builtin_amdgcn_rsqf(wave_sum(q) * (1.0f / 512) + EPS);
#pragma unroll
                for (int e = 0; e < 8; ++e) y[rr][e] = y[rr][e] * rstd * gch[e] + bch[e];
                if (vout) {
#pragma unroll
                    for (int e = 0; e < 8; ++e) vout[(size_t)(j0 + rr) * 512 + lane + 64 * e] = y[rr][e];
                }
            }
#pragma unroll
            for (int e = 0; e < 8; ++e) {
                u32x4 w; w.x = cvt_pk_bf16(y[0][e], y[1][e]); w.y = cvt_pk_bf16(y[2][e], y[3][e]); w.z = cvt_pk_bf16(y[4][e], y[5][e]); w.w = cvt_pk_bf16(y[6][e], y[7][e]);
                *(LAS u32x4*)(vnT + (lane + 64 * e) * 272 + j0 * 2) = w;
            }
        }
        __syncthreads();
        const int ib = wave * 16, nkb = (ib + 15) / 32 + 1;
        const bf16_t* WsB = c.W + W_WS;
        const float* bs = a->in[21] + L * 512;
#pragma unroll 1
        for (int g = 0; g < 4; ++g) {
            bf16x8 af[4];
#pragma unroll
            for (int kb = 0; kb < 4; ++kb) af[kb] = *(const bf16x8*)(WsB + ((size_t)g * 128 + ib + fr) * 128 + kb * 32 + fq * 8);
            float bsv[4]; bf16_t uraw[8][4];
#pragma unroll
            for (int jj = 0; jj < 4; ++jj) bsv[jj] = bs[g * 128 + ib + fq * 4 + jj];
            if (ib < R) {
#pragma unroll
                for (int ni = 0; ni < 8; ++ni)
#pragma unroll
                    for (int jj = 0; jj < 4; ++jj) uraw[ni][jj] = ZM[(size_t)(row0 + ib + fq * 4 + jj) * ZMW + 512 + g * 128 + ni * 16 + fr];
#pragma unroll
                for (int ni = 0; ni < 8; ++ni) {
                    const int col = g * 128 + ni * 16 + fr;
                    f32x4 acc = (f32x4){0.f, 0.f, 0.f, 0.f};
#pragma unroll
                    for (int kb = 0; kb < 4; ++kb) if (kb < nkb) {
                        const bf16x8 bfr = *(const LAS bf16x8*)(vnT + col * 272 + (kb * 32 + fq * 8) * 2);
                        acc = __builtin_amdgcn_mfma_f32_16x16x32_bf16(af[kb], bfr, acc, 0, 0, 0);
                    }
#pragma unroll
                    for (int jj = 0; jj < 4; ++jj) {
                        const size_t r = (size_t)(row0 + ib + fq * 4 + jj);
                        c.XB[r * XW + col] = f2bf(bf2f(uraw[ni][jj]) * (acc[jj] + bsv[jj]));
                    }
                }
            }
        }
        __syncthreads();
    }
    __syncthreads();
    {
        LAS float* wl = (LAS float*)c.lds; const float* wg = a->in[13] + (size_t)L * 31 * 512;
        for (int i = tid; i < 31 * 512 / 4; i += 512) *(LAS f32x4*)(wl + i * 4) = *(const f32x4*)(wg + i * 4);
    }
    __syncthreads();
    {
        const LAS float* wl = (const LAS float*)c.lds;
        float dwb[8], lng[8], lnb[8];
#pragma unroll
        for (int e = 0; e < 8; ++e) { dwb[e] = a->in[14][L * 512 + lane * 8 + e]; lng[e] = a->in[15][L * 512 + lane * 8 + e]; lnb[e] = a->in[16][L * 512 + lane * 8 + e]; }
        unsigned nextv = 0; int qb = M;
        if (!(skip & 2)) { if (tid == 0) *qslot = atomicAdd(qctr, 8u); __syncthreads(); qb = (int)*qslot; __syncthreads(); }
        for (;;) {
            if (qb >= M / 4) break;
            if (tid == 0) nextv = atomicAdd(qctr, 8u);
            const int qi = qb + wave;
            const int itm = qi < MS / 4 ? MP / 4 + qi : qi - MS / 4;
            const int r0 = itm * 4;
            int seq0, trel; const float* hist = nullptr;
            if (r0 < MP) { seq0 = (r0 / SEQ) * SEQ; trel = r0 - seq0; }
            else { const int s = (r0 - MP) / DSEQ; seq0 = MP + s * DSEQ; trel = r0 - seq0; hist = a->in[4] + ((size_t)(L * 32 + s) * 30) * 512; }
            if (!hist || trel >= 30) {
                float ah[2][4][4];
#pragma unroll
                for (int hf = 0; hf < 2; ++hf) {
                    const int ch = hf * 256 + lane * 4; const unsigned choff = (unsigned)ch * 2u;
                    u32x2 raw[34];
#pragma unroll
                    for (int ri = 0; ri < 34; ++ri) { const int t = trel - 30 + ri;
                        const char* rowp = (const char*)ZM + (size_t)(seq0 + (t >= 0 ? t : 0)) * (ZMW * 2);
                        const u32x2 v = *(const u32x2*)(rowp + choff);
                        raw[ri].x = (t >= 0) ? v.x : 0u; raw[ri].y = (t >= 0) ? v.y : 0u; }
#pragma unroll
                    for (int o = 0; o < 4; ++o)
#pragma unroll
                        for (int e = 0; e < 4; ++e) ah[hf][o][e] = 0.f;
                    float xq[4][4];
#pragma unroll
                    for (int i = 0; i < 3; ++i) { xq[i][0] = bflo(raw[i].x); xq[i][1] = bfhi(raw[i].x); xq[i][2] = bflo(raw[i].y); xq[i][3] = bfhi(raw[i].y); }
                    f32x4 w0 = *(const LAS f32x4*)(wl + ch);
#pragma unroll
                    for (int k = 0; k < 31; ++k) {
                        f32x4 n0 = w0;
                        if (k < 30) n0 = *(const LAS f32x4*)(wl + (k + 1) * 512 + ch);
                        { const int i = (k + 3) & 3; xq[i][0] = bflo(raw[k + 3].x); xq[i][1] = bfhi(raw[k + 3].x); xq[i][2] = bflo(raw[k + 3].y); xq[i][3] = bfhi(raw[k + 3].y); }
#pragma unroll
                        for (int o = 0; o < 4; ++o)
#pragma unroll
                            for (int e = 0; e < 4; ++e) ah[hf][o][e] += xq[(k + o) & 3][e] * w0[e];
                        w0 = n0;
                        asm volatile("" : "+v"(ah[hf][0][0]), "+v"(ah[hf][0][1]), "+v"(ah[hf][0][2]), "+v"(ah[hf][0][3]), "+v"(ah[hf][1][0]), "+v"(ah[hf][1][1]), "+v"(ah[hf][1][2]), "+v"(ah[hf][1][3]),
                                          "+v"(ah[hf][2][0]), "+v"(ah[hf][2][1]), "+v"(ah[hf][2][2]), "+v"(ah[hf][2][3]), "+v"(ah[hf][3][0]), "+v"(ah[hf][3][1]), "+v"(ah[hf][3][2]), "+v"(ah[hf][3][3]));
                    }
                }
                const float* pdb = a->in[14] + L * 512; const float* plg = a->in[15] + L * 512; const float* plb = a->in[16] + L * 512;
                f32x4 db[2], lg2[2], lb2[2];
#pragma unroll
                for (int hf = 0; hf < 2; ++hf) { db[hf] = *(const f32x4*)(pdb + hf * 256 + lane * 4); lg2[hf] = *(const f32x4*)(plg + hf * 256 + lane * 4); lb2[hf] = *(const f32x4*)(plb + hf * 256 + lane * 4); }
#pragma unroll
                for (int o = 0; o < 4; ++o) {
                    float sm = 0.f;
#pragma unroll
                    for (int hf = 0; hf < 2; ++hf)
#pragma unroll
                        for (int e = 0; e < 4; ++e) { ah[hf][o][e] += db[hf][e]; sm += ah[hf][o][e]; }
                    const float mu = wave_sum(sm) * (1.0f / 512);
                    float q = 0.f;
#pragma unroll
                    for (int hf = 0; hf < 2; ++hf)
#pragma unroll
                        for (int e = 0; e < 4; ++e) { ah[hf][o][e] -= mu; q += ah[hf][o][e] * ah[hf][o][e]; }
                    const float rstd = __builtin_amdgcn_rsqf(wave_sum(q) * (1.0f / 512) + EPS);
#pragma unroll
                    for (int hf = 0; hf < 2; ++hf) {
                        float y4[4];
#pragma unroll
                        for (int e = 0; e < 4; ++e) { const float yv = ah[hf][o][e] * rstd * lg2[hf][e] + lb2[hf][e]; y4[e] = yv * sigmoidf_(yv); }
                        u32x2 w; w.x = cvt_pk_bf16(y4[0], y4[1]); w.y = cvt_pk_bf16(y4[2], y4[3]);
                        *(u32x2*)(c.XA + (size_t)(r0 + o) * XW + hf * 256 + lane * 4) = w;
                    }
                }
                goto a_item_done;
            }
            float acc[4][8];
#pragma unroll
            for (int o = 0; o < 4; ++o)
#pragma unroll
                for (int e = 0; e < 8; ++e) acc[o][e] = dwb[e];
            float xw[4][8];
            {
            auto ldrow = [&](int ri, float (&x)[8]) {
                const int t = trel - 30 + ri;
                if (t >= 0) load_bf8(ZM + (size_t)(seq0 + t) * ZMW + lane * 8, x);
                else { const f32x4 h0 = *(const f32x4*)(hist + (size_t)(30 + t) * 512 + lane * 8), h1 = *(const f32x4*)(hist + (size_t)(30 + t) * 512 + lane * 8 + 4);
                    x[0] = h0[0]; x[1] = h0[1]; x[2] = h0[2]; x[3] = h0[3]; x[4] = h1[0]; x[5] = h1[1]; x[6] = h1[2]; x[7] = h1[3]; }
            };
            ldrow(0, xw[0]); ldrow(1, xw[1]); ldrow(2, xw[2]);
#pragma unroll 2
            for (int kk = 0; kk < 32; kk += 4) {
#pragma unroll
                for (int k4 = 0; k4 < 4; ++k4) {
                    const int k = kk + k4;
                    if (k < 31) {
                        ldrow(k + 3, xw[(k4 + 3) & 3]);
                        const f32x4 w0 = *(const LAS f32x4*)(wl + k * 512 + lane * 8), w1 = *(const LAS f32x4*)(wl + k * 512 + lane * 8 + 4);
#pragma unroll
                        for (int o = 0; o < 4; ++o) {
#pragma unroll
                            for (int e = 0; e < 4; ++e) { acc[o][e] += xw[(k4 + o) & 3][e] * w0[e]; acc[o][e + 4] += xw[(k4 + o) & 3][e + 4] * w1[e]; }
                        }
                    }
                }
            }
            }
#pragma unroll
            for (int o = 0; o < 4; ++o) {
                float s = 0.f;
#pragma unroll
                for (int e = 0; e < 8; ++e) s += acc[o][e];
                const float mu = wave_sum(s) * (1.0f / 512);
                float q = 0.f;
#pragma unroll
                for (int e = 0; e < 8; ++e) { acc[o][e] -= mu; q += acc[o][e] * acc[o][e]; }
                const float rstd = __builtin_amdgcn_rsqf(wave_sum(q) * (1.0f / 512) + EPS);
                float h[8];
#pragma unroll
                for (int e = 0; e < 8; ++e) { const float yv = acc[o][e] * rstd * lng[e] + lnb[e]; h[e] = yv * sigmoidf_(yv); }
                *(u32x4*)(c.XA + (size_t)(r0 + o) * XW + lane * 8) = pack8(h);
            }
            a_item_done:
            if (tid == 0) *qslot = nextv;
            __syncthreads();
            qb = (int)*qslot;
            __syncthreads();
        }
    }
    {
        const int win = 2 << (lane >> 4);
        unsigned nextv = 0; int qb = M;
        if (!(skip & 4)) { if (tid == 0) *qslot = atomicAdd(qctr + 64, 8u); __syncthreads(); qb = (int)*qslot; __syncthreads(); }
        for (;;) {
            if (qb >= M / 4) break;
            if (tid == 0) nextv = atomicAdd(qctr + 64, 8u);
            const int qi = qb + wave;
            const int itm = qi < MS / 4 ? MP / 4 + qi : qi - MS / 4;
            const int r0 = itm * 4;
            int seq0, trel; const float* hist = nullptr;
            if (r0 < MP) { seq0 = (r0 / SEQ) * SEQ; trel = r0 - seq0; }
            else { const int s = (r0 - MP) / DSEQ; seq0 = MP + s * DSEQ; trel = r0 - seq0; hist = a->in[5] + ((size_t)(L * 32 + s) * 15) * 512; }
            float acc[4][8], cur[4][8];
#pragma unroll
            for (int o = 0; o < 4; ++o)
#pragma unroll
                for (int e = 0; e < 8; ++e) { acc[o][e] = 0.f; cur[o][e] = 0.f; }
#pragma unroll
            for (int ri = 0; ri < 19; ++ri) {
                const int t = trel - 15 + ri;
                float x[8];
                if (t >= 0) load_bf8(ZM + (size_t)(seq0 + t) * ZMW + 1536 + lane * 8, x);
                else if (hist) { const f32x4 h0 = *(const f32x4*)(hist + (size_t)(15 + t) * 512 + lane * 8), h1 = *(const f32x4*)(hist + (size_t)(15 + t) * 512 + lane * 8 + 4);
                    x[0] = h0[0]; x[1] = h0[1]; x[2] = h0[2]; x[3] = h0[3]; x[4] = h1[0]; x[5] = h1[1]; x[6] = h1[2]; x[7] = h1[3]; }
                else {
#pragma unroll
                    for (int e = 0; e < 8; ++e) x[e] = 0.f; }
#pragma unroll
                for (int o = 0; o < 4; ++o) {
                    const int dd = 15 + o - ri;
                    if (dd >= 0 && dd < 16) {
                        const bool inw = dd < win;
#pragma unroll
                        for (int e = 0; e < 8; ++e) acc[o][e] += inw ? x[e] : 0.f;
                        if (dd == 0) {
#pragma unroll
                            for (int e = 0; e < 8; ++e) cur[o][e] = x[e];
                        }
                    }
                }
            }
#pragma unroll
            for (int o = 0; o < 4; ++o) {
                const int cnt = hist ? win : min(trel + o + 1, win);
                const float inv = 1.0f / (float)cnt;
                float h[8];
#pragma unroll
                for (int e = 0; e < 8; ++e) h[e] = acc[o][e] * inv - cur[o][e];
                *(u32x4*)(c.XD + (size_t)(r0 + o) * XW + lane * 8) = pack8(h);
            }
            if (tid == 0) *qslot = nextv;
            __syncthreads();
            qb = (int)*qslot;
            __syncthreads();
        }
    }
    for (int idx = c.gw; idx < 34 * 45; idx += c.nW) {
        const int seq = idx / 45, k = idx - seq * 45;
        size_t srow; float* dst; int coff;
        if (k < 30) { coff = 0;
            if (seq < 2) { srow = (size_t)seq * SEQ + (SEQ - 30) + k; dst = out + O_CONVP + ((size_t)(L * 2 + seq) * 30 + k) * 512; }
            else { srow = (size_t)MP + (seq - 2) * DSEQ + (DSEQ - 30) + k; dst = out + O_CONVS + ((size_t)(L * 32 + seq - 2) * 30 + k) * 512; }
        } else { const int kk = k - 30; coff = 1536;
            if (seq < 2) { srow = (size_t)seq * SEQ + (SEQ - 15) + kk; dst = out + O_POOLP + ((size_t)(L * 2 + seq) * 15 + kk) * 512; }
            else { srow = (size_t)MP + (seq - 2) * DSEQ + (DSEQ - 15) + kk; dst = out + O_POOLS + ((size_t)(L * 32 + seq - 2) * 15 + kk) * 512; }
        }
        float x[8]; load_bf8(ZM + srow * ZMW + coff + lane * 8, x);
        *(f32x4*)(dst + lane * 8) = (f32x4){x[0], x[1], x[2], x[3]}; *(f32x4*)(dst + lane * 8 + 4) = (f32x4){x[4], x[5], x[6], x[7]};
    }
    __syncthreads();
}


#define XB_TMO      128
#define XB_XCNT(j)  (256  + 64 * (j))
#define XB_XSUB(j)  (1280 + 64 * (j))
#define XB_XGEN(j)  (2304 + 64 * (j))
#define XB_TOP      3328
#define XB_TOPGEN   3392
#define XCD_BAR_WORDS 3456
#define XB_SPIN_CAP (1u << 22)
__device__ __forceinline__ unsigned xb_ld(unsigned* p)              { return __hip_atomic_load(p, __ATOMIC_RELAXED, __HIP_MEMORY_SCOPE_AGENT); }
__device__ __forceinline__ unsigned xb_add(unsigned* p, unsigned v) { return __hip_atomic_fetch_add(p, v, __ATOMIC_RELAXED, __HIP_MEMORY_SCOPE_AGENT); }
__device__ __forceinline__ unsigned xb_xcc_id() { return (unsigned)__builtin_amdgcn_s_getreg((3 << 11) | 20) & 0xFu; }
#define XB_SPIN(cond, bar) do { unsigned _sp = 0; while (cond) { __builtin_amdgcn_s_sleep(1); \
    if ((++_sp & 255u) == 0u) { if (xb_ld(&(bar)[XB_TMO])) break; if (_sp > XB_SPIN_CAP) { atomicAdd(&(bar)[XB_TMO], 1u); break; } } } } while (0)
__device__ __forceinline__ void xcd_barrier_complete(unsigned* bar, unsigned x, unsigned& nloc, unsigned& nx) {
    const unsigned G = gridDim.x * gridDim.y * gridDim.z;
    unsigned sum, cnt, mine, sp = 0u;
    for (;;) {
        sum = 0u; cnt = 0u; mine = 0u;
#pragma unroll
        for (unsigned j = 0; j < 16; ++j) { const unsigned c = xb_ld(&bar[XB_XCNT(j)]); sum += c; cnt += (c > 0u) ? 1u : 0u; mine = (j == x) ? c : mine; }
        if (sum == G) break;
        __builtin_amdgcn_s_sleep(1);
        if ((++sp & 255u) == 0u) { if (xb_ld(&bar[XB_TMO])) break; if (sp > XB_SPIN_CAP) { atomicAdd(&bar[XB_TMO], 1u); break; } }
    }
    nloc = mine > 0u ? mine : 1u; nx = cnt > 0u ? cnt : 1u;
}
__device__ __forceinline__ void xcd_barrier(unsigned* bar, volatile LAS unsigned* st, int tid) {
    asm volatile("s_waitcnt vmcnt(0)" ::: "memory");
    __syncthreads();
    if (tid == 0) {
        __builtin_amdgcn_s_waitcnt(0);
        const unsigned x = xb_xcc_id();
        unsigned nloc = st[0], nx = st[1];
        if (nloc == 0u) { xcd_barrier_complete(bar, x, nloc, nx); st[0] = nloc; st[1] = nx;
            const unsigned G8 = (gridDim.x * gridDim.y * gridDim.z) >> 3; bool uni = ((G8 << 3) == gridDim.x * gridDim.y * gridDim.z) && nx == 8u && x < 8u;
#pragma unroll
            for (unsigned j = 0; j < 8; ++j) uni = uni && (xb_ld(&bar[XB_XCNT(j)]) == G8);
            if (uni) st[2] = st[3] * 8u + x;
            st[3] = (uni && gridDim.x == 256u) ? 1u : 0u; }
        const unsigned old = xb_add(&bar[XB_XSUB(x)], 1u);
        const unsigned gen = old / nloc;
        if (old + 1u == (gen + 1u) * nloc) {
            __builtin_amdgcn_fence(__ATOMIC_RELEASE, "agent");
            asm volatile("s_waitcnt vmcnt(0)" ::: "memory");
            const unsigned og = xb_add(&bar[XB_TOP], 1u);
            const unsigned tg = og / nx;
            if (og + 1u == (tg + 1u) * nx) xb_add(&bar[XB_TOPGEN], 1u);
            else XB_SPIN(xb_ld(&bar[XB_TOPGEN]) == tg, bar);
            __builtin_amdgcn_fence(__ATOMIC_ACQUIRE, "agent");
            xb_add(&bar[XB_XGEN(x)], 1u);
            asm volatile("s_waitcnt vmcnt(0)" ::: "memory");
        } else {
            XB_SPIN(xb_ld(&bar[XB_XGEN(x)]) == gen, bar);
            __builtin_amdgcn_fence(__ATOMIC_ACQUIRE, "agent");
            asm volatile("s_waitcnt vmcnt(0)" ::: "memory");
        }
    }
    __syncthreads();
}

constexpr int NPT = 6;
constexpr int P0N = 1 + (int)(REP_MASK & 1u), PPL = NPT + __builtin_popcount((REP_MASK >> 1) & ((1u << NPT) - 1u)), NPHASE = P0N + PPL * NLAYER + 1;

__global__ void __launch_bounds__(512, 2) fwd_kernel(Args args) {
    extern __shared__ __attribute__((aligned(16))) unsigned char lds_raw[];
    (void)args;
    LAS unsigned char* lds = (LAS unsigned char*)lds_raw;
    const int wave0 = __builtin_amdgcn_readfirstlane((int)threadIdx.x >> 6);
    const int hi = get_args()->ph_hi;
    unsigned* bar = (unsigned*)(get_args()->ws + WS_BAR);
    volatile LAS unsigned* bst = (volatile LAS unsigned*)(lds + LDS_BYTES - 16);
    if (threadIdx.x == 0) { bst[0] = 0u; bst[1] = 0u; bst[2] = blockIdx.x; bst[3] = xb_add(&bar[XB_XCNT(xb_xcc_id())], 1u); }
    __syncthreads();
#define MKCTX() Ctx c; { ArgsP ka = get_args(); int t_; asm volatile("v_mbcnt_lo_u32_b32 %0, -1, 0\n\tv_mbcnt_hi_u32_b32 %0, -1, %0" : "=v"(t_)); int wv_ = wave0, bx_ = (int)__builtin_amdgcn_readfirstlane((int)*(volatile LAS unsigned*)(lds + LDS_BYTES - 8)), gx_ = (int)gridDim.x; asm volatile("" : "+s"(wv_), "+s"(bx_), "+s"(gx_)); t_ += wv_ * 64; unsigned char* ws = ka->ws; \
        c.lds = lds; c.tid = t_; c.lane = t_ & 63; c.wave = wv_; c.bx = bx_; c.gx = gx_; c.gw = bx_ * 8 + wv_; c.nW = gx_ * 8; \
        c.H = ka->out; c.SS = (float*)ws; c.NB2 = (bf16_t*)(ws + WS_NB2); c.W = (bf16_t*)(ws + WS_W); c.PB = (bf16_t*)(ws + WS_PB); c.NB = (bf16_t*)(ws + WS_NB); c.BIG = ws + WS_BIG; \
        c.XA = (bf16_t*)(ws + WS_X); c.XB = c.XA + (size_t)M * XW; c.XD = c.XB + (size_t)M * XW; c.XC = c.XD + (size_t)M * XW; } \
        bf16_t* HID = (bf16_t*)c.BIG; bf16_t* ZM = (bf16_t*)c.BIG; bf16_t* ZG = (bf16_t*)c.BIG; float* T = (float*)c.BIG; (void)HID; (void)ZM; (void)ZG; (void)T; \

#define GEMM1(EPI, Aptr, Bptr, Nn, Kk, ...) do { pg8::Gemm g{(Aptr), (Aptr), (Aptr), (Bptr), (Bptr), (Bptr)}; \
        pg8::EPI E{__VA_ARGS__}; pg8::gemm_phase<pg8::EPI, (Nn), (Kk), 1, G_ALIGN, G_SP2>(lds, c.tid, g, E); } while (0)

#pragma unroll 1
    for (int ph = get_args()->ph_lo; ph < hi; ++ph) {
        int L = 0, j = -1, rep = 0;
        if (ph < P0N) rep = ph;
        else if (ph >= P0N + PPL * NLAYER) { L = NLAYER - 1; j = NPT; }
        else { int q = ph - P0N; L = q / PPL; q -= L * PPL;
            for (int jj = 0; jj < NPT; ++jj) { const int cnt = 1 + (int)((REP_MASK >> (jj + 1)) & 1u); if (q < cnt) { j = jj; rep = q; break; } q -= cnt; } }
        const float rsc = rep ? 0.f : 1.f, rsh = rep ? 0.f : 0.5f;
        {
#ifdef PH_ONLY
        switch (PH_ONLY) {
#else
        switch (j) {
#endif
        case -1: { MKCTX(); prep_phase(c, 0, 0, 1648, c.bx, c.gx, true); norm_phase<0>(c, nullptr); } break;
        case 0: case 4: { MKCTX(); const bool f1 = (j == 0);
            pg8::FfnArgs fa{f1 ? c.NB2 : c.NB, c.W + (f1 ? W_GU1 : W_GU2), HID, c.W + (f1 ? W_D1 : W_D2), c.SS + (size_t)(4 * L + (f1 ? 0 : 2)) * M,
                            c.H, c.NB, c.SS + (size_t)(4 * L + (f1 ? 1 : 3)) * M, (unsigned*)(get_args()->ws + WS_BAR) + 8192 + 1152 * (2 * (2 * L + (f1 ? 0 : 1)) + rep),
                            (f1 && L == 0 && !rep) ? get_args()->in[0] : nullptr, (f1 && L == 0 && !rep) ? get_args()->in[1] : nullptr,
                            f1 ? nullptr : c.PB, c.W + W_PE, (float*)c.XA, rsh, rsc};
            pg8::ffn_phase(lds, c.tid, fa); } break;
        case 1: { MKCTX(); GEMM1(EpiWinMix, c.NB, c.W + W_IM, 2560, D, ZM, c.SS + (size_t)(4 * L + 1) * M);
            if (L > 0 && !rep && c.gx > 64) prep_phase(c, L, 1568, 1632, c.bx - 208, c.gx - 208, false);
        } break;
        case 2: { MKCTX(); mix_phase(c, L, 2 * L + rep); } break;
        case 3: { MKCTX();
            unsigned* tc = (unsigned*)(get_args()->ws + WS_BAR) + 17408 + 2304 * (2 * L + rep);
            pg8::TailArgs ta{get_args()->ws, c.H, get_args()->in[12] + L * 3072, get_args()->in[24] + L * 512, c.SS + (size_t)(4 * L + 1) * M, c.SS + (size_t)(4 * L + 2) * M, tc, tc + 1152, rsc};
            pg8::tail_phase(lds, c.tid, ta); } break;
        case 5: {
            { MKCTX(); GEMM1(EpiPE, c.NB, c.W + W_PG, D, D, c.H, (const float*)c.XA, rsc, c.SS + (size_t)(4 * L + 3) * M, (L + 1 < NLAYER) ? c.NB2 : (bf16_t*)nullptr, c.SS + (size_t)(4 * L + 4) * M); }
            if (L + 1 < NLAYER && !rep) { MKCTX();
                if (c.gx > 64) { prep_phase(c, L + 1, 0, 1568, c.bx - 32, c.gx - 32, false); prep_phase(c, L + 1, 1632, 1648, c.bx - 32, c.gx - 32, true); }
                else prep_phase(c, L + 1, 0, 1648, c.bx, c.gx, true); }
        } break;
        default: { MKCTX(); if (!rep) norm_phase<2>(c, get_args()->in[34]); } break;
        }
        }
        if (ph + 1 < hi) {
            if (hi < 0) cg::this_grid().sync();
            { int t_; asm volatile("v_mbcnt_lo_u32_b32 %0, -1, 0\n\tv_mbcnt_hi_u32_b32 %0, -1, %0" : "=v"(t_)); xcd_barrier(bar, bst, t_ + wave0 * 64); }
        }
    }
#undef GEMM1
#undef MKCTX
}

extern "C" void kernel_launch(void* const* d_in, const int* in_sizes, int n_in, void* d_out, int out_size, void* d_ws, size_t ws_size, hipStream_t stream) {
    static int grid = 0;
    if (grid == 0) {
        if (n_in != 35 || (size_t)out_size != O_END || ws_size < WS_END) { fprintf(stderr, "kernel_launch: unexpected shapes (n_in %d, out %d, ws %zu)\n", n_in, out_size, ws_size); grid = -1; return; }
        int dev = 0, cus = 0, per_cu = 0;
        if (hipGetDevice(&dev) != hipSuccess || hipDeviceGetAttribute(&cus, hipDeviceAttributeMultiprocessorCount, dev) != hipSuccess) { grid = -1; return; }
        if (hipFuncSetAttribute((const void*)fwd_kernel, hipFuncAttributeMaxDynamicSharedMemorySize, LDS_BYTES) != hipSuccess) { fprintf(stderr, "kernel_launch: hipFuncSetAttribute failed\n"); grid = -1; return; }
        if (hipOccupancyMaxActiveBlocksPerMultiprocessor(&per_cu, (const void*)fwd_kernel, 512, LDS_BYTES) != hipSuccess || per_cu < 1) { fprintf(stderr, "kernel_launch: occupancy query says %d\n", per_cu); per_cu = 1; }
        (void)hipGetLastError();
        grid = cus * 1;
    }
    if (grid < 0) return;
    Args a{};
    for (int i = 0; i < 35; ++i) a.in[i] = (const float*)d_in[i];
    a.out = (float*)d_out; a.ws = (unsigned char*)d_ws;
#if MK_N_LAUNCHES == 1
    (void)hipMemsetAsync((char*)d_ws + WS_BAR, 0, 131072, stream);
    a.ph_lo = 0; a.ph_hi = NPHASE;
    void* kargs[] = {&a};
    hipError_t e = hipLaunchCooperativeKernel((const void*)fwd_kernel, dim3(grid), dim3(512), kargs, LDS_BYTES, stream);
    if (e != hipSuccess) fprintf(stderr, "kernel_launch: cooperative launch failed: %s (grid %d)\n", hipGetErrorString(e), grid);
#else
    for (int ph = 0; ph < NPHASE; ++ph) {
        a.ph_lo = ph; a.ph_hi = ph + 1;
        hipLaunchKernelGGL(fwd_kernel, dim3(grid), dim3(512), LDS_BYTES, stream, a);
    }
#endif
}
```
